# Optimizing an MI355X kernel written in HIP

```python
import math
import jax, jax.numpy as jnp
from jax import lax
import numpy as np

D_MODEL = 2048
BATCH = 32
SEQ = 256
DEPTH = 2
DEC_BATCH = 2
DEC_SEQ = 4096
PAST_LEN = 256

GRID_W = 64
D_SSM = 512
SSM_GROUP = 16
N_SSM_GROUPS = D_SSM // SSM_GROUP
SSM_STATE = 64
HEAD_DIM = 128
N_HEADS = 8
N_KV_HEADS = 2
D_ATTN = N_HEADS * HEAD_DIM
D_KV = N_KV_HEADS * HEAD_DIM
WINDOW = 128
BLOCK = 128
ROPE_BASE = 10000.0
D_SGU = 512
SGU_CHUNK = 128
SGU_GROUP_CH = 128
N_SGU_GROUPS = D_SGU // SGU_GROUP_CH
N_BRANCH = 3
IN_SIZES = (D_SSM, D_SSM, D_ATTN, D_KV, D_KV, D_ATTN, D_SGU, D_SGU, D_SGU, N_BRANCH * D_MODEL)
IN_SPLITS = tuple(sum(IN_SIZES[:i + 1]) for i in range(len(IN_SIZES) - 1))
D_IN = sum(IN_SIZES)
DEEPNORM_ALPHA = (2 * DEPTH) ** 0.25
DEEPNORM_BETA = (8 * DEPTH) ** -0.25
LN_EPS = 1e-5

kernel_name = 'hybrid_s5_swa_sgu_diffusion_step'


def _layernorm(x):
    xf = x.astype(jnp.float32)
    mu = jnp.mean(xf, axis=-1, keepdims=True)
    var = jnp.mean(jnp.square(xf - mu), axis=-1, keepdims=True)
    return ((xf - mu) * lax.rsqrt(var + LN_EPS)).astype(x.dtype)


def _axial_rope(x, rows):
    row = jnp.repeat(jnp.arange(rows), GRID_W)
    col = jnp.tile(jnp.arange(GRID_W), rows)
    half = HEAD_DIM // 2
    inv = ROPE_BASE ** (-jnp.arange(0, half, 2, dtype=jnp.float32) / half)

    def rot(xh, pos):
        ang = pos.astype(jnp.float32)[:, None] * inv[None, :]
        cos = jnp.cos(ang)[None, :, None, :]
        sin = jnp.sin(ang)[None, :, None, :]
        x1, x2 = jnp.split(xh.astype(jnp.float32), 2, axis=-1)
        return jnp.concatenate([x1 * cos - x2 * sin, x1 * sin + x2 * cos], axis=-1)

    xr, xc = jnp.split(x, 2, axis=-1)
    return jnp.concatenate([rot(xr, row), rot(xc, col)], axis=-1).astype(x.dtype)


def _softmax_with_sink(s, sink_kg):
    sk = jnp.broadcast_to(sink_kg.astype(jnp.float32)[None, :, :, None, None], s.shape[:-1] + (1,))
    p = jax.nn.softmax(jnp.concatenate([s, sk], axis=-1), axis=-1)
    return p[..., :-1]


def _context_attention(q, k, v, sink):
    b, lc = q.shape[:2]
    nb = lc // BLOCK
    g = N_HEADS // N_KV_HEADS
    scale = HEAD_DIM ** -0.5
    sink_kg = sink.reshape(N_KV_HEADS, g)
    qb = q.reshape(b, nb, BLOCK, N_KV_HEADS, g, HEAD_DIM).transpose(1, 0, 2, 3, 4, 5)

    def one(qblk):
        s = jnp.einsum('bqkgd,bskd->bkgqs', qblk, k).astype(jnp.float32) * scale
        p = _softmax_with_sink(s, sink_kg).astype(v.dtype)
        return jnp.einsum('bkgqs,bskd->bqkgd', p, v)

    o = lax.map(one, qb)
    return o.transpose(1, 0, 2, 3, 4, 5).reshape(b, lc, D_ATTN)


def _latent_attention(q, k, v, kc, vc, sink):
    b, l = q.shape[:2]
    nb = l // BLOCK
    g = N_HEADS // N_KV_HEADS
    scale = HEAD_DIM ** -0.5
    sink_kg = sink.reshape(N_KV_HEADS, g)
    pad = ((0, 0), (BLOCK, BLOCK), (0, 0), (0, 0))
    kp = jnp.pad(k, pad).reshape(b, nb + 2, BLOCK, N_KV_HEADS, HEAD_DIM)
    vp = jnp.pad(v, pad).reshape(b, nb + 2, BLOCK, N_KV_HEADS, HEAD_DIM)
    kband = jnp.concatenate([kp[:, :-2], kp[:, 1:-1], kp[:, 2:]], axis=2)
    vband = jnp.concatenate([vp[:, :-2], vp[:, 1:-1], vp[:, 2:]], axis=2)
    qpos = jnp.arange(nb)[:, None] * BLOCK + jnp.arange(BLOCK)[None, :]
    kpos = jnp.arange(nb)[:, None] * BLOCK - BLOCK + jnp.arange(3 * BLOCK)[None, :]
    kq = kpos[:, None, :]
    mask = (jnp.abs(kq - qpos[:, :, None]) <= WINDOW) & (kq >= 0) & (kq < l)
    qb = q.reshape(b, nb, BLOCK, N_KV_HEADS, g, HEAD_DIM).transpose(1, 0, 2, 3, 4, 5)
    xs = (qb, kband.transpose(1, 0, 2, 3, 4), vband.transpose(1, 0, 2, 3, 4), mask)
    n_loc = 3 * BLOCK

    def one(args):
        qblk, kblk, vblk, m = args
        s_loc = jnp.einsum('bqkgd,bskd->bkgqs', qblk, kblk).astype(jnp.float32) * scale
        s_loc = jnp.where(m[None, None, None], s_loc, -jnp.inf)
        s_ctx = jnp.einsum('bqkgd,bskd->bkgqs', qblk, kc).astype(jnp.float32) * scale
        p = _softmax_with_sink(jnp.concatenate([s_loc, s_ctx], axis=-1), sink_kg).astype(v.dtype)
        return (jnp.einsum('bkgqs,bskd->bqkgd', p[..., :n_loc], vblk)
                + jnp.einsum('bkgqs,bskd->bqkgd', p[..., n_loc:], vc))

    o = lax.map(one, xs)
    return o.transpose(1, 0, 2, 3, 4, 5).reshape(b, l, D_ATTN)


def _zoh(lam_re, lam_im, log_step, b_re, b_im):
    lr = lam_re.astype(jnp.float32)
    li = lam_im.astype(jnp.float32)
    dt = jnp.exp(log_step.astype(jnp.float32))[:, None]
    mag = jnp.exp(lr * dt)
    ab_re = mag * jnp.cos(li * dt)
    ab_im = mag * jnp.sin(li * dt)
    den = lr * lr + li * li
    nr = ab_re - 1.0
    f_re = (nr * lr + ab_im * li) / den
    f_im = (ab_im * lr - nr * li) / den
    br = b_re.astype(jnp.float32)
    bi = b_im.astype(jnp.float32)
    bb_re = f_re[..., None] * br - f_im[..., None] * bi
    bb_im = f_re[..., None] * bi + f_im[..., None] * br
    return ab_re, ab_im, bb_re, bb_im


def _complex_scan(a_re, a_im, u_re, u_im, s0_re, s0_im):
    u_re = u_re.at[:, 0].add(a_re * s0_re - a_im * s0_im)
    u_im = u_im.at[:, 0].add(a_re * s0_im + a_im * s0_re)
    A_re = jnp.broadcast_to(a_re, u_re.shape)
    A_im = jnp.broadcast_to(a_im, u_im.shape)

    def comb(e1, e2):
        a1r, a1i, b1r, b1i = e1
        a2r, a2i, b2r, b2i = e2
        return (a2r * a1r - a2i * a1i, a2r * a1i + a2i * a1r,
                a2r * b1r - a2i * b1i + b2r, a2r * b1i + a2i * b1r + b2i)

    _, _, s_re, s_im = lax.associative_scan(comb, (A_re, A_im, u_re, u_im), axis=1)
    return s_re, s_im


def _ssm_branch(xa, s0, lam_re, lam_im, log_step, b_re, b_im, c_re, c_im, d_skip, w_glu, b_glu):
    bsz, L = xa.shape[:2]
    u = xa.astype(jnp.float32).reshape(bsz, L, N_SSM_GROUPS, SSM_GROUP)
    y = u * d_skip.astype(jnp.float32).reshape(N_SSM_GROUPS, SSM_GROUP)
    s0 = s0.astype(jnp.float32)
    finals = []
    for d in range(2):
        ab_re, ab_im, bb_re, bb_im = _zoh(lam_re[d], lam_im[d], log_step[d], b_re[d], b_im[d])
        ud = u if d == 0 else jnp.flip(u, axis=1)
        bu_re = jnp.einsum('gpc,blgc->blgp', bb_re, ud)
        bu_im = jnp.einsum('gpc,blgc->blgp', bb_im, ud)
        s_re, s_im = _complex_scan(ab_re, ab_im, bu_re, bu_im, s0[:, d, 0], s0[:, d, 1])
        yd = (jnp.einsum('gcp,blgp->blgc', c_re[d].astype(jnp.float32), s_re)
              - jnp.einsum('gcp,blgp->blgc', c_im[d].astype(jnp.float32), s_im))
        if d == 1:
            yd = jnp.flip(yd, axis=1)
        y = y + yd
        finals.append(jnp.stack([s_re[:, -1], s_im[:, -1]], axis=1))
    y = jax.nn.gelu(y.reshape(bsz, L, D_SSM))
    y = y * jax.nn.sigmoid(y @ w_glu.astype(jnp.float32) + b_glu.astype(jnp.float32))
    return y.astype(xa.dtype), jnp.stack(finals, axis=1)


def _sgu_branch(u, v, ln_g, ln_b, w_s, b_s):
    u = jax.nn.gelu(u)
    v = _layernorm(jax.nn.gelu(v)) * ln_g + ln_b
    b, L = v.shape[:2]
    nc = L // SGU_CHUNK
    vc = v.reshape(b, nc, SGU_CHUNK, N_SGU_GROUPS, SGU_GROUP_CH)
    vm = jnp.einsum('gpq,bnqgc->bnpgc', w_s, vc) + b_s.T[None, None, :, :, None]
    return u * vm.reshape(b, L, D_SGU)


def _trunk_layer(x, cond, lp, ctx_k, ctx_v, ssm_s0):
    is_context = ctx_k is None
    b, L = x.shape[:2]
    mod = jax.nn.silu(cond) @ lp['w_ada'] + lp['b_ada']
    shift, scale, gate = jnp.split(mod[:, None, :], 3, axis=-1)
    h = _layernorm(x) * (1.0 + scale) + shift
    proj = h @ lp['w_in']
    xa, za, q, k, v, zb, u, vs, zc, mg = jnp.split(proj, IN_SPLITS, axis=-1)
    if is_context:
        ssm_s0 = jnp.zeros((b, 2, 2, N_SSM_GROUPS, SSM_STATE), jnp.float32)
    ya, ssm_final = _ssm_branch(xa, ssm_s0, lp['lam_re'], lp['lam_im'], lp['log_step'],
                                lp['b_re'], lp['b_im'], lp['c_re'], lp['c_im'],
                                lp['d_skip'], lp['w_glu'], lp['b_glu'])
    ya = ya * jax.nn.silu(za)
    q = q.reshape(b, L, N_HEADS, HEAD_DIM)
    k = k.reshape(b, L, N_KV_HEADS, HEAD_DIM)
    v = v.reshape(b, L, N_KV_HEADS, HEAD_DIM)
    if is_context:
        yb = _context_attention(q, k, v, lp['sink'])
    else:
        rows = L // GRID_W
        yb = _latent_attention(_axial_rope(q, rows), _axial_rope(k, rows), v, ctx_k, ctx_v, lp['sink'])
    yb = yb * jax.nn.silu(zb)
    yc = _sgu_branch(u, vs, lp['sgu_g'], lp['sgu_b'], lp['w_s'], lp['b_s']) * jax.nn.silu(zc)
    g_a, g_b, g_c = jnp.split(jax.nn.sigmoid(mg), 3, axis=-1)
    merged = g_a * (ya @ lp['w_pa']) + g_b * (yb @ lp['w_pb']) + g_c * (yc @ lp['w_pc'])
    out = merged @ lp['w_out']
    y = _layernorm(DEEPNORM_ALPHA * x + gate * out) * lp['ln_g'] + lp['ln_b']
    return y, k, v, ssm_final


def setup_inputs(seed: int = 0) -> dict:
    key = jax.random.key(seed)
    ks = jax.random.split(key, 40)
    f32 = jnp.float32

    def nrm(k, shape, scale):
        return jax.random.normal(k, shape, f32) * scale

    G, P, C = N_SSM_GROUPS, SSM_STATE, SSM_GROUP
    n = jnp.arange(SSM_STATE, dtype=f32)
    return {
        'x_prompt': nrm(ks[0], (BATCH, SEQ, D_MODEL), 1.0),
        'x_sample': nrm(ks[1], (DEC_BATCH, DEC_SEQ, D_MODEL), 1.0),
        'cache_k': nrm(ks[2], (DEC_BATCH, DEPTH, PAST_LEN, N_KV_HEADS, HEAD_DIM), 1.0),
        'cache_v': nrm(ks[3], (DEC_BATCH, DEPTH, PAST_LEN, N_KV_HEADS, HEAD_DIM), 1.0),
        'state_ssm': nrm(ks[4], (DEC_BATCH, DEPTH, 2, 2, G, P), 0.1),
        'c': nrm(ks[5], (DEC_BATCH, D_MODEL), 1.0),
        'c_ctx': nrm(ks[6], (D_MODEL,), 1.0),
        'w_ada': nrm(ks[7], (DEPTH, D_MODEL, 3 * D_MODEL), 0.5 * D_MODEL ** -0.5),
        'b_ada': nrm(ks[8], (DEPTH, 3 * D_MODEL), 0.01),
        'w_in': nrm(ks[9], (DEPTH, D_MODEL, D_IN), D_MODEL ** -0.5),
        'ssm_lam_re': -0.5 + nrm(ks[10], (DEPTH, 2, G, P), 0.01),
        'ssm_lam_im': math.pi * n + nrm(ks[11], (DEPTH, 2, G, P), 0.01),
        'ssm_log_step': jax.random.uniform(ks[12], (DEPTH, 2, G), f32,
                                           minval=math.log(1e-3), maxval=math.log(1e-1)),
        'ssm_b_re': nrm(ks[13], (DEPTH, 2, G, P, C), (2.0 * C) ** -0.5),
        'ssm_b_im': nrm(ks[14], (DEPTH, 2, G, P, C), (2.0 * C) ** -0.5),
        'ssm_c_re': nrm(ks[15], (DEPTH, 2, G, C, P), (2.0 * P) ** -0.5),
        'ssm_c_im': nrm(ks[16], (DEPTH, 2, G, C, P), (2.0 * P) ** -0.5),
        'ssm_d': nrm(ks[17], (DEPTH, D_SSM), 1.0),
        'w_glu': nrm(ks[18], (DEPTH, D_SSM, D_SSM), D_SSM ** -0.5),
        'b_glu': nrm(ks[19], (DEPTH, D_SSM), 0.01),
        'attn_sink': nrm(ks[20], (DEPTH, N_HEADS), 0.5),
        'sgu_ln_g': 1.0 + nrm(ks[21], (DEPTH, D_SGU), 0.01),
        'sgu_ln_b': nrm(ks[22], (DEPTH, D_SGU), 0.01),
        'w_spatial': nrm(ks[23], (DEPTH, N_SGU_GROUPS, SGU_CHUNK, SGU_CHUNK), 0.5 * SGU_CHUNK ** -0.5),
        'b_spatial': 1.0 + nrm(ks[24], (DEPTH, N_SGU_GROUPS, SGU_CHUNK), 0.01),
        'w_proj_a': nrm(ks[25], (DEPTH, D_SSM, D_MODEL), DEEPNORM_BETA * D_SSM ** -0.5),
        'w_proj_b': nrm(ks[26], (DEPTH, D_ATTN, D_MODEL), DEEPNORM_BETA * D_ATTN ** -0.5),
        'w_proj_c': nrm(ks[27], (DEPTH, D_SGU, D_MODEL), DEEPNORM_BETA * D_SGU ** -0.5),
        'w_out': nrm(ks[28], (DEPTH, D_MODEL, D_MODEL), DEEPNORM_BETA * D_MODEL ** -0.5),
        'ln_g': 1.0 + nrm(ks[29], (DEPTH, D_MODEL), 0.01),
        'ln_b': nrm(ks[30], (DEPTH, D_MODEL), 0.01),
    }


def reference(x_prompt, x_sample, cache_k, cache_v, state_ssm, c, c_ctx,
              w_ada, b_ada, w_in, ssm_lam_re, ssm_lam_im, ssm_log_step,
              ssm_b_re, ssm_b_im, ssm_c_re, ssm_c_im, ssm_d, w_glu, b_glu,
              attn_sink, sgu_ln_g, sgu_ln_b, w_spatial, b_spatial,
              w_proj_a, w_proj_b, w_proj_c, w_out, ln_g, ln_b):
    def layer_params(l):
        return {
            'w_ada': w_ada[l], 'b_ada': b_ada[l], 'w_in': w_in[l],
            'lam_re': ssm_lam_re[l], 'lam_im': ssm_lam_im[l], 'log_step': ssm_log_step[l],
            'b_re': ssm_b_re[l], 'b_im': ssm_b_im[l], 'c_re': ssm_c_re[l], 'c_im': ssm_c_im[l],
            'd_skip': ssm_d[l], 'w_glu': w_glu[l], 'b_glu': b_glu[l],
            'sink': attn_sink[l], 'sgu_g': sgu_ln_g[l], 'sgu_b': sgu_ln_b[l],
            'w_s': w_spatial[l], 'b_s': b_spatial[l],
            'w_pa': w_proj_a[l], 'w_pb': w_proj_b[l], 'w_pc': w_proj_c[l],
            'w_out': w_out[l], 'ln_g': ln_g[l], 'ln_b': ln_b[l],
        }

    h = x_prompt
    ks_list, vs_list, ss_list = [], [], []
    for l in range(DEPTH):
        h, k_l, v_l, s_l = _trunk_layer(h, c_ctx[None, :], layer_params(l), None, None, None)
        ks_list.append(k_l)
        vs_list.append(v_l)
        ss_list.append(s_l)
    y_prompt = h
    new_cache_k = jnp.stack(ks_list, axis=1)
    new_cache_v = jnp.stack(vs_list, axis=1)
    new_state_ssm = jnp.stack(ss_list, axis=1)

    z = x_sample
    for l in range(DEPTH):
        z, _, _, _ = _trunk_layer(z, c, layer_params(l), cache_k[:, l], cache_v[:, l], state_ssm[:, l])
    y_sample = z
    return (y_prompt, y_sample, new_cache_k, new_cache_v, new_state_ssm)
```

```cpp
#include <hip/hip_runtime.h>
#include <hip/hip_cooperative_groups.h>
#include <cstdio>
#include <cstdint>
#include <cmath>
namespace cg = cooperative_groups;

#define GAS __attribute__((address_space(1)))
#define LAS __attribute__((address_space(3)))
typedef unsigned short bf16;
typedef short bf16x8 __attribute__((ext_vector_type(8)));
typedef short s16x4 __attribute__((ext_vector_type(4)));
typedef float f32x2 __attribute__((ext_vector_type(2)));
typedef float f32x4 __attribute__((ext_vector_type(4)));
typedef float f32x16 __attribute__((ext_vector_type(16)));
typedef unsigned u32x2 __attribute__((ext_vector_type(2)));
typedef unsigned u32x4 __attribute__((ext_vector_type(4)));
typedef __bf16 bf16x2_t __attribute__((ext_vector_type(2)));

constexpr int DM = 2048, M = 16384, MCTX = 8192, DIN = 11264, NW = 8, NT = 512;
constexpr int C_XA = 0, C_ZA = 512, C_Q = 1024, C_K = 2048, C_V = 2304, C_ZB = 2560, C_U = 3584, C_VS = 4096, C_ZC = 4608, C_MG = 5120;
constexpr float LN_EPS = 1e-5f;
constexpr float DN_ALPHA = 1.41421356237309515f;
constexpr float LOG2E = 1.4426950408889634f;
constexpr float QSCALE = 0.08838834764831845f * LOG2E;
constexpr int TCH = 32;

constexpr size_t MiB = 1u << 20;
constexpr size_t WS_CTL = 0, CTL_ZERO_BYTES = 1 * MiB;
constexpr size_t WS_MODP = 1 * MiB;
constexpr size_t WS_ROPE = 6 * MiB;
constexpr size_t WS_AT = 6 * MiB + 65536;
constexpr size_t WS_MOD = 6 * MiB + 262144;
constexpr size_t WS_WS = 7 * MiB;
constexpr size_t WS_CK = 8 * MiB;
constexpr size_t WS_CV = 8 * MiB + 524288;
constexpr size_t WS_LAG = 9 * MiB;
constexpr size_t WS_WF = 11 * MiB;
constexpr size_t WS_WY = 27 * MiB;
constexpr size_t WS_WGLU = 43 * MiB;
constexpr size_t WS_WP = 44 * MiB;
constexpr size_t WS_WOUT = 60 * MiB;
constexpr size_t WS_WIN = 76 * MiB;
constexpr size_t WS_H = 164 * MiB;
constexpr size_t WS_MRG = 228 * MiB;
constexpr size_t WS_YG = 292 * MiB;
constexpr size_t WS_F = 308 * MiB;
constexpr size_t WS_SIN = 324 * MiB;
constexpr size_t WS_P = 332 * MiB;
constexpr size_t WS_END = 684 * MiB;
constexpr int CW_WQ = 64;
constexpr int CW_BAR = 8192;

constexpr int RING_BYTES = 131072;
constexpr int LDSCTL_OFF = RING_BYTES, MISC_OFF = LDSCTL_OFF + 320;
constexpr int LDS_BYTES = 147456;

__device__ __forceinline__ unsigned f2bf(float f) { unsigned u = __builtin_bit_cast(unsigned, f); return (u + 0x7fffu + ((u >> 16) & 1u)) >> 16; }
__device__ __forceinline__ unsigned pk2(float lo, float hi) { f32x2 v = {lo, hi}; bf16x2_t b = __builtin_convertvector(v, bf16x2_t); return __builtin_bit_cast(unsigned, b); }
__device__ __forceinline__ float bf2f(unsigned short h) { return __builtin_bit_cast(float, (unsigned)h << 16); }
__device__ __forceinline__ float bflo(unsigned w) { return __builtin_bit_cast(float, w << 16); }
__device__ __forceinline__ float bfhi(unsigned w) { return __builtin_bit_cast(float, w & 0xffff0000u); }
__device__ __forceinline__ float sigmoidf_(float x) { return 1.0f / (1.0f + __expf(-x)); }
__device__ __forceinline__ float siluf_(float x) { return x / (1.0f + __expf(-x)); }
__device__ __forceinline__ float geluf_(float x) { const float z = 1.5957691216057308f * (x + 0.044715f * x * x * x); return x / (1.0f + __expf(-z)); }
__device__ __forceinline__ float wave_sum(float v) {
#pragma unroll
    for (int o = 1; o < 64; o <<= 1) v += __shfl_xor(v, o);
    return v;
}
#define LDS_WAIT() asm volatile("s_waitcnt lgkmcnt(0)" ::: "memory")
#define VM_WAIT() asm volatile("s_waitcnt vmcnt(0)" ::: "memory")
namespace pg8 {
#define PG8_LAS __attribute__((address_space(3)))
typedef unsigned short bf16_t;
typedef short bf16x8 __attribute__((ext_vector_type(8)));
typedef float f32x4 __attribute__((ext_vector_type(4)));
typedef unsigned u32x4 __attribute__((ext_vector_type(4)));
constexpr int BM = 256, BK = 64, HALF = 128, HTB = HALF * BK * 2  , STAGE_BYTES = 8 * HTB, NXCD = 8, WGM = 8;

__host__ __device__ __forceinline__ int lds_byte(int r, int c) { const int st = (r >> 4) * 2 + (c >> 5), rr = r & 15, cc = c & 31, ob = rr * 64 + cc * 2; return st * 1024 + (ob ^ (((ob >> 9) & 1) << 5)); }
__host__ __device__ __forceinline__ void stage_rc(int b, int& R, int& C) { const int st = b / 1024, sb = b % 1024, swz = sb ^ (((sb >> 9) & 1) << 5); R = (st >> 1) * 16 + swz / 64; C = (st & 1) * 32 + (swz % 64) / 2; }
__host__ __device__ __forceinline__ int perm32(int rho) { const int n = rho >> 4, i = rho & 15; return 8 * (i >> 2) + 4 * n + (i & 3); }

struct Unit { int pm, pn; };
struct Gemm { const bf16_t* A; const bf16_t* Bt; int M, N, K; };

struct StaticOrder {
    int nM, nN, nwg, G, c;
    __host__ __device__ void init(int M, int N, int G_, int c_) { nM = M / BM; nN = N / BM; nwg = nM * nN; G = G_; c = c_; }
    __host__ __device__ bool next(int i, Unit& u) const {
        const long L = (long)i * G + c; if (L >= nwg) return false;
        int wgid = (int)L; { const int q = nwg / NXCD, r = nwg % NXCD, xcd = wgid % NXCD, off = wgid / NXCD; wgid = (xcd < r ? xcd * (q + 1) : r * (q + 1) + (xcd - r) * q) + off; }
        const int nig = WGM * nN, gid = wgid / nig, fm = gid * WGM, gsz = (nM - fm) < WGM ? (nM - fm) : WGM;
        u.pm = fm + ((wgid % nig) % gsz); u.pn = (wgid % nig) / gsz; return true;
    }
    __device__ __forceinline__ void a_ready(const Unit&) const {}
    __device__ __forceinline__ void done(const Unit&) const {}
};


struct OneUnit {
    Unit u;
    __device__ __forceinline__ bool next(int i, Unit& o) const { if (i != 0) return false; o = u; return true; }
    __device__ __forceinline__ void a_ready(const Unit&) const {}
    __device__ __forceinline__ void done(const Unit&) const {}
};

struct EpiInProj {
    static constexpr bool PERM = true, AFTER_DRAIN = false, HAS_MID = false;
    bf16_t* P; float* outk; float* outv; const float* rope;
    __device__ __forceinline__ void operator()(const f32x4 (&acc)[2][2][4][2], const Unit& u, int wr, int wc, int fr, int fq) const {
        const int pn = u.pn;
        int kind;
        if (pn < 2) kind = 0; else if (pn < 4) kind = 1; else if (pn < 8) kind = 4; else if (pn == 8) kind = 5; else if (pn == 9) kind = 6;
        else if (pn < 14) kind = 1; else if (pn < 18) kind = 2; else if (pn < 20) kind = 1; else kind = 3;
        const bool lat = u.pm >= 32;
        int row0 = u.pm * BM + wr * 64 + fr; asm volatile("" : "+v"(row0)); const int colL = wc * 32 + 8 * fq;
        const int p0 = wc * 16 + 4 * fq;
        const int j0 = (wc < 2) ? p0 : p0 - 32;
        const int dbase = (wc < 2) ? p0 : p0 + 32;
#pragma unroll
        for (int ai = 0; ai < 2; ++ai)
#pragma unroll
            for (int m = 0; m < 4; ++m) {
                const int row = row0 + ai * HALF + m * 16;
                bf16_t* rowp = P + (size_t)row * DIN + pn * BM + colL;
                f32x4 cs0 = {1.f, 0.f, 1.f, 0.f}, cs1 = {1.f, 0.f, 1.f, 0.f};
                if ((kind == 4 || kind == 5) && lat) {
                    const int t = (row - MCTX) & 4095; const int pos = (wc < 2) ? (t >> 6) : (t & 63);
                    const float* rp = rope + (size_t)(pos * 32 + j0) * 2; cs0 = *(const f32x4*)rp; cs1 = *(const f32x4*)(rp + 4);
                }
#pragma unroll
                for (int bj = 0; bj < 2; ++bj) {
                    f32x4 v0 = acc[ai][bj][m][0], v1 = acc[ai][bj][m][1];
                    if (kind == 1) { for (int e = 0; e < 4; ++e) { v0[e] = siluf_(v0[e]); v1[e] = siluf_(v1[e]); } }
                    else if (kind == 2) { for (int e = 0; e < 4; ++e) { v0[e] = geluf_(v0[e]); v1[e] = geluf_(v1[e]); } }
                    else if (kind == 3) { for (int e = 0; e < 4; ++e) { v0[e] = sigmoidf_(fminf(fmaxf(v0[e], -30.f), 30.f)); v1[e] = sigmoidf_(fminf(fmaxf(v1[e], -30.f), 30.f)); } }
                    else if (kind == 4 || kind == 5) {
                        if (kind == 5 && !lat) {
                            const int b = row >> 8, t = row & 255;
                            float* o = outk + (size_t)b * (2 * 256 * 256) + t * 256 + bj * 128 + dbase;
                            *(f32x4*)o = (f32x4){v0[0], v0[2], v1[0], v1[2]}; *(f32x4*)(o + 32) = (f32x4){v0[1], v0[3], v1[1], v1[3]};
                        }
                        const float sc = (kind == 4) ? QSCALE : 1.0f;
                        f32x4 w0, w1;
                        w0[0] = (v0[0] * cs0[0] - v0[1] * cs0[1]) * sc; w0[1] = (v0[0] * cs0[1] + v0[1] * cs0[0]) * sc;
                        w0[2] = (v0[2] * cs0[2] - v0[3] * cs0[3]) * sc; w0[3] = (v0[2] * cs0[3] + v0[3] * cs0[2]) * sc;
                        w1[0] = (v1[0] * cs1[0] - v1[1] * cs1[1]) * sc; w1[1] = (v1[0] * cs1[1] + v1[1] * cs1[0]) * sc;
                        w1[2] = (v1[2] * cs1[2] - v1[3] * cs1[3]) * sc; w1[3] = (v1[2] * cs1[3] + v1[3] * cs1[2]) * sc;
                        v0 = w0; v1 = w1;
                    } else if (kind == 6) {
                        if (!lat) { const int b = row >> 8, t = row & 255; float* o = outv + (size_t)b * (2 * 256 * 256) + t * 256 + bj * 128 + colL; *(f32x4*)o = v0; *(f32x4*)(o + 4) = v1; }
                    }
                    u32x4 w; w.x = pk2(v0[0], v0[1]); w.y = pk2(v0[2], v0[3]); w.z = pk2(v1[0], v1[1]); w.w = pk2(v1[2], v1[3]);
                    *(u32x4*)(rowp + bj * HALF) = w;
                }
            }
    }
};

struct EpiGlu {
    static constexpr bool PERM = true, AFTER_DRAIN = false, HAS_MID = false;
    const bf16_t* YG; const bf16_t* P; bf16_t* YC; const float* bias;
    __device__ __forceinline__ void operator()(const f32x4 (&acc)[2][2][4][2], const Unit& u, int wr, int wc, int fr, int fq) const {
        int row0 = u.pm * BM + wr * 64 + fr; asm volatile("" : "+v"(row0)); const int col0 = u.pn * BM + wc * 32 + 8 * fq;
#pragma unroll
        for (int bj = 0; bj < 2; ++bj) {
            const int col = col0 + bj * HALF;
            const f32x4 b0 = *(const f32x4*)(bias + col), b1 = *(const f32x4*)(bias + col + 4);
#pragma unroll
            for (int ai = 0; ai < 2; ++ai)
#pragma unroll
                for (int m = 0; m < 4; ++m) {
                    const int row = row0 + ai * HALF + m * 16;
                    const u32x4 yg = *(const u32x4*)(YG + (size_t)row * 512 + col);
                    const u32x4 za = *(const u32x4*)(P + (size_t)row * DIN + C_ZA + col);
                    const f32x4 v0 = acc[ai][bj][m][0] + b0, v1 = acc[ai][bj][m][1] + b1;
                    u32x4 w;
                    w.x = pk2(bflo(yg.x) * sigmoidf_(v0[0]) * bflo(za.x), bfhi(yg.x) * sigmoidf_(v0[1]) * bfhi(za.x));
                    w.y = pk2(bflo(yg.y) * sigmoidf_(v0[2]) * bflo(za.y), bfhi(yg.y) * sigmoidf_(v0[3]) * bfhi(za.y));
                    w.z = pk2(bflo(yg.z) * sigmoidf_(v1[0]) * bflo(za.z), bfhi(yg.z) * sigmoidf_(v1[1]) * bfhi(za.z));
                    w.w = pk2(bflo(yg.w) * sigmoidf_(v1[2]) * bflo(za.w), bfhi(yg.w) * sigmoidf_(v1[3]) * bfhi(za.w));
                    *(u32x4*)(YC + (size_t)row * DM + col) = w;
                }
        }
    }
};

struct EpiMerge {
    static constexpr bool PERM = true, AFTER_DRAIN = false, HAS_MID = true;
    const bf16_t* P; bf16_t* O;
    __device__ __forceinline__ bool is_mid(int t) const { return t == 8 || t == 24; }
    __device__ __forceinline__ void mid(f32x4 (&acc)[2][2][4][2], const Unit& u, int wr, int wc, int fr, int fq, int t) const {
        const int s = (t == 8) ? 0 : 1;
        int row0 = u.pm * BM + wr * 64 + fr; asm volatile("" : "+v"(row0)); const int col0 = u.pn * BM + wc * 32 + 8 * fq;
#pragma unroll
        for (int ai = 0; ai < 2; ++ai)
#pragma unroll
            for (int m = 0; m < 4; ++m) {
                const bf16_t* gp = P + (size_t)(row0 + ai * HALF + m * 16) * DIN + C_MG + s * 2048 + col0;
#pragma unroll
                for (int bj = 0; bj < 2; ++bj) {
                    const u32x4 gn = *(const u32x4*)(gp + bj * HALF), gd = *(const u32x4*)(gp + 2048 + bj * HALF);
                    f32x4 r0, r1;
                    r0[0] = bflo(gn.x) * __builtin_amdgcn_rcpf(bflo(gd.x)); r0[1] = bfhi(gn.x) * __builtin_amdgcn_rcpf(bfhi(gd.x)); r0[2] = bflo(gn.y) * __builtin_amdgcn_rcpf(bflo(gd.y)); r0[3] = bfhi(gn.y) * __builtin_amdgcn_rcpf(bfhi(gd.y));
                    r1[0] = bflo(gn.z) * __builtin_amdgcn_rcpf(bflo(gd.z)); r1[1] = bfhi(gn.z) * __builtin_amdgcn_rcpf(bfhi(gd.z)); r1[2] = bflo(gn.w) * __builtin_amdgcn_rcpf(bflo(gd.w)); r1[3] = bfhi(gn.w) * __builtin_amdgcn_rcpf(bfhi(gd.w));
                    acc[ai][bj][m][0] *= r0; acc[ai][bj][m][1] *= r1;
                }
                asm volatile("" ::: "memory");
            }
    }
    __device__ __forceinline__ void operator()(const f32x4 (&acc)[2][2][4][2], const Unit& u, int wr, int wc, int fr, int fq) const {
        int row0 = u.pm * BM + wr * 64 + fr; asm volatile("" : "+v"(row0)); const int col0 = u.pn * BM + wc * 32 + 8 * fq;
#pragma unroll
        for (int ai = 0; ai < 2; ++ai)
#pragma unroll
            for (int m = 0; m < 4; ++m) {
                const int row = row0 + ai * HALF + m * 16;
                const bf16_t* gp = P + (size_t)row * DIN + C_MG + 2 * 2048 + col0;
#pragma unroll
                for (int bj = 0; bj < 2; ++bj) {
                    const u32x4 g = *(const u32x4*)(gp + bj * HALF);
                    const f32x4 v0 = acc[ai][bj][m][0], v1 = acc[ai][bj][m][1];
                    u32x4 w;
                    w.x = pk2(v0[0] * bflo(g.x), v0[1] * bfhi(g.x)); w.y = pk2(v0[2] * bflo(g.y), v0[3] * bfhi(g.y));
                    w.z = pk2(v1[0] * bflo(g.z), v1[1] * bfhi(g.z)); w.w = pk2(v1[2] * bflo(g.w), v1[3] * bfhi(g.w));
                    *(u32x4*)(O + (size_t)row * DM + col0 + bj * HALF) = w;
                }
            }
    }
};

struct EpiOut {
    static constexpr bool PERM = false, AFTER_DRAIN = false, HAS_MID = false;
    const float* xa; const float* xb;
    float* out; const float* gate;
    __device__ __forceinline__ void operator()(const f32x4 (&acc)[2][2][4][2], const Unit& u, int wr, int wc, int fr, int fq) const {
        int row0 = u.pm * BM + wr * 64 + fr; asm volatile("" : "+v"(row0)); const int col0 = u.pn * BM + wc * 32 + 4 * fq;
        const int cv = (u.pm < 32) ? 0 : ((u.pm < 48) ? 1 : 2);
        const float* gp = gate + (size_t)cv * 6144 + 4096 + col0;
#pragma unroll
        for (int bj = 0; bj < 2; ++bj)
#pragma unroll
            for (int n = 0; n < 2; ++n) {
                const f32x4 g = *(const f32x4*)(gp + bj * HALF + n * 16);
#pragma unroll
                for (int ai = 0; ai < 2; ++ai)
#pragma unroll
                    for (int m = 0; m < 4; ++m) {
                        const int row = row0 + ai * HALF + m * 16;
                        const float* xr = (row < MCTX) ? (xa + (size_t)row * DM) : (xb + (size_t)(row - MCTX) * DM);
                        const f32x4 x = *(const f32x4*)(xr + col0 + bj * HALF + n * 16);
                        const f32x4 o = x * DN_ALPHA + g * acc[ai][bj][m][n];
                        *(f32x4*)(out + (size_t)row * DM + col0 + bj * HALF + n * 16) = o;
                    }
            }
    }
};
template <class Epi, class Sched, bool ALIGN_EPI = false, bool SP2 = false>
__device__ __forceinline__ void gemm_phase(PG8_LAS unsigned char* lds, const Gemm g, const Sched& S, const Epi& E) {
    int tid_ = threadIdx.x; asm volatile("" : "+v"(tid_));
    const int tid = tid_, wid = __builtin_amdgcn_readfirstlane(tid >> 6), lane = tid & 63, wr = wid >> 2, wc = wid & 3, fr = lane & 15, fq = lane >> 4;
    const int K = g.K, nt = K / BK;
    unsigned voffA[2], voffB[2];
#pragma unroll
    for (int i = 0; i < 2; ++i) { int R, C; stage_rc(tid * 16 + i * 8192, R, C); const int Rb = Epi::PERM ? ((R & ~31) + perm32(R & 31)) : R;
        voffA[i] = (unsigned)(R * K + C) * 2u; voffB[i] = (unsigned)(Rb * K + C) * 2u; }
    const size_t kstep = (size_t)(BK * 2);
    const size_t hstep = (size_t)HALF * K * 2;
    const size_t tstep = 2 * hstep;
    const unsigned ldsw = (unsigned)wid * 1024u;
    const int aoff = lds_byte(wr * 64 + fr, fq * 8), boff = lds_byte(wc * 32 + fr, fq * 8);
#define PG8_SA(b, h) (((b) * 2 + (h)) * HTB)
#define PG8_SB(b, h) ((4 + (b) * 2 + (h)) * HTB)
#define PG8_STAGE(bufoff, gbase, voff) do { _Pragma("unroll") for (int _i = 0; _i < 2; ++_i) \
        __builtin_amdgcn_global_load_lds((const unsigned*)((const char*)(gbase) + (voff)[_i]), (PG8_LAS unsigned*)(lds + (bufoff) + ldsw + _i * 8192), 16, 0, 0); } while (0)
#define PG8_LDA(dst, b, h) do { _Pragma("unroll") for (int m = 0; m < 4; ++m) _Pragma("unroll") for (int k = 0; k < 2; ++k) dst[m][k] = *(const PG8_LAS bf16x8*)(lds + PG8_SA(b, h) + aoff + m * 2048 + k * 1024); } while (0)
#define PG8_LDB(dst, b, h) do { _Pragma("unroll") for (int n = 0; n < 2; ++n) _Pragma("unroll") for (int k = 0; k < 2; ++k) dst[n][k] = *(const PG8_LAS bf16x8*)(lds + PG8_SB(b, h) + boff + n * 2048 + k * 1024); } while (0)
#define PG8_MMA(ai, bj, At, Bt) do { __builtin_amdgcn_s_setprio(1); _Pragma("unroll") for (int m = 0; m < 4; ++m) _Pragma("unroll") for (int n = 0; n < 2; ++n) _Pragma("unroll") for (int k = 0; k < 2; ++k) \
        acc[ai][bj][m][n] = __builtin_amdgcn_mfma_f32_16x16x32_bf16(Bt[n][k], At[m][k], acc[ai][bj][m][n], 0, 0, 0); __builtin_amdgcn_s_setprio(0); } while (0)
#define PG8_WAIT_V(n) asm volatile("s_waitcnt vmcnt(" #n ")" ::: "memory")
#define PG8_WAIT_L(n) asm volatile("s_waitcnt lgkmcnt(" #n ")" ::: "memory")
#define PG8_BAR __builtin_amdgcn_s_barrier()
#define PG8_SCHED __builtin_amdgcn_sched_barrier(0)
    Unit cur, nxt; int ui = 0;
    if (!S.next(0, cur)) return;
    f32x4 acc[2][2][4][2];
#pragma unroll
    for (int a = 0; a < 2; ++a)
#pragma unroll
        for (int b = 0; b < 2; ++b)
#pragma unroll
            for (int m = 0; m < 4; ++m)
#pragma unroll
                for (int n = 0; n < 2; ++n) acc[a][b][m][n] = (f32x4){0.f, 0.f, 0.f, 0.f};
    bf16x8 At[4][2], B0[2][2], B1[2][2];
    const char* cA = (const char*)g.A + (size_t)cur.pm * tstep; const char* cB = (const char*)g.Bt + (size_t)cur.pn * tstep;
    S.a_ready(cur);
    if constexpr (SP2) {
        PG8_STAGE(PG8_SB(0, 0), cB, voffB); PG8_STAGE(PG8_SB(0, 1), cB + hstep, voffB); PG8_STAGE(PG8_SA(0, 0), cA, voffA); PG8_STAGE(PG8_SA(0, 1), cA + hstep, voffA);
        if (wr == 1) PG8_BAR;
        PG8_WAIT_V(2); PG8_BAR;
        PG8_STAGE(PG8_SB(1, 0), cB + kstep, voffB); PG8_STAGE(PG8_SA(1, 0), cA + kstep, voffA); PG8_STAGE(PG8_SB(1, 1), cB + hstep + kstep, voffB);
        PG8_WAIT_V(6); PG8_BAR;
    } else {
        PG8_STAGE(PG8_SB(0, 0), cB, voffB); PG8_STAGE(PG8_SA(0, 0), cA, voffA); PG8_STAGE(PG8_SB(0, 1), cB + hstep, voffB); PG8_STAGE(PG8_SA(0, 1), cA + hstep, voffA);
        if (wr == 1) PG8_BAR;
        PG8_WAIT_V(4); PG8_BAR;
        PG8_STAGE(PG8_SB(1, 0), cB + kstep, voffB); PG8_STAGE(PG8_SA(1, 0), cA + kstep, voffA); PG8_STAGE(PG8_SB(1, 1), cB + hstep + kstep, voffB);
        PG8_WAIT_V(6); PG8_BAR;
    }
    for (;;) {
        const bool has_next = S.next(ui + 1, nxt);
        const char* nA = has_next ? (const char*)g.A + (size_t)nxt.pm * tstep : cA; const char* nB = has_next ? (const char*)g.Bt + (size_t)nxt.pn * tstep : cB;
        for (int t = 0; t < nt; t += 2) {
            if constexpr (Epi::HAS_MID) { if (E.is_mid(t)) E.mid(acc, cur, wr, wc, fr, fq, t); }
            const bool last = (t == nt - 2);
            const char* a1 = cA + (size_t)(t + 1) * kstep;
            const char* a2 = last ? nA : cA + (size_t)(t + 2) * kstep; const char* b2 = last ? nB : cB + (size_t)(t + 2) * kstep;
            const char* a3 = a2 + kstep; const char* b3 = b2 + kstep;
            if (last && has_next) S.a_ready(nxt);
            if constexpr (SP2) {
            PG8_LDB(B0, 0, 0); PG8_LDB(B1, 0, 1); PG8_SCHED; PG8_LDA(At, 0, 0); PG8_STAGE(PG8_SA(1, 1), a1 + hstep, voffA);
            PG8_WAIT_V(8); PG8_WAIT_L(0); PG8_BAR; PG8_MMA(0, 0, At, B0); PG8_MMA(0, 1, At, B1); PG8_BAR; PG8_SCHED;
            PG8_LDA(At, 0, 1); PG8_STAGE(PG8_SB(0, 0), b2, voffB); PG8_STAGE(PG8_SB(0, 1), b2 + hstep, voffB); PG8_STAGE(PG8_SA(0, 0), a2, voffA);
            PG8_WAIT_V(8); PG8_WAIT_L(0); PG8_BAR; PG8_MMA(1, 0, At, B0); PG8_MMA(1, 1, At, B1); PG8_BAR; PG8_SCHED;
            PG8_LDB(B0, 1, 0); PG8_LDB(B1, 1, 1); PG8_SCHED; PG8_LDA(At, 1, 0); PG8_STAGE(PG8_SA(0, 1), a2 + hstep, voffA);
            PG8_WAIT_V(8); PG8_WAIT_L(0); PG8_BAR; PG8_MMA(0, 0, At, B0); PG8_MMA(0, 1, At, B1); PG8_BAR; PG8_SCHED;
            PG8_LDA(At, 1, 1); PG8_STAGE(PG8_SB(1, 0), b3, voffB); PG8_STAGE(PG8_SB(1, 1), b3 + hstep, voffB); PG8_STAGE(PG8_SA(1, 0), a3, voffA);
            PG8_WAIT_V(8); PG8_WAIT_L(0); PG8_BAR; PG8_MMA(1, 0, At, B0); PG8_MMA(1, 1, At, B1); PG8_BAR; PG8_SCHED;
            } else {
            PG8_LDB(B0, 0, 0); PG8_SCHED; PG8_LDA(At, 0, 0); PG8_STAGE(PG8_SA(1, 1), a1 + hstep, voffA);
            PG8_WAIT_L(8); PG8_BAR; PG8_WAIT_L(0); PG8_MMA(0, 0, At, B0); PG8_BAR; PG8_SCHED;
            PG8_LDB(B1, 0, 1); PG8_STAGE(PG8_SB(0, 0), b2, voffB);
            PG8_BAR; PG8_WAIT_L(0); PG8_MMA(0, 1, At, B1); PG8_BAR;
            PG8_LDA(At, 0, 1); PG8_STAGE(PG8_SA(0, 0), a2, voffA);
            PG8_BAR; PG8_WAIT_L(0); PG8_MMA(1, 0, At, B0); PG8_BAR; PG8_SCHED;
            PG8_STAGE(PG8_SB(0, 1), b2 + hstep, voffB);
            PG8_WAIT_V(6); PG8_BAR; PG8_MMA(1, 1, At, B1); PG8_BAR;
            PG8_LDB(B0, 1, 0); PG8_SCHED; PG8_LDA(At, 1, 0); PG8_STAGE(PG8_SA(0, 1), a2 + hstep, voffA);
            PG8_WAIT_L(8); PG8_BAR; PG8_WAIT_L(0); PG8_MMA(0, 0, At, B0); PG8_BAR; PG8_SCHED;
            PG8_LDB(B1, 1, 1); PG8_STAGE(PG8_SB(1, 0), b3, voffB);
            PG8_BAR; PG8_WAIT_L(0); PG8_MMA(0, 1, At, B1); PG8_BAR;
            PG8_LDA(At, 1, 1); PG8_STAGE(PG8_SA(1, 0), a3, voffA);
            PG8_BAR; PG8_WAIT_L(0); PG8_MMA(1, 0, At, B0); PG8_BAR; PG8_SCHED;
            PG8_STAGE(PG8_SB(1, 1), b3 + hstep, voffB);
            PG8_WAIT_V(6); PG8_BAR; PG8_MMA(1, 1, At, B1); PG8_BAR;
            }
        }
        if constexpr (ALIGN_EPI) { if (wr == 0) PG8_BAR; }
        if constexpr (!Epi::AFTER_DRAIN) { E(acc, cur, wr, wc, fr, fq); S.done(cur); }
        if (!has_next) break;
#pragma unroll
        for (int a = 0; a < 2; ++a)
#pragma unroll
            for (int b = 0; b < 2; ++b)
#pragma unroll
                for (int m = 0; m < 4; ++m)
#pragma unroll
                    for (int n = 0; n < 2; ++n) acc[a][b][m][n] = (f32x4){0.f, 0.f, 0.f, 0.f};
        cur = nxt; cA = nA; cB = nB; ++ui;
        if constexpr (ALIGN_EPI) { if (wr == 1) PG8_BAR; }
    }
    PG8_WAIT_V(0);
    if constexpr (!ALIGN_EPI) { if (wr == 0) PG8_BAR; }
    PG8_BAR;
    if constexpr (Epi::AFTER_DRAIN) { E.fused(acc, cur, wr, wc, fr, fq, lds, wid, lane); S.done(cur); }
#undef PG8_SA
#undef PG8_SB
#undef PG8_STAGE
#undef PG8_LDA
#undef PG8_LDB
#undef PG8_MMA
#undef PG8_WAIT_V
#undef PG8_WAIT_L
#undef PG8_BAR
#undef PG8_SCHED
}
}

typedef GAS unsigned gu32;
struct Args { const float* in[31]; float* out; unsigned char* ws; int ph_lo, ph_hi; };
typedef const __attribute__((address_space(4))) Args* KArgs;
struct Frame {
    LAS unsigned char* lds;
    volatile LAS unsigned* MISC;
    unsigned* ctl;
    int tid, lane, wave, G, bid;
    unsigned char* ws;
    float* out;
    KArgs ka;
    __device__ __forceinline__ const float* in(int k) const { return ka->in[k]; }
};
#define WSP(T, off) ((T*)(F.ws + (off)))

__device__ __forceinline__ int wq_next(Frame& F, int phase) {
    __syncthreads();
    if (F.tid == 0) F.MISC[16] = __hip_atomic_fetch_add(F.ctl + CW_WQ + 64 * phase, 1u, __ATOMIC_RELAXED, __HIP_MEMORY_SCOPE_AGENT);
    __syncthreads();
    return (int)F.MISC[16];
}

__device__ __forceinline__ void p0_gemv_tile(Frame& F, int idx) {
    const int l = idx / 768, rem = idx % 768, kc = rem / 24, nc = rem % 24, lane = F.lane;
    const int k = kc * 64 + lane;
    const float s0 = siluf_(F.in(6  )[k]), s1 = siluf_(F.in(5  )[k]), s2 = siluf_(F.in(5  )[2048 + k]);
    const float* W = F.in(7  ) + ((size_t)l * 2048 + kc * 64) * 6144 + nc * 256 + lane * 4;
    f32x4 a0 = {0.f, 0.f, 0.f, 0.f}, a1 = a0, a2 = a0;
#pragma unroll 16
    for (int r = 0; r < 64; ++r) {
        const f32x4 wv = *(const f32x4*)(W + (size_t)r * 6144);
        const float t0 = __shfl(s0, r), t1 = __shfl(s1, r), t2 = __shfl(s2, r);
        a0 += wv * t0; a1 += wv * t1; a2 += wv * t2;
    }
    float* o = WSP(float, WS_MODP) + ((size_t)(l * 32 + kc) * 3) * 6144 + nc * 256 + lane * 4;
    *(f32x4*)o = a0; *(f32x4*)(o + 6144) = a1; *(f32x4*)(o + 2 * 6144) = a2;
}
__device__ __forceinline__ int sigma_col(int n) {
    if (n < C_Q || n >= C_V) return n;
    const int hb = n & ~127, c = n & 127, p = c >> 1, e = c & 1;
    return hb + ((p < 32) ? p : p + 32) + 32 * e;
}
__device__ __forceinline__ void p0_transpose_item(const float* W, int N, bf16* WT, int Kd, int koff, bool perm, LAS float* scr, int item, int lane) {
    const int nblk = N / 32, kb = item / nblk, nb = item % nblk, k0 = 64 * kb, n0 = 32 * nb;
    const int ncol = perm ? sigma_col(n0 + (lane & 31)) : (n0 + (lane & 31));
#pragma unroll 8
    for (int i = 0; i < 32; ++i) { const int kk = 2 * i + (lane >> 5); scr[kk * 33 + (lane & 31)] = W[(size_t)(k0 + kk) * N + ncol]; }
    LDS_WAIT(); asm volatile("" ::: "memory");
    const int c = lane & 7;
#pragma unroll
    for (int j = 0; j < 4; ++j) { const int n = (lane >> 3) + 8 * j; const LAS float* s = scr + (8 * c) * 33 + n;
        u32x4 o; o.x = pk2(s[0 * 33], s[1 * 33]); o.y = pk2(s[2 * 33], s[3 * 33]); o.z = pk2(s[4 * 33], s[5 * 33]); o.w = pk2(s[6 * 33], s[7 * 33]);
        *(u32x4*)(WT + (size_t)(n0 + n) * Kd + koff + k0 + 8 * c) = o; }
    LDS_WAIT(); asm volatile("" ::: "memory");
}
__device__ __forceinline__ void p0_ssm_tables(Frame& F, int item) {
    const int l = item >> 5, g = item & 31, tid = F.tid;
    LAS float* apow = (LAS float*)F.lds;
    LAS float* Bb = apow + 2 * 33 * 64 * 2;
    LAS float* Cc = Bb + 2 * 64 * 16 * 2;
    __syncthreads();
    for (int idx = tid; idx < 2 * 33 * 64; idx += NT) {
        const int d = idx / (33 * 64), j = (idx / 64) % 33, p = idx & 63;
        const int pi = ((l * 2 + d) * 32 + g) * 64 + p;
        const double lr = (double)F.in(10  )[pi], li = (double)F.in(11  )[pi], dt = exp((double)F.in(12  )[(l * 2 + d) * 32 + g]);
        const double mag = exp(lr * dt * (double)j); double sn, cs; sincos(li * dt * (double)j, &sn, &cs);
        apow[idx * 2] = (float)(mag * cs); apow[idx * 2 + 1] = (float)(mag * sn);
        if (j == TCH) { float* at = WSP(float, WS_AT) + (size_t)((l * 32 + g) * 2 + d) * 128; at[p] = (float)(mag * cs); at[64 + p] = (float)(mag * sn); }
    }
    for (int idx = tid; idx < 2 * 64 * 16; idx += NT) {
        const int d = idx / 1024, p = (idx >> 4) & 63, cc = idx & 15;
        const int pi = ((l * 2 + d) * 32 + g) * 64 + p;
        const double lr = (double)F.in(10  )[pi], li = (double)F.in(11  )[pi], dt = exp((double)F.in(12  )[(l * 2 + d) * 32 + g]);
        const double mag = exp(lr * dt); double sn, cs; sincos(li * dt, &sn, &cs);
        const double are = mag * cs, aim = mag * sn, nr = are - 1.0, den = lr * lr + li * li;
        const double fre = (nr * lr + aim * li) / den, fim = (aim * lr - nr * li) / den;
        const double br = (double)F.in(13  )[(size_t)pi * 16 + cc], bi = (double)F.in(14  )[(size_t)pi * 16 + cc];
        Bb[idx * 2] = (float)(fre * br - fim * bi); Bb[idx * 2 + 1] = (float)(fre * bi + fim * br);
        const int ci = (((l * 2 + d) * 32 + g) * 16 + cc) * 64 + p;
        const int co = (d * 16 + cc) * 64 + p;
        Cc[co * 2] = F.in(15  )[ci]; Cc[co * 2 + 1] = F.in(16  )[ci];
    }
    __syncthreads();
    bf16* lagt = WSP(bf16, WS_LAG) + (size_t)(l * 32 + g) * 16384;
    for (int idx = tid; idx < 63 * 256; idx += NT) {
        const int L = idx >> 8, delta = L - 31, cc = (idx >> 4) & 15, c2 = idx & 15;
        float v = 0.f;
        if (delta >= 0) { const int j = delta;
            for (int p = 0; p < 64; ++p) { const float ar = apow[((0 * 33 + j) * 64 + p) * 2], ai = apow[((0 * 33 + j) * 64 + p) * 2 + 1];
                const float br = Bb[((0 * 64 + p) * 16 + c2) * 2], bi = Bb[((0 * 64 + p) * 16 + c2) * 2 + 1];
                const float zr = ar * br - ai * bi, zi = ar * bi + ai * br;
                v += Cc[((0 * 16 + cc) * 64 + p) * 2] * zr - Cc[((0 * 16 + cc) * 64 + p) * 2 + 1] * zi; } }
        if (delta <= 0) { const int j = -delta;
            for (int p = 0; p < 64; ++p) { const float ar = apow[((1 * 33 + j) * 64 + p) * 2], ai = apow[((1 * 33 + j) * 64 + p) * 2 + 1];
                const float br = Bb[((1 * 64 + p) * 16 + c2) * 2], bi = Bb[((1 * 64 + p) * 16 + c2) * 2 + 1];
                const float zr = ar * br - ai * bi, zi = ar * bi + ai * br;
                v += Cc[((1 * 16 + cc) * 64 + p) * 2] * zr - Cc[((1 * 16 + cc) * 64 + p) * 2 + 1] * zi; } }
        if (delta == 0 && cc == c2) v += F.in(17  )[l * 512 + g * 16 + cc];
        lagt[idx] = (bf16)f2bf(v);
    }
    bf16* wf = WSP(bf16, WS_WF) + (size_t)(l * 32 + g) * 131072;
    for (int idx = tid; idx < 256 * 512; idx += NT) {
        const int row = idx >> 9, col = idx & 511, d = row >> 7, ri = (row >> 6) & 1, p = row & 63, j = col >> 4, c2 = col & 15;
        const int pw = (d == 0) ? (TCH - 1 - j) : j;
        const float ar = apow[((d * 33 + pw) * 64 + p) * 2], ai = apow[((d * 33 + pw) * 64 + p) * 2 + 1];
        const float br = Bb[((d * 64 + p) * 16 + c2) * 2], bi = Bb[((d * 64 + p) * 16 + c2) * 2 + 1];
        wf[idx] = (bf16)f2bf(ri ? (ar * bi + ai * br) : (ar * br - ai * bi));
    }
    bf16* wy = WSP(bf16, WS_WY) + (size_t)(l * 32 + g) * 131072;
    for (int idx = tid; idx < 512 * 256; idx += NT) {
        const int row = idx >> 8, col = idx & 255, i = row >> 4, cc = row & 15, d = col >> 7, ri = (col >> 6) & 1, p = col & 63;
        const int pw = (d == 0) ? (i + 1) : (TCH - i);
        const float ar = apow[((d * 33 + pw) * 64 + p) * 2], ai = apow[((d * 33 + pw) * 64 + p) * 2 + 1];
        const float cr = Cc[((d * 16 + cc) * 64 + p) * 2], ci = Cc[((d * 16 + cc) * 64 + p) * 2 + 1];
        wy[idx] = (bf16)f2bf(ri ? -(cr * ai + ci * ar) : (cr * ar - ci * ai));
    }
    __syncthreads();
}
__device__ __forceinline__ void p0_prologue(Frame& F) {
    const int gw = F.bid * NW + F.wave, NGW = F.G * NW;
    for (int it = gw; it < 1536; it += NGW) p0_gemv_tile(F, it);
    for (int it = F.G - 1 - F.bid; it < 64; it += F.G) p0_ssm_tables(F, it);
    LAS float* scr = (LAS float*)(F.lds + F.wave * 16384);
    constexpr int I_IN = 32 * 352, I_PA = 8 * 64, I_PB = 16 * 64, I_PC = 8 * 64, I_OUT = 32 * 64, I_GLU = 8 * 16;
    constexpr int I_L = I_IN + I_PA + I_PB + I_PC + I_OUT + I_GLU;
    for (int it = gw; it < 2 * I_L; it += NGW) {
        const int l = it / I_L; int r = it % I_L;
        if (r < I_IN) { p0_transpose_item(F.in(9  ) + (size_t)l * 2048 * DIN, DIN, WSP(bf16, WS_WIN) + (size_t)l * DIN * 2048, 2048, 0, true, scr, r, F.lane); continue; } r -= I_IN;
        if (r < I_PA) { p0_transpose_item(F.in(25  ) + (size_t)l * 512 * 2048, 2048, WSP(bf16, WS_WP) + (size_t)l * 2048 * 2048, 2048, 0, false, scr, r, F.lane); continue; } r -= I_PA;
        if (r < I_PB) { p0_transpose_item(F.in(26  ) + (size_t)l * 1024 * 2048, 2048, WSP(bf16, WS_WP) + (size_t)l * 2048 * 2048, 2048, 512, false, scr, r, F.lane); continue; } r -= I_PB;
        if (r < I_PC) { p0_transpose_item(F.in(27  ) + (size_t)l * 512 * 2048, 2048, WSP(bf16, WS_WP) + (size_t)l * 2048 * 2048, 2048, 1536, false, scr, r, F.lane); continue; } r -= I_PC;
        if (r < I_OUT) { p0_transpose_item(F.in(28  ) + (size_t)l * 2048 * 2048, 2048, WSP(bf16, WS_WOUT) + (size_t)l * 2048 * 2048, 2048, 0, false, scr, r, F.lane); continue; } r -= I_OUT;
        p0_transpose_item(F.in(18  ) + (size_t)l * 512 * 512, 512, WSP(bf16, WS_WGLU) + (size_t)l * 512 * 512, 512, 0, false, scr, r, F.lane);
    }
    const int gt = F.bid * NT + F.tid, NGT = F.G * NT;
    for (int i = gt; i < 2 * 2 * 256 * 256; i += NGT) {
        const int col = i & 255, rowi = i >> 8;
        const int hb = col & 128, cc = col & 127, p = cc >> 1, e = cc & 1, src = hb + ((p < 32) ? p : p + 32) + 32 * e;
        WSP(bf16, WS_CK)[i] = (bf16)f2bf(F.in(2  )[(size_t)rowi * 256 + src]);
        WSP(bf16, WS_CV)[i] = (bf16)f2bf(F.in(3  )[i]);
    }
    for (int i = gt; i < 2 * 4 * 128 * 128; i += NGT) WSP(bf16, WS_WS)[i] = (bf16)f2bf(F.in(23  )[i]);
    for (int i = gt; i < 64 * 32; i += NGT) {
        const int pos = i >> 5, j = i & 31;
        const double inv = pow(10000.0, -(double)(2 * j) / 64.0); double sn, cs; sincos((double)pos * inv, &sn, &cs);
        WSP(float, WS_ROPE)[i * 2] = (float)cs; WSP(float, WS_ROPE)[i * 2 + 1] = (float)sn;
    }
}

__device__ __forceinline__ void ln_row(const float* xrow, f32x4 (&v)[8], int lane) {
    const f32x4* xr = (const f32x4*)xrow + lane; float s = 0.f;
#pragma unroll
    for (int j = 0; j < 8; ++j) { v[j] = xr[64 * j]; s += (v[j].x + v[j].y) + (v[j].z + v[j].w); }
    const float mean = wave_sum(s) * (1.f / DM); float s2 = 0.f;
#pragma unroll
    for (int j = 0; j < 8; ++j) { v[j] = v[j] - mean; s2 += (v[j].x * v[j].x + v[j].y * v[j].y) + (v[j].z * v[j].z + v[j].w * v[j].w); }
    const float rstd = 1.f / sqrtf(wave_sum(s2) * (1.f / DM) + LN_EPS);
#pragma unroll
    for (int j = 0; j < 8; ++j) v[j] = v[j] * rstd;
}
__device__ __forceinline__ void ln_renorm(f32x4 (&v)[8]) {
    float s = 0.f;
#pragma unroll
    for (int j = 0; j < 8; ++j) s += (v[j].x + v[j].y) + (v[j].z + v[j].w);
    const float mean = wave_sum(s) * (1.f / DM); float s2 = 0.f;
#pragma unroll
    for (int j = 0; j < 8; ++j) { v[j] = v[j] - mean; s2 += (v[j].x * v[j].x + v[j].y * v[j].y) + (v[j].z * v[j].z + v[j].w * v[j].w); }
    const float rstd = 1.f / sqrtf(wave_sum(s2) * (1.f / DM) + LN_EPS);
#pragma unroll
    for (int j = 0; j < 8; ++j) v[j] = v[j] * rstd;
}
__device__ __forceinline__ void store_h_row(bf16* hrow, const f32x4 (&v)[8], const LAS float* sc1p, const LAS float* sh, int lane) {
#pragma unroll
    for (int j = 0; j < 8; ++j) { const int c = lane * 4 + 256 * j;
        const f32x4 a = *(const LAS f32x4*)(sc1p + c), b = *(const LAS f32x4*)(sh + c);
        const f32x4 o = v[j] * a + b; u32x2 w; w.x = pk2(o.x, o.y); w.y = pk2(o.z, o.w);
        *(u32x2*)(hrow + c) = w; }
}
__device__ __forceinline__ void p1_lnmod(Frame& F) {
    const float* modp = WSP(float, WS_MODP); float* mod = WSP(float, WS_MOD);
    if (F.tid < 144) { const int idx = F.bid * 144 + F.tid; if (idx < 36864) { const int l = idx / 18432, r = idx % 18432, cv = r / 6144, n = r % 6144; float s = F.in(8  )[l * 6144 + n];
        for (int kc = 0; kc < 32; ++kc) s += modp[((size_t)(l * 32 + kc) * 3 + cv) * 6144 + n]; mod[idx] = s; } }
    const int row0 = F.bid * 64, cv = (row0 < MCTX) ? 0 : 1 + ((row0 - MCTX) >> 12);
    LAS float* sc1p = (LAS float*)F.lds; LAS float* sh = sc1p + 2048;
    for (int n = F.tid; n < 4096; n += NT) { float s = F.in(8  )[n];
        for (int kc = 0; kc < 32; ++kc) s += modp[((size_t)(0 * 32 + kc) * 3 + cv) * 6144 + n];
        if (n < 2048) sh[n] = s; else sc1p[n - 2048] = 1.0f + s; }
    __syncthreads();
    bf16* H = WSP(bf16, WS_H);
    for (int i = 0; i < 8; ++i) { const int row = row0 + F.wave * 8 + i;
        const float* xr = (row < MCTX) ? (F.in(0  ) + (size_t)row * DM) : (F.in(1  ) + (size_t)(row - MCTX) * DM);
        f32x4 v[8]; ln_row(xr, v, F.lane); store_h_row(H + (size_t)row * DM, v, sc1p, sh, F.lane); }
    __syncthreads();
}
__device__ __forceinline__ void pg_postln(Frame& F, int l) {
    const float* mod = WSP(float, WS_MOD);
    const int row0 = F.bid * 64, cv = (row0 < MCTX) ? 0 : 1 + ((row0 - MCTX) >> 12);
    LAS float* sc1p = (LAS float*)F.lds; LAS float* sh = sc1p + 2048; LAS float* lg = sh + 2048; LAS float* lb = lg + 2048;
    __syncthreads();
    for (int n = F.tid; n < 2048; n += NT) { lg[n] = F.in(29  )[l * 2048 + n]; lb[n] = F.in(30  )[l * 2048 + n];
        if (l == 0) { sh[n] = mod[(size_t)(1 * 3 + cv) * 6144 + n]; sc1p[n] = 1.0f + mod[(size_t)(1 * 3 + cv) * 6144 + 2048 + n]; } }
    __syncthreads();
    bf16* H = WSP(bf16, WS_H);
    for (int i = 0; i < 8; ++i) { const int row = row0 + F.wave * 8 + i;
        float* orow = F.out + (size_t)row * DM;
        f32x4 v[8]; ln_row(orow, v, F.lane);
#pragma unroll
        for (int j = 0; j < 8; ++j) { const int c = F.lane * 4 + 256 * j; v[j] = v[j] * *(const LAS f32x4*)(lg + c) + *(const LAS f32x4*)(lb + c); *(f32x4*)(orow + c) = v[j]; }
        if (l == 0) { ln_renorm(v); store_h_row(H + (size_t)row * DM, v, sc1p, sh, F.lane); } }
    __syncthreads();
}

__device__ __forceinline__ int crow(int r, int hi) { return (r & 3) + 8 * (r >> 2) + 4 * hi; }
constexpr int AK_PITCH = 272, AV_PITCH = 320, ATT_K_OFF = 0, ATT_V_OFF = 64 * AK_PITCH;
__device__ __forceinline__ s16x4 vtr(const LAS unsigned char* p) { typedef short v4i16_t __attribute__((ext_vector_type(4))); return __builtin_bit_cast(s16x4, __builtin_amdgcn_ds_read_tr16_b64_v4i16((LAS v4i16_t*)p)); }

__device__ __forceinline__ void attn_unit(Frame& F, int l, int kind, int b, int h, int qb) {
    const int lane = F.lane, w = F.wave, r32 = lane & 31, hi = lane >> 5, tid = F.tid;
    const bf16* P = WSP(bf16, WS_P);
    const int kvh = h >> 2;
    const int seq0 = kind ? (MCTX + b * 4096) : (b * 256);
    const int t0 = kind ? qb * 256 : 0;
    const int tq = t0 + 32 * w + r32;
    const size_t qrow = (size_t)(seq0 + tq);
    int tlo = 0, nloc = 4;
    if (kind) { const int lo = (t0 - 128) < 0 ? 0 : (t0 - 128), hi_ = (t0 + 384) > 4096 ? 4096 : (t0 + 384); tlo = lo >> 6; nloc = (hi_ >> 6) - tlo; }
    const int ntile = nloc + (kind ? 4 : 0);
    bf16x8 qf[8];
    { const bf16* qp = P + qrow * DIN + C_Q + h * 128 + hi * 8;
#pragma unroll
      for (int ks = 0; ks < 8; ++ks) qf[ks] = *(const bf16x8*)(qp + 16 * ks); }
    float mrun = F.in(20  )[l * 8 + h] * LOG2E, lrun = (hi == 0) ? 1.0f : 0.0f;
    f32x16 o[4];
#pragma unroll
    for (int i = 0; i < 4; ++i)
#pragma unroll
        for (int r = 0; r < 16; ++r) o[i][r] = 0.f;
    LAS unsigned char* ldsK = F.lds + ATT_K_OFF; LAS unsigned char* ldsV = F.lds + ATT_V_OFF;
    u32x4 kr[2], vr[2];
    const bf16* CK = WSP(bf16, WS_CK) + (size_t)((b * 2 + l) * 256) * 256 + kvh * 128;
    const bf16* CV = WSP(bf16, WS_CV) + (size_t)((b * 2 + l) * 256) * 256 + kvh * 128;
#define ATT_LOAD(i) do { \
        _Pragma("unroll") for (int q_ = 0; q_ < 2; ++q_) { const int c_ = tid + 512 * q_, kv_ = c_ >> 4, dch_ = c_ & 15; \
            if ((i) < nloc) { const bf16* src_ = P + (size_t)(seq0 + (tlo + (i)) * 64 + kv_) * DIN + kvh * 128 + dch_ * 8; kr[q_] = *(const u32x4*)(src_ + C_K); vr[q_] = *(const u32x4*)(src_ + C_V); } \
            else { const size_t off_ = (size_t)(((i) - nloc) * 64 + kv_) * 256 + dch_ * 8; kr[q_] = *(const u32x4*)(CK + off_); vr[q_] = *(const u32x4*)(CV + off_); } } } while (0)
    ATT_LOAD(0);
    for (int i = 0; i < ntile; ++i) {
        __syncthreads();
#pragma unroll
        for (int q_ = 0; q_ < 2; ++q_) { const int c_ = tid + 512 * q_, kv_ = c_ >> 4, dch_ = c_ & 15;
            *(LAS u32x4*)(ldsK + kv_ * AK_PITCH + dch_ * 16) = kr[q_]; *(LAS u32x4*)(ldsV + kv_ * AV_PITCH + dch_ * 16) = vr[q_]; }
        __syncthreads();
        if (i + 1 < ntile) ATT_LOAD(i + 1);
        const bool local = kind && (i < nloc);
        const int k0 = (tlo + i) * 64;
        bool need = true;
        if (local) { const int wq0 = t0 + 32 * w; need = (k0 + 63 >= wq0 - 128) && (k0 <= wq0 + 31 + 128); }
        if (need) {
            f32x16 s0, s1;
#pragma unroll
            for (int r = 0; r < 16; ++r) { s0[r] = 0.f; s1[r] = 0.f; }
#pragma unroll
            for (int ks = 0; ks < 8; ++ks) {
                const bf16x8 a0 = *(const LAS bf16x8*)(ldsK + r32 * AK_PITCH + ks * 32 + hi * 16);
                const bf16x8 a1 = *(const LAS bf16x8*)(ldsK + (32 + r32) * AK_PITCH + ks * 32 + hi * 16);
                s0 = __builtin_amdgcn_mfma_f32_32x32x16_bf16(a0, qf[ks], s0, 0, 0, 0);
                s1 = __builtin_amdgcn_mfma_f32_32x32x16_bf16(a1, qf[ks], s1, 0, 0, 0);
            }
            if (local) {
#pragma unroll
                for (int r = 0; r < 16; ++r) { const int kp = k0 + crow(r, hi); int d0 = kp - tq; d0 = d0 < 0 ? -d0 : d0; int d1 = kp + 32 - tq; d1 = d1 < 0 ? -d1 : d1;
                    if (d0 > 128) s0[r] = -INFINITY; if (d1 > 128) s1[r] = -INFINITY; }
            }
            float mx = fmaxf(s0[0], s1[0]);
#pragma unroll
            for (int r = 1; r < 16; ++r) mx = fmaxf(mx, fmaxf(s0[r], s1[r]));
            mx = fmaxf(mx, __shfl_xor(mx, 32));
            const float mnew = fmaxf(mrun, mx), alpha = __builtin_amdgcn_exp2f(mrun - mnew);
            mrun = mnew; lrun *= alpha;
#pragma unroll
            for (int i2 = 0; i2 < 4; ++i2)
#pragma unroll
                for (int r = 0; r < 16; ++r) o[i2][r] *= alpha;
            float ls = 0.f;
#pragma unroll
            for (int r = 0; r < 16; ++r) { s0[r] = __builtin_amdgcn_exp2f(s0[r] - mnew); s1[r] = __builtin_amdgcn_exp2f(s1[r] - mnew); ls += s0[r] + s1[r]; }
            lrun += ls;
            bf16x8 pb[4];
            { u32x4 t;
              t.x = pk2(s0[0], s0[1]); t.y = pk2(s0[2], s0[3]); t.z = pk2(s0[4], s0[5]); t.w = pk2(s0[6], s0[7]); pb[0] = __builtin_bit_cast(bf16x8, t);
              t.x = pk2(s0[8], s0[9]); t.y = pk2(s0[10], s0[11]); t.z = pk2(s0[12], s0[13]); t.w = pk2(s0[14], s0[15]); pb[1] = __builtin_bit_cast(bf16x8, t);
              t.x = pk2(s1[0], s1[1]); t.y = pk2(s1[2], s1[3]); t.z = pk2(s1[4], s1[5]); t.w = pk2(s1[6], s1[7]); pb[2] = __builtin_bit_cast(bf16x8, t);
              t.x = pk2(s1[8], s1[9]); t.y = pk2(s1[10], s1[11]); t.z = pk2(s1[12], s1[13]); t.w = pk2(s1[14], s1[15]); pb[3] = __builtin_bit_cast(bf16x8, t); }
            const LAS unsigned char* vb = ldsV + (4 * hi + ((lane & 15) >> 2)) * AV_PITCH + ((lane >> 4) & 1) * 32 + (lane & 3) * 8;
#pragma unroll
            for (int s = 0; s < 4; ++s)
#pragma unroll
                for (int db = 0; db < 4; ++db) {
                    const s16x4 lo = vtr(vb + (16 * s) * AV_PITCH + db * 64), hh = vtr(vb + (16 * s + 8) * AV_PITCH + db * 64);
                    const bf16x8 a = {lo[0], lo[1], lo[2], lo[3], hh[0], hh[1], hh[2], hh[3]};
                    o[db] = __builtin_amdgcn_mfma_f32_32x32x16_bf16(a, pb[s], o[db], 0, 0, 0);
                }
        }
    }
#undef ATT_LOAD
    const float ltot = lrun + __shfl_xor(lrun, 32), inv = 1.0f / ltot;
    bf16* YC = WSP(bf16, WS_H) + qrow * DM + 512 + h * 128;
    const bf16* zb = P + qrow * DIN + C_ZB + h * 128;
#pragma unroll
    for (int db = 0; db < 4; ++db)
#pragma unroll
        for (int rg = 0; rg < 4; ++rg) { const int d = 32 * db + 8 * rg + 4 * hi;
            const u32x2 z = *(const u32x2*)(zb + d);
            u32x2 wv; wv.x = pk2(o[db][4 * rg] * inv * bflo(z.x), o[db][4 * rg + 1] * inv * bfhi(z.x)); wv.y = pk2(o[db][4 * rg + 2] * inv * bflo(z.y), o[db][4 * rg + 3] * inv * bfhi(z.y));
            *(u32x2*)(YC + d) = wv; }
}

__device__ __forceinline__ void ssm_stage_u(Frame& F, int g, int rowbase) {
    const bf16* P = WSP(bf16, WS_P);
#pragma unroll
    for (int q = 0; q < 8; ++q) { const int c = F.tid + 512 * q, hh = c & 1, tok = c >> 1, n = tok >> 5, j = tok & 31;
        const u32x4 v = *(const u32x4*)(P + (size_t)(rowbase + tok) * DIN + C_XA + g * 16 + hh * 8);
        *(LAS u32x4*)(F.lds + ((j * 64 + n) * 32 + hh * 16)) = v; }
}
__device__ __forceinline__ void ssm_unit(Frame& F, int l, int g, int tb) {
    const int lane = F.lane, w = F.wave, r32 = lane & 31, hi = lane >> 5, tid = F.tid;
    const int unit = g * 4 + tb;
    const int rowblk = tb * 4096;
    const bool ctx = tb < 2;
    const int nchunk = ctx ? 8 : 128;
    float* Fb = WSP(float, WS_F) + (size_t)unit * 128 * 256;
    bf16* Sb = WSP(bf16, WS_SIN) + (size_t)unit * 128 * 256;
    const bf16* WF = WSP(bf16, WS_WF) + (size_t)(l * 32 + g) * 131072;
    const bf16* WY = WSP(bf16, WS_WY) + (size_t)(l * 32 + g) * 131072;
    LAS unsigned char* ldsU = F.lds;
    LAS unsigned char* ldsL = F.lds + 65536;
    __syncthreads();
    { const u32x4* src = (const u32x4*)(WSP(bf16, WS_LAG) + (size_t)(l * 32 + g) * 16384);
      for (int i = tid; i < 63 * 32; i += NT) *(LAS u32x4*)(ldsL + i * 16) = src[i]; }
    for (int half = 0; half < 2; ++half) {
        __syncthreads();
        ssm_stage_u(F, g, rowblk + half * 2048);
        __syncthreads();
        f32x16 acc[2];
#pragma unroll
        for (int r = 0; r < 16; ++r) { acc[0][r] = 0.f; acc[1][r] = 0.f; }
        const bf16* wfr = WF + (size_t)(32 * w + r32) * 512 + hi * 8;
#pragma unroll 8
        for (int j = 0; j < 32; ++j) {
            const bf16x8 a = *(const bf16x8*)(wfr + 16 * j);
            const bf16x8 b0 = *(const LAS bf16x8*)(ldsU + (j * 64 + r32) * 32 + hi * 16), b1 = *(const LAS bf16x8*)(ldsU + (j * 64 + 32 + r32) * 32 + hi * 16);
            acc[0] = __builtin_amdgcn_mfma_f32_32x32x16_bf16(a, b0, acc[0], 0, 0, 0);
            acc[1] = __builtin_amdgcn_mfma_f32_32x32x16_bf16(a, b1, acc[1], 0, 0, 0);
        }
#pragma unroll
        for (int ib = 0; ib < 2; ++ib)
#pragma unroll
            for (int rg = 0; rg < 4; ++rg) { float* o = Fb + (size_t)(half * 64 + ib * 32 + r32) * 256 + 32 * w + 8 * rg + 4 * hi;
                *(f32x4*)o = (f32x4){acc[ib][4 * rg], acc[ib][4 * rg + 1], acc[ib][4 * rg + 2], acc[ib][4 * rg + 3]}; }
    }
    __syncthreads();
    { const int nseq = ctx ? 16 : 1;
      const float* at = WSP(float, WS_AT) + (size_t)((l * 32 + g) * 2) * 128;
      for (int it = tid; it < nseq * 128; it += NT) {
          const int sq = it >> 7, d = (it >> 6) & 1, p = it & 63;
          const float ar = at[d * 128 + p], ai = at[d * 128 + 64 + p];
          float sr = 0.f, si = 0.f;
          if (!ctx) { const float* s0 = F.in(4  ) + (size_t)((((tb - 2) * 2 + l) * 2 + d) * 2) * 2048 + g * 64 + p; sr = s0[0]; si = s0[2048]; }
          for (int cI = 0; cI < nchunk; ++cI) {
              const int cc = d ? (nchunk - 1 - cI) : cI, n = sq * nchunk + cc;
              bf16* so = Sb + (size_t)n * 256 + d * 128 + p; so[0] = (bf16)f2bf(sr); so[64] = (bf16)f2bf(si);
              const float* f = Fb + (size_t)n * 256 + d * 128 + p; const float fr_ = f[0], fi_ = f[64];
              const float nr = ar * sr - ai * si + fr_, ni = ar * si + ai * sr + fi_; sr = nr; si = ni;
          }
          if (ctx) { const int bb = tb * 16 + sq; float* o = F.out + (size_t)M * DM + 2 * (size_t)(32 * 2 * 256 * 256) + (size_t)((((bb * 2 + l) * 2 + d) * 2) * 2048) + g * 64 + p; o[0] = sr; o[2048] = si; }
      } }
    bf16* YG = WSP(bf16, WS_YG);
    for (int half = 0; half < 2; ++half) {
        __syncthreads();
        ssm_stage_u(F, g, rowblk + half * 2048);
        __syncthreads();
        f32x16 acc[2][2];
#pragma unroll
        for (int a_ = 0; a_ < 2; ++a_)
#pragma unroll
            for (int b_ = 0; b_ < 2; ++b_)
#pragma unroll
                for (int r = 0; r < 16; ++r) acc[a_][b_][r] = 0.f;
        const LAS unsigned char* lagp = ldsL + (r32 & 15) * 32 + hi * 16;
#pragma unroll 4
        for (int j = 0; j < 32; ++j) {
            const bf16x8 b0 = *(const LAS bf16x8*)(ldsU + (j * 64 + r32) * 32 + hi * 16), b1 = *(const LAS bf16x8*)(ldsU + (j * 64 + 32 + r32) * 32 + hi * 16);
#pragma unroll
            for (int rr = 0; rr < 2; ++rr) { const int i = 2 * (2 * w + rr) + (r32 >> 4);
                const bf16x8 a = *(const LAS bf16x8*)(lagp + (i - j + 31) * 512);
                acc[rr][0] = __builtin_amdgcn_mfma_f32_32x32x16_bf16(a, b0, acc[rr][0], 0, 0, 0);
                acc[rr][1] = __builtin_amdgcn_mfma_f32_32x32x16_bf16(a, b1, acc[rr][1], 0, 0, 0); }
        }
#pragma unroll 4
        for (int ks = 0; ks < 16; ++ks) {
            const bf16x8 b0 = *(const bf16x8*)(Sb + (size_t)(half * 64 + r32) * 256 + 16 * ks + hi * 8), b1 = *(const bf16x8*)(Sb + (size_t)(half * 64 + 32 + r32) * 256 + 16 * ks + hi * 8);
#pragma unroll
            for (int rr = 0; rr < 2; ++rr) {
                const bf16x8 a = *(const bf16x8*)(WY + (size_t)(32 * (2 * w + rr) + r32) * 256 + 16 * ks + hi * 8);
                acc[rr][0] = __builtin_amdgcn_mfma_f32_32x32x16_bf16(a, b0, acc[rr][0], 0, 0, 0);
                acc[rr][1] = __builtin_amdgcn_mfma_f32_32x32x16_bf16(a, b1, acc[rr][1], 0, 0, 0); }
        }
#pragma unroll
        for (int rr = 0; rr < 2; ++rr)
#pragma unroll
            for (int ib = 0; ib < 2; ++ib)
#pragma unroll
                for (int rg = 0; rg < 4; ++rg) { const int i = 2 * (2 * w + rr) + (rg >> 1), c = 8 * (rg & 1) + 4 * hi, n = ib * 32 + r32;
                    const size_t row = (size_t)(rowblk + half * 2048 + n * 32 + i);
                    u32x2 wv; wv.x = pk2(geluf_(acc[rr][ib][4 * rg]), geluf_(acc[rr][ib][4 * rg + 1])); wv.y = pk2(geluf_(acc[rr][ib][4 * rg + 2]), geluf_(acc[rr][ib][4 * rg + 3]));
                    *(u32x2*)(YG + row * 512 + g * 16 + c) = wv; }
    }
}

constexpr int SG_PITCH = 272;
__device__ __forceinline__ void sgu_unit(Frame& F, int l, int ck, int g) {
    const int lane = F.lane, w = F.wave, r32 = lane & 31, hi = lane >> 5, tid = F.tid;
    const bf16* P = WSP(bf16, WS_P);
    const int row0 = ck * 128;
    LAS unsigned char* vnt = F.lds;
    __syncthreads();
    {
      const int q = tid >> 2, qq = tid & 3;
      const bf16* vrow = P + (size_t)(row0 + q) * DIN + C_VS + qq * 32;
      u32x4 mine[4]; float s = 0.f, s2 = 0.f;
#pragma unroll
      for (int gg = 0; gg < 4; ++gg)
#pragma unroll
          for (int k = 0; k < 4; ++k) { const u32x4 v = *(const u32x4*)(vrow + gg * 128 + k * 8); if (gg == g) mine[k] = v;
              const float f0 = bflo(v.x), f1 = bfhi(v.x), f2 = bflo(v.y), f3 = bfhi(v.y), f4 = bflo(v.z), f5 = bfhi(v.z), f6 = bflo(v.w), f7 = bfhi(v.w);
              s += ((f0 + f1) + (f2 + f3)) + ((f4 + f5) + (f6 + f7)); s2 += ((f0 * f0 + f1 * f1) + (f2 * f2 + f3 * f3)) + ((f4 * f4 + f5 * f5) + (f6 * f6 + f7 * f7)); }
      s += __shfl_xor(s, 1); s += __shfl_xor(s, 2); s2 += __shfl_xor(s2, 1); s2 += __shfl_xor(s2, 2);
      const float mean = s * (1.f / 512.f), var = fmaxf(s2 * (1.f / 512.f) - mean * mean, 0.f), rstd = 1.f / sqrtf(var + LN_EPS);
      const float* lgp = F.in(21  ) + l * 512 + g * 128 + qq * 32; const float* lbp = F.in(22  ) + l * 512 + g * 128 + qq * 32;
#pragma unroll
      for (int k = 0; k < 4; ++k) { const unsigned ww[4] = {mine[k].x, mine[k].y, mine[k].z, mine[k].w};
#pragma unroll
          for (int e = 0; e < 4; ++e) { const int c = qq * 32 + k * 8 + e * 2;
              const float v0 = (bflo(ww[e]) - mean) * rstd * lgp[k * 8 + e * 2] + lbp[k * 8 + e * 2], v1 = (bfhi(ww[e]) - mean) * rstd * lgp[k * 8 + e * 2 + 1] + lbp[k * 8 + e * 2 + 1];
              *(LAS unsigned short*)(vnt + c * SG_PITCH + q * 2) = (unsigned short)f2bf(v0); *(LAS unsigned short*)(vnt + (c + 1) * SG_PITCH + q * 2) = (unsigned short)f2bf(v1); } }
    }
    __syncthreads();
    const int pb = w >> 1, cb0 = 2 * (w & 1);
    const bf16* Ws = WSP(bf16, WS_WS) + (size_t)((l * 4 + g) * 128 + 32 * pb + r32) * 128 + hi * 8;
    f32x16 acc[2];
#pragma unroll
    for (int r = 0; r < 16; ++r) { acc[0][r] = 0.f; acc[1][r] = 0.f; }
#pragma unroll
    for (int ks = 0; ks < 8; ++ks) {
        const bf16x8 a = *(const bf16x8*)(Ws + 16 * ks);
        const bf16x8 b0 = *(const LAS bf16x8*)(vnt + (32 * cb0 + r32) * SG_PITCH + (16 * ks + 8 * hi) * 2), b1 = *(const LAS bf16x8*)(vnt + (32 * (cb0 + 1) + r32) * SG_PITCH + (16 * ks + 8 * hi) * 2);
        acc[0] = __builtin_amdgcn_mfma_f32_32x32x16_bf16(a, b0, acc[0], 0, 0, 0);
        acc[1] = __builtin_amdgcn_mfma_f32_32x32x16_bf16(a, b1, acc[1], 0, 0, 0);
    }
    bf16* YC = WSP(bf16, WS_H);
    const float* bs = F.in(24  ) + (l * 4 + g) * 128;
#pragma unroll
    for (int cbi = 0; cbi < 2; ++cbi)
#pragma unroll
        for (int r = 0; r < 16; ++r) { const int p = 32 * pb + crow(r, hi), c = 32 * (cb0 + cbi) + r32; const size_t row = (size_t)(row0 + p);
            const float u = bf2f(P[row * DIN + C_U + g * 128 + c]), z = bf2f(P[row * DIN + C_ZC + g * 128 + c]);
            YC[row * DM + 1536 + g * 128 + c] = (bf16)f2bf((acc[cbi][r] + bs[p]) * u * z); }
}

#ifndef PHASE_MASK
#define PHASE_MASK 0xff
#endif
#define PM(k) ((PHASE_MASK >> (k)) & 1)
#ifndef UNIT_MASK
#define UNIT_MASK 7
#endif
#define UM(k) ((UNIT_MASK >> (k)) & 1)
constexpr int N_PHASES = 14;
__global__ void __launch_bounds__(NT, 2) fwd_kernel(Args args) {
    extern __shared__ __attribute__((aligned(16))) unsigned char lds[];
    Frame F;
    F.lds = (LAS unsigned char*)lds;
    F.MISC = (volatile LAS unsigned*)(F.lds + MISC_OFF);
    F.tid = threadIdx.x; F.lane = F.tid & 63; F.wave = __builtin_amdgcn_readfirstlane(F.tid >> 6);
    F.G = gridDim.x; F.bid = blockIdx.x;
    F.ws = args.ws; F.out = args.out; F.ctl = (unsigned*)(args.ws + WS_CTL);
    F.ka = (KArgs)__builtin_amdgcn_kernarg_segment_ptr();
    for (int u = F.tid; u < (LDS_BYTES - LDSCTL_OFF) / 4; u += NT) ((LAS unsigned*)(F.lds + LDSCTL_OFF))[u] = 0u;
    __syncthreads();
    cg::grid_group grid = cg::this_grid();
    const int lo = args.ph_lo, hi = args.ph_hi;
#define IN(k) (lo <= (k) && (k) < hi)
#define FRESH() do { asm volatile("" : "+s"(F.ka)); asm volatile("" : "+v"(F.tid)); F.lane = F.tid & 63; F.wave = __builtin_amdgcn_readfirstlane(F.tid >> 6); } while (0)
#define SEAM(k) do { if (IN(k) && IN((k) + 1)) grid.sync(); } while (0)

    if (PM(0) && IN(0)) { FRESH(); p0_prologue(F); }
    SEAM(0);
    if (PM(1) && IN(1)) { FRESH(); p1_lnmod(F); }
    SEAM(1);
    for (int l = 0; l < 2; ++l) {
        const int pb = 2 + 6 * l;
        if (PM(2) && IN(pb)) { FRESH();
            pg8::Gemm g{WSP(bf16, WS_H), WSP(bf16, WS_WIN) + (size_t)l * DIN * 2048, M, DIN, DM}; pg8::StaticOrder S; S.init(M, DIN, F.G, F.bid);
            float* okv = F.out + (size_t)M * DM + (size_t)l * 256 * 256;
            pg8::EpiInProj E{WSP(bf16, WS_P), okv, okv + (size_t)32 * 2 * 256 * 256, WSP(float, WS_ROPE)};
            pg8::gemm_phase<pg8::EpiInProj, pg8::StaticOrder, true, true>(F.lds, g, S, E);
        }
        SEAM(pb);
        if (PM(3) && IN(pb + 1)) { FRESH();
            for (;;) {
                int u = wq_next(F, pb + 1); FRESH();
                if (u >= 1152) break;
                if (u < 256) { if (UM(0)) attn_unit(F, l, 1, u >> 7, (u >> 4) & 7, u & 15); continue; } u -= 256;
                if (u < 128) { if (UM(1)) ssm_unit(F, l, u >> 2, u & 3); continue; } u -= 128;
                if (u < 256) { if (UM(0)) attn_unit(F, l, 0, u >> 3, u & 7, 0); continue; } u -= 256;
                if (UM(2)) sgu_unit(F, l, u >> 2, u & 3);
            }
            __syncthreads();
        }
        SEAM(pb + 1);
        if (PM(4) && IN(pb + 2)) { FRESH();
            for (int t = F.bid; t < 128; t += F.G) {
                pg8::Gemm g{WSP(bf16, WS_YG), WSP(bf16, WS_WGLU) + (size_t)l * 512 * 512, M, 512, 512}; pg8::OneUnit S{{t >> 1, t & 1}};
                pg8::EpiGlu E{WSP(bf16, WS_YG), WSP(bf16, WS_P), WSP(bf16, WS_H), F.in(19  ) + l * 512};
                pg8::gemm_phase<pg8::EpiGlu, pg8::OneUnit, false, true>(F.lds, g, S, E);
            }
        }
        SEAM(pb + 2);
        if (PM(5) && IN(pb + 3)) { FRESH();
            pg8::Gemm g{WSP(bf16, WS_H), WSP(bf16, WS_WP) + (size_t)l * 2048 * 2048, M, DM, DM}; pg8::StaticOrder S; S.init(M, DM, F.G, F.bid);
            pg8::EpiMerge E{WSP(bf16, WS_P), WSP(bf16, WS_MRG)};
            pg8::gemm_phase<pg8::EpiMerge, pg8::StaticOrder, true, true>(F.lds, g, S, E);
        }
        SEAM(pb + 3);
        if (PM(6) && IN(pb + 4)) { FRESH();
            pg8::Gemm g{WSP(bf16, WS_MRG), WSP(bf16, WS_WOUT) + (size_t)l * 2048 * 2048, M, DM, DM}; pg8::StaticOrder S; S.init(M, DM, F.G, F.bid);
            const float* xa = (l == 0) ? F.in(0  ) : F.out; const float* xb = (l == 0) ? F.in(1  ) : (F.out + (size_t)MCTX * DM);
            pg8::EpiOut E{xa, xb, F.out, WSP(float, WS_MOD) + (size_t)l * 3 * 6144};
            pg8::gemm_phase<pg8::EpiOut, pg8::StaticOrder, true, true>(F.lds, g, S, E);
        }
        SEAM(pb + 4);
        if (PM(7) && IN(pb + 5)) { FRESH(); pg_postln(F, l); }
        if (l == 0) SEAM(pb + 5);
    }
#undef IN
#undef SEAM
}

#ifndef N_LAUNCH_MODE
#define N_LAUNCH_MODE 0
#endif
extern "C" void kernel_launch(void* const* d_in, const int* in_sizes, int n_in, void* d_out, int out_size, void* d_ws, size_t ws_size, hipStream_t stream) {
    static int grid = 0;
    if (grid == 0) {
        if (n_in != 31 || ws_size < WS_END) { fprintf(stderr, "kernel_launch: need 31 inputs and >= %zu bytes of workspace; got %d, %zu\n", (size_t)WS_END, n_in, ws_size); grid = -1; return; }
        int dev = 0, cus = 0, per_cu = 0;
        if (hipGetDevice(&dev) != hipSuccess || hipDeviceGetAttribute(&cus, hipDeviceAttributeMultiprocessorCount, dev) != hipSuccess) { grid = -1; return; }
        if (hipFuncSetAttribute((const void*)fwd_kernel, hipFuncAttributeMaxDynamicSharedMemorySize, LDS_BYTES) != hipSuccess) { fprintf(stderr, "kernel_launch: hipFuncSetAttribute failed\n"); grid = -1; return; }
        if (hipOccupancyMaxActiveBlocksPerMultiprocessor(&per_cu, (const void*)fwd_kernel, NT, LDS_BYTES) != hipSuccess || per_cu < 1) { fprintf(stderr, "kernel_launch: occupancy query says %d\n", per_cu); (void)hipGetLastError(); grid = -1; return; }
        grid = cus;
    }
    if (grid < 0) return;
    (void)hipMemsetAsync((char*)d_ws + WS_CTL, 0, CTL_ZERO_BYTES, stream);
    Args a{};
    for (int i = 0; i < 31; ++i) a.in[i] = (const float*)d_in[i];
    a.out = (float*)d_out; a.ws = (unsigned char*)d_ws;
#if N_LAUNCH_MODE == 0
    a.ph_lo = 0; a.ph_hi = N_PHASES;
    { void* params[] = {&a}; hipError_t e = hipLaunchCooperativeKernel((const void*)fwd_kernel, dim3(grid), dim3(NT), params, LDS_BYTES, stream);
      if (e != hipSuccess) fprintf(stderr, "cooperative launch failed: %s\n", hipGetErrorString(e)); }
#else
    for (int p = 0; p < N_PHASES; ++p) { a.ph_lo = p; a.ph_hi = p + 1;
        void* params[] = {&a}; hipError_t e = hipLaunchCooperativeKernel((const void*)fwd_kernel, dim3(grid), dim3(NT), params, LDS_BYTES, stream);
        if (e != hipSuccess) { fprintf(stderr, "launch %d failed: %s\n", p, hipGetErrorString(e)); break; } }
#endif
}
```

```cpp
#include <hip/hip_runtime.h>
#include <hip/hip_cooperative_groups.h>
#include <cstdio>
#include <cstdint>
#include <cmath>
namespace cg = cooperative_groups;

#define GAS __attribute__((address_space(1)))
#define LAS __attribute__((address_space(3)))
typedef unsigned short bf16;
typedef short bf16x8 __attribute__((ext_vector_type(8)));
typedef short s16x4 __attribute__((ext_vector_type(4)));
typedef float f32x2 __attribute__((ext_vector_type(2)));
typedef float f32x4 __attribute__((ext_vector_type(4)));
typedef float f32x16 __attribute__((ext_vector_type(16)));
typedef unsigned u32x2 __attribute__((ext_vector_type(2)));
typedef unsigned u32x4 __attribute__((ext_vector_type(4)));
typedef __bf16 bf16x2_t __attribute__((ext_vector_type(2)));

constexpr int DM = 2048, M = 16384, MCTX = 8192, DIN = 11264, NW = 8, NT = 512;
constexpr int C_XA = 0, C_ZA = 512, C_Q = 1024, C_K = 2048, C_V = 2304, C_ZB = 2560, C_U = 3584, C_VS = 4096, C_ZC = 4608, C_MG = 5120;
constexpr float LN_EPS = 1e-5f;
constexpr float DN_ALPHA = 1.41421356237309515f;
constexpr float LOG2E = 1.4426950408889634f;
constexpr float QSCALE = 0.08838834764831845f * LOG2E;
constexpr int TCH = 32;

constexpr size_t MiB = 1u << 20;
constexpr size_t WS_CTL = 0, CTL_ZERO_BYTES = 1 * MiB;
constexpr size_t WS_MODP = 1 * MiB;
constexpr size_t WS_ROPE = 6 * MiB;
constexpr size_t WS_AT = 6 * MiB + 65536;
constexpr size_t WS_MOD = 6 * MiB + 262144;
constexpr size_t WS_WS = 7 * MiB;
constexpr size_t WS_CK = 8 * MiB;
constexpr size_t WS_CV = 8 * MiB + 524288;
constexpr size_t WS_LAG = 9 * MiB;
constexpr size_t WS_WF = 11 * MiB;
constexpr size_t WS_WY = 27 * MiB;
constexpr size_t WS_WGLU = 43 * MiB;
constexpr size_t WS_WP = 44 * MiB;
constexpr size_t WS_WOUT = 60 * MiB;
constexpr size_t WS_WIN = 76 * MiB;
constexpr size_t WS_H = 164 * MiB;
constexpr size_t WS_MRG = 228 * MiB;
constexpr size_t WS_YG = 292 * MiB;
constexpr size_t WS_F = 308 * MiB;
constexpr size_t WS_SIN = 324 * MiB;
constexpr size_t WS_P = 332 * MiB;
constexpr size_t WS_END = 684 * MiB;
constexpr int CW_WQ = 64;
constexpr int CW_BAR = 8192;

constexpr int RING_BYTES = 131072;
constexpr int LDSCTL_OFF = RING_BYTES, MISC_OFF = LDSCTL_OFF + 320;
constexpr int LDS_BYTES = 147456;

__device__ __forceinline__ unsigned f2bf(float f) { unsigned u = __builtin_bit_cast(unsigned, f); return (u + 0x7fffu + ((u >> 16) & 1u)) >> 16; }
__device__ __forceinline__ unsigned pk2(float lo, float hi) { f32x2 v = {lo, hi}; bf16x2_t b = __builtin_convertvector(v, bf16x2_t); return __builtin_bit_cast(unsigned, b); }
__device__ __forceinline__ float bf2f(unsigned short h) { return __builtin_bit_cast(float, (unsigned)h << 16); }
__device__ __forceinline__ float bflo(unsigned w) { return __builtin_bit_cast(float, w << 16); }
__device__ __forceinline__ float bfhi(unsigned w) { return __builtin_bit_cast(float, w & 0xffff0000u); }
__device__ __forceinline__ float sigmoidf_(float x) { return 1.0f / (1.0f + __expf(-x)); }
__device__ __forceinline__ float siluf_(float x) { return x / (1.0f + __expf(-x)); }
__device__ __forceinline__ float geluf_(float x) { const float z = 1.5957691216057308f * (x + 0.044715f * x * x * x); return x / (1.0f + __expf(-z)); }
__device__ __forceinline__ float wave_sum(float v) {
#pragma unroll
    for (int o = 1; o < 64; o <<= 1) v += __shfl_xor(v, o);
    return v;
}
#define LDS_WAIT() asm volatile("s_waitcnt lgkmcnt(0)" ::: "memory")
#define VM_WAIT() asm volatile("s_waitcnt vmcnt(0)" ::: "memory")
namespace pg8 {
#define PG8_LAS __attribute__((address_space(3)))
typedef unsigned short bf16_t;
typedef short bf16x8 __attribute__((ext_vector_type(8)));
typedef float f32x4 __attribute__((ext_vector_type(4)));
typedef unsigned u32x4 __attribute__((ext_vector_type(4)));
constexpr int BM = 256, BK = 64, HALF = 128, HTB = HALF * BK * 2  , STAGE_BYTES = 8 * HTB, NXCD = 8, WGM = 8;

__host__ __device__ __forceinline__ int lds_byte(int r, int c) { const int st = (r >> 4) * 2 + (c >> 5), rr = r & 15, cc = c & 31, ob = rr * 64 + cc * 2; return st * 1024 + (ob ^ (((ob >> 9) & 1) << 5)); }
__host__ __device__ __forceinline__ void stage_rc(int b, int& R, int& C) { const int st = b / 1024, sb = b % 1024, swz = sb ^ (((sb >> 9) & 1) << 5); R = (st >> 1) * 16 + swz / 64; C = (st & 1) * 32 + (swz % 64) / 2; }
__host__ __device__ __forceinline__ int perm32(int rho) { const int n = rho >> 4, i = rho & 15; return 8 * (i >> 2) + 4 * n + (i & 3); }

struct Unit { int pm, pn; };
struct Gemm { const bf16_t* A; const bf16_t* Bt; int M, N, K; };

struct StaticOrder {
    int nM, nN, nwg, G, c;
    __host__ __device__ void init(int M, int N, int G_, int c_) { nM = M / BM; nN = N / BM; nwg = nM * nN; G = G_; c = c_; }
    __host__ __device__ bool next(int i, Unit& u) const {
        const long L = (long)i * G + c; if (L >= nwg) return false;
        int wgid = (int)L; { const int q = nwg / NXCD, r = nwg % NXCD, xcd = wgid % NXCD, off = wgid / NXCD; wgid = (xcd < r ? xcd * (q + 1) : r * (q + 1) + (xcd - r) * q) + off; }
        const int nig = WGM * nN, gid = wgid / nig, fm = gid * WGM, gsz = (nM - fm) < WGM ? (nM - fm) : WGM;
        u.pm = fm + ((wgid % nig) % gsz); u.pn = (wgid % nig) / gsz; return true;
    }
    __device__ __forceinline__ void a_ready(const Unit&) const {}
    __device__ __forceinline__ void done(const Unit&) const {}
};


struct OneUnit {
    Unit u;
    __device__ __forceinline__ bool next(int i, Unit& o) const { if (i != 0) return false; o = u; return true; }
    __device__ __forceinline__ void a_ready(const Unit&) const {}
    __device__ __forceinline__ void done(const Unit&) const {}
};

struct EpiInProj {
    static constexpr bool PERM = true, AFTER_DRAIN = false, HAS_MID = false;
    bf16_t* P; float* outk; float* outv; const float* rope;
    __device__ __forceinline__ void operator()(const f32x4 (&acc)[2][2][4][2], const Unit& u, int wr, int wc, int fr, int fq) const {
        const int pn = u.pn;
        int kind;
        if (pn < 2) kind = 0; else if (pn < 4) kind = 1; else if (pn < 8) kind = 4; else if (pn == 8) kind = 5; else if (pn == 9) kind = 6;
        else if (pn < 14) kind = 1; else if (pn < 18) kind = 2; else if (pn < 20) kind = 1; else kind = 3;
        const bool lat = u.pm >= 32;
        int row0 = u.pm * BM + wr * 64 + fr; asm volatile("" : "+v"(row0)); const int colL = wc * 32 + 8 * fq;
        const int p0 = wc * 16 + 4 * fq;
        const int j0 = (wc < 2) ? p0 : p0 - 32;
        const int dbase = (wc < 2) ? p0 : p0 + 32;
#pragma unroll
        for (int ai = 0; ai < 2; ++ai)
#pragma unroll
            for (int m = 0; m < 4; ++m) {
                const int row = row0 + ai * HALF + m * 16;
                bf16_t* rowp = P + (size_t)row * DIN + pn * BM + colL;
                f32x4 cs0 = {1.f, 0.f, 1.f, 0.f}, cs1 = {1.f, 0.f, 1.f, 0.f};
                if ((kind == 4 || kind == 5) && lat) {
                    const int t = (row - MCTX) & 4095; const int pos = (wc < 2) ? (t >> 6) : (t & 63);
                    const float* rp = rope + (size_t)(pos * 32 + j0) * 2; cs0 = *(const f32x4*)rp; cs1 = *(const f32x4*)(rp + 4);
                }
#pragma unroll
                for (int bj = 0; bj < 2; ++bj) {
                    f32x4 v0 = acc[ai][bj][m][0], v1 = acc[ai][bj][m][1];
                    if (kind == 1) { for (int e = 0; e < 4; ++e) { v0[e] = siluf_(v0[e]); v1[e] = siluf_(v1[e]); } }
                    else if (kind == 2) { for (int e = 0; e < 4; ++e) { v0[e] = geluf_(v0[e]); v1[e] = geluf_(v1[e]); } }
                    else if (kind == 3) { for (int e = 0; e < 4; ++e) { v0[e] = sigmoidf_(fminf(fmaxf(v0[e], -30.f), 30.f)); v1[e] = sigmoidf_(fminf(fmaxf(v1[e], -30.f), 30.f)); } }
                    else if (kind == 4 || kind == 5) {
                        if (kind == 5 && !lat) {
                            const int b = row >> 8, t = row & 255;
                            float* o = outk + (size_t)b * (2 * 256 * 256) + t * 256 + bj * 128 + dbase;
                            *(f32x4*)o = (f32x4){v0[0], v0[2], v1[0], v1[2]}; *(f32x4*)(o + 32) = (f32x4){v0[1], v0[3], v1[1], v1[3]};
                        }
                        const float sc = (kind == 4) ? QSCALE : 1.0f;
                        f32x4 w0, w1;
                        w0[0] = (v0[0] * cs0[0] - v0[1] * cs0[1]) * sc; w0[1] = (v0[0] * cs0[1] + v0[1] * cs0[0]) * sc;
                        w0[2] = (v0[2] * cs0[2] - v0[3] * cs0[3]) * sc; w0[3] = (v0[2] * cs0[3] + v0[3] * cs0[2]) * sc;
                        w1[0] = (v1[0] * cs1[0] - v1[1] * cs1[1]) * sc; w1[1] = (v1[0] * cs1[1] + v1[1] * cs1[0]) * sc;
                        w1[2] = (v1[2] * cs1[2] - v1[3] * cs1[3]) * sc; w1[3] = (v1[2] * cs1[3] + v1[3] * cs1[2]) * sc;
                        v0 = w0; v1 = w1;
                    } else if (kind == 6) {
                        if (!lat) { const int b = row >> 8, t = row & 255; float* o = outv + (size_t)b * (2 * 256 * 256) + t * 256 + bj * 128 + colL; *(f32x4*)o = v0; *(f32x4*)(o + 4) = v1; }
                    }
                    u32x4 w; w.x = pk2(v0[0], v0[1]); w.y = pk2(v0[2], v0[3]); w.z = pk2(v1[0], v1[1]); w.w = pk2(v1[2], v1[3]);
                    *(u32x4*)(rowp + bj * HALF) = w;
                }
            }
    }
};

struct EpiGlu {
    static constexpr bool PERM = true, AFTER_DRAIN = false, HAS_MID = false;
    const bf16_t* YG; const bf16_t* P; bf16_t* YC; const float* bias;
    __device__ __forceinline__ void operator()(const f32x4 (&acc)[2][2][4][2], const Unit& u, int wr, int wc, int fr, int fq) const {
        int row0 = u.pm * BM + wr * 64 + fr; asm volatile("" : "+v"(row0)); const int col0 = u.pn * BM + wc * 32 + 8 * fq;
#pragma unroll
        for (int bj = 0; bj < 2; ++bj) {
            const int col = col0 + bj * HALF;
            const f32x4 b0 = *(const f32x4*)(bias + col), b1 = *(const f32x4*)(bias + col + 4);
#pragma unroll
            for (int ai = 0; ai < 2; ++ai)
#pragma unroll
                for (int m = 0; m < 4; ++m) {
                    const int row = row0 + ai * HALF + m * 16;
                    const u32x4 yg = *(const u32x4*)(YG + (size_t)row * 512 + col);
                    const u32x4 za = *(const u32x4*)(P + (size_t)row * DIN + C_ZA + col);
                    const f32x4 v0 = acc[ai][bj][m][0] + b0, v1 = acc[ai][bj][m][1] + b1;
                    u32x4 w;
                    w.x = pk2(bflo(yg.x) * sigmoidf_(v0[0]) * bflo(za.x), bfhi(yg.x) * sigmoidf_(v0[1]) * bfhi(za.x));
                    w.y = pk2(bflo(yg.y) * sigmoidf_(v0[2]) * bflo(za.y), bfhi(yg.y) * sigmoidf_(v0[3]) * bfhi(za.y));
                    w.z = pk2(bflo(yg.z) * sigmoidf_(v1[0]) * bflo(za.z), bfhi(yg.z) * sigmoidf_(v1[1]) * bfhi(za.z));
                    w.w = pk2(bflo(yg.w) * sigmoidf_(v1[2]) * bflo(za.w), bfhi(yg.w) * sigmoidf_(v1[3]) * bfhi(za.w));
                    *(u32x4*)(YC + (size_t)row * DM + col) = w;
                }
        }
    }
};

struct EpiMerge {
    static constexpr bool PERM = true, AFTER_DRAIN = false, HAS_MID = true;
    const bf16_t* P; bf16_t* O;
    __device__ __forceinline__ bool is_mid(int t) const { return t == 8 || t == 24; }
    __device__ __forceinline__ void mid(f32x4 (&acc)[2][2][4][2], const Unit& u, int wr, int wc, int fr, int fq, int t) const {
        const int s = (t == 8) ? 0 : 1;
        int row0 = u.pm * BM + wr * 64 + fr; asm volatile("" : "+v"(row0)); const int col0 = u.pn * BM + wc * 32 + 8 * fq;
#pragma unroll
        for (int ai = 0; ai < 2; ++ai)
#pragma unroll
            for (int m = 0; m < 4; ++m) {
                const bf16_t* gp = P + (size_t)(row0 + ai * HALF + m * 16) * DIN + C_MG + s * 2048 + col0;
#pragma unroll
                for (int bj = 0; bj < 2; ++bj) {
                    const u32x4 gn = *(const u32x4*)(gp + bj * HALF), gd = *(const u32x4*)(gp + 2048 + bj * HALF);
                    f32x4 r0, r1;
                    r0[0] = bflo(gn.x) * __builtin_amdgcn_rcpf(bflo(gd.x)); r0[1] = bfhi(gn.x) * __builtin_amdgcn_rcpf(bfhi(gd.x)); r0[2] = bflo(gn.y) * __builtin_amdgcn_rcpf(bflo(gd.y)); r0[3] = bfhi(gn.y) * __builtin_amdgcn_rcpf(bfhi(gd.y));
                    r1[0] = bflo(gn.z) * __builtin_amdgcn_rcpf(bflo(gd.z)); r1[1] = bfhi(gn.z) * __builtin_amdgcn_rcpf(bfhi(gd.z)); r1[2] = bflo(gn.w) * __builtin_amdgcn_rcpf(bflo(gd.w)); r1[3] = bfhi(gn.w) * __builtin_amdgcn_rcpf(bfhi(gd.w));
                    acc[ai][bj][m][0] *= r0; acc[ai][bj][m][1] *= r1;
                }
                asm volatile("" ::: "memory");
            }
    }
    __device__ __forceinline__ void operator()(const f32x4 (&acc)[2][2][4][2], const Unit& u, int wr, int wc, int fr, int fq) const {
        int row0 = u.pm * BM + wr * 64 + fr; asm volatile("" : "+v"(row0)); const int col0 = u.pn * BM + wc * 32 + 8 * fq;
#pragma unroll
        for (int ai = 0; ai < 2; ++ai)
#pragma unroll
            for (int m = 0; m < 4; ++m) {
                const int row = row0 + ai * HALF + m * 16;
                const bf16_t* gp = P + (size_t)row * DIN + C_MG + 2 * 2048 + col0;
#pragma unroll
                for (int bj = 0; bj < 2; ++bj) {
                    const u32x4 g = *(const u32x4*)(gp + bj * HALF);
                    const f32x4 v0 = acc[ai][bj][m][0], v1 = acc[ai][bj][m][1];
                    u32x4 w;
                    w.x = pk2(v0[0] * bflo(g.x), v0[1] * bfhi(g.x)); w.y = pk2(v0[2] * bflo(g.y), v0[3] * bfhi(g.y));
                    w.z = pk2(v1[0] * bflo(g.z), v1[1] * bfhi(g.z)); w.w = pk2(v1[2] * bflo(g.w), v1[3] * bfhi(g.w));
                    *(u32x4*)(O + (size_t)row * DM + col0 + bj * HALF) = w;
                }
            }
    }
};

struct EpiOut {
    static constexpr bool PERM = false, AFTER_DRAIN = false, HAS_MID = false;
    const float* xa; const float* xb;
    float* out; const float* gate;
    __device__ __forceinline__ void operator()(const f32x4 (&acc)[2][2][4][2], const Unit& u, int wr, int wc, int fr, int fq) const {
        int row0 = u.pm * BM + wr * 64 + fr; asm volatile("" : "+v"(row0)); const int col0 = u.pn * BM + wc * 32 + 4 * fq;
        const int cv = (u.pm < 32) ? 0 : ((u.pm < 48) ? 1 : 2);
        const float* gp = gate + (size_t)cv * 6144 + 4096 + col0;
#pragma unroll
        for (int bj = 0; bj < 2; ++bj)
#pragma unroll
            for (int n = 0; n < 2; ++n) {
                const f32x4 g = *(const f32x4*)(gp + bj * HALF + n * 16);
#pragma unroll
                for (int ai = 0; ai < 2; ++ai)
#pragma unroll
                    for (int m = 0; m < 4; ++m) {
                        const int row = row0 + ai * HALF + m * 16;
                        const float* xr = (row < MCTX) ? (xa + (size_t)row * DM) : (xb + (size_t)(row - MCTX) * DM);
                        const f32x4 x = *(const f32x4*)(xr + col0 + bj * HALF + n * 16);
                        const f32x4 o = x * DN_ALPHA + g * acc[ai][bj][m][n];
                        *(f32x4*)(out + (size_t)row * DM + col0 + bj * HALF + n * 16) = o;
                    }
            }
    }
};
template <class Epi, class Sched, bool ALIGN_EPI = false, bool SP2 = false>
__device__ __forceinline__ void gemm_phase(PG8_LAS unsigned char* lds, const Gemm g, const Sched& S, const Epi& E) {
    int tid_ = threadIdx.x; asm volatile("" : "+v"(tid_));
    const int tid = tid_, wid = __builtin_amdgcn_readfirstlane(tid >> 6), lane = tid & 63, wr = wid >> 2, wc = wid & 3, fr = lane & 15, fq = lane >> 4;
    const int K = g.K, nt = K / BK;
    unsigned voffA[2], voffB[2];
#pragma unroll
    for (int i = 0; i < 2; ++i) { int R, C; stage_rc(tid * 16 + i * 8192, R, C); const int Rb = Epi::PERM ? ((R & ~31) + perm32(R & 31)) : R;
        voffA[i] = (unsigned)(R * K + C) * 2u; voffB[i] = (unsigned)(Rb * K + C) * 2u; }
    const size_t kstep = (size_t)(BK * 2);
    const size_t hstep = (size_t)HALF * K * 2;
    const size_t tstep = 2 * hstep;
    const unsigned ldsw = (unsigned)wid * 1024u;
    const int aoff = lds_byte(wr * 64 + fr, fq * 8), boff = lds_byte(wc * 32 + fr, fq * 8);
#define PG8_SA(b, h) (((b) * 2 + (h)) * HTB)
#define PG8_SB(b, h) ((4 + (b) * 2 + (h)) * HTB)
#define PG8_STAGE(bufoff, gbase, voff) do { _Pragma("unroll") for (int _i = 0; _i < 2; ++_i) \
        __builtin_amdgcn_global_load_lds((const unsigned*)((const char*)(gbase) + (voff)[_i]), (PG8_LAS unsigned*)(lds + (bufoff) + ldsw + _i * 8192), 16, 0, 0); } while (0)
#define PG8_LDA(dst, b, h) do { _Pragma("unroll") for (int m = 0; m < 4; ++m) _Pragma("unroll") for (int k = 0; k < 2; ++k) dst[m][k] = *(const PG8_LAS bf16x8*)(lds + PG8_SA(b, h) + aoff + m * 2048 + k * 1024); } while (0)
#define PG8_LDB(dst, b, h) do { _Pragma("unroll") for (int n = 0; n < 2; ++n) _Pragma("unroll") for (int k = 0; k < 2; ++k) dst[n][k] = *(const PG8_LAS bf16x8*)(lds + PG8_SB(b, h) + boff + n * 2048 + k * 1024); } while (0)
#define PG8_MMA(ai, bj, At, Bt) do { __builtin_amdgcn_s_setprio(1); _Pragma("unroll") for (int m = 0; m < 4; ++m) _Pragma("unroll") for (int n = 0; n < 2; ++n) _Pragma("unroll") for (int k = 0; k < 2; ++k) \
        acc[ai][bj][m][n] = __builtin_amdgcn_mfma_f32_16x16x32_bf16(Bt[n][k], At[m][k], acc[ai][bj][m][n], 0, 0, 0); __builtin_amdgcn_s_setprio(0); } while (0)
#define PG8_WAIT_V(n) asm volatile("s_waitcnt vmcnt(" #n ")" ::: "memory")
#define PG8_WAIT_L(n) asm volatile("s_waitcnt lgkmcnt(" #n ")" ::: "memory")
#define PG8_BAR __builtin_amdgcn_s_barrier()
#define PG8_SCHED __builtin_amdgcn_sched_barrier(0)
    Unit cur, nxt; int ui = 0;
    if (!S.next(0, cur)) return;
    f32x4 acc[2][2][4][2];
#pragma unroll
    for (int a = 0; a < 2; ++a)
#pragma unroll
        for (int b = 0; b < 2; ++b)
#pragma unroll
            for (int m = 0; m < 4; ++m)
#pragma unroll
                for (int n = 0; n < 2; ++n) acc[a][b][m][n] = (f32x4){0.f, 0.f, 0.f, 0.f};
    bf16x8 At[4][2], B0[2][2], B1[2][2];
    const char* cA = (const char*)g.A + (size_t)cur.pm * tstep; const char* cB = (const char*)g.Bt + (size_t)cur.pn * tstep;
    S.a_ready(cur);
    if constexpr (SP2) {
        PG8_STAGE(PG8_SB(0, 0), cB, voffB); PG8_STAGE(PG8_SB(0, 1), cB + hstep, voffB); PG8_STAGE(PG8_SA(0, 0), cA, voffA); PG8_STAGE(PG8_SA(0, 1), cA + hstep, voffA);
        if (wr == 1) PG8_BAR;
        PG8_WAIT_V(2); PG8_BAR;
        PG8_STAGE(PG8_SB(1, 0), cB + kstep, voffB); PG8_STAGE(PG8_SA(1, 0), cA + kstep, voffA); PG8_STAGE(PG8_SB(1, 1), cB + hstep + kstep, voffB);
        PG8_WAIT_V(6); PG8_BAR;
    } else {
        PG8_STAGE(PG8_SB(0, 0), cB, voffB); PG8_STAGE(PG8_SA(0, 0), cA, voffA); PG8_STAGE(PG8_SB(0, 1), cB + hstep, voffB); PG8_STAGE(PG8_SA(0, 1), cA + hstep, voffA);
        if (wr == 1) PG8_BAR;
        PG8_WAIT_V(4); PG8_BAR;
        PG8_STAGE(PG8_SB(1, 0), cB + kstep, voffB); PG8_STAGE(PG8_SA(1, 0), cA + kstep, voffA); PG8_STAGE(PG8_SB(1, 1), cB + hstep + kstep, voffB);
        PG8_WAIT_V(6); PG8_BAR;
    }
    for (;;) {
        const bool has_next = S.next(ui + 1, nxt);
        const char* nA = has_next ? (const char*)g.A + (size_t)nxt.pm * tstep : cA; const char* nB = has_next ? (const char*)g.Bt + (size_t)nxt.pn * tstep : cB;
        for (int t = 0; t < nt; t += 2) {
            if constexpr (Epi::HAS_MID) { if (E.is_mid(t)) E.mid(acc, cur, wr, wc, fr, fq, t); }
            const bool last = (t == nt - 2);
            const char* a1 = cA + (size_t)(t + 1) * kstep;
            const char* a2 = last ? nA : cA + (size_t)(t + 2) * kstep; const char* b2 = last ? nB : cB + (size_t)(t + 2) * kstep;
            const char* a3 = a2 + kstep; const char* b3 = b2 + kstep;
            if (last && has_next) S.a_ready(nxt);
            if constexpr (SP2) {
            PG8_LDB(B0, 0, 0); PG8_LDB(B1, 0, 1); PG8_SCHED; PG8_LDA(At, 0, 0); PG8_STAGE(PG8_SA(1, 1), a1 + hstep, voffA);
            PG8_WAIT_V(8); PG8_WAIT_L(0); PG8_BAR; PG8_MMA(0, 0, At, B0); PG8_MMA(0, 1, At, B1); PG8_BAR; PG8_SCHED;
            PG8_LDA(At, 0, 1); PG8_STAGE(PG8_SB(0, 0), b2, voffB); PG8_STAGE(PG8_SB(0, 1), b2 + hstep, voffB); PG8_STAGE(PG8_SA(0, 0), a2, voffA);
            PG8_WAIT_V(8); PG8_WAIT_L(0); PG8_BAR; PG8_MMA(1, 0, At, B0); PG8_MMA(1, 1, At, B1); PG8_BAR; PG8_SCHED;
            PG8_LDB(B0, 1, 0); PG8_LDB(B1, 1, 1); PG8_SCHED; PG8_LDA(At, 1, 0); PG8_STAGE(PG8_SA(0, 1), a2 + hstep, voffA);
            PG8_WAIT_V(8); PG8_WAIT_L(0); PG8_BAR; PG8_MMA(0, 0, At, B0); PG8_MMA(0, 1, At, B1); PG8_BAR; PG8_SCHED;
            PG8_LDA(At, 1, 1); PG8_STAGE(PG8_SB(1, 0), b3, voffB); PG8_STAGE(PG8_SB(1, 1), b3 + hstep, voffB); PG8_STAGE(PG8_SA(1, 0), a3, voffA);
            PG8_WAIT_V(8); PG8_WAIT_L(0); PG8_BAR; PG8_MMA(1, 0, At, B0); PG8_MMA(1, 1, At, B1); PG8_BAR; PG8_SCHED;
            } else {
            PG8_LDB(B0, 0, 0); PG8_SCHED; PG8_LDA(At, 0, 0); PG8_STAGE(PG8_SA(1, 1), a1 + hstep, voffA);
            PG8_WAIT_L(8); PG8_BAR; PG8_WAIT_L(0); PG8_MMA(0, 0, At, B0); PG8_BAR; PG8_SCHED;
            PG8_LDB(B1, 0, 1); PG8_STAGE(PG8_SB(0, 0), b2, voffB);
            PG8_BAR; PG8_WAIT_L(0); PG8_MMA(0, 1, At, B1); PG8_BAR;
            PG8_LDA(At, 0, 1); PG8_STAGE(PG8_SA(0, 0), a2, voffA);
            PG8_BAR; PG8_WAIT_L(0); PG8_MMA(1, 0, At, B0); PG8_BAR; PG8_SCHED;
            PG8_STAGE(PG8_SB(0, 1), b2 + hstep, voffB);
            PG8_WAIT_V(6); PG8_BAR; PG8_MMA(1, 1, At, B1); PG8_BAR;
            PG8_LDB(B0, 1, 0); PG8_SCHED; PG8_LDA(At, 1, 0); PG8_STAGE(PG8_SA(0, 1), a2 + hstep, voffA);
            PG8_WAIT_L(8); PG8_BAR; PG8_WAIT_L(0); PG8_MMA(0, 0, At, B0); PG8_BAR; PG8_SCHED;
            PG8_LDB(B1, 1, 1); PG8_STAGE(PG8_SB(1, 0), b3, voffB);
            PG8_BAR; PG8_WAIT_L(0); PG8_MMA(0, 1, At, B1); PG8_BAR;
            PG8_LDA(At, 1, 1); PG8_STAGE(PG8_SA(1, 0), a3, voffA);
            PG8_BAR; PG8_WAIT_L(0); PG8_MMA(1, 0, At, B0); PG8_BAR; PG8_SCHED;
            PG8_STAGE(PG8_SB(1, 1), b3 + hstep, voffB);
            PG8_WAIT_V(6); PG8_BAR; PG8_MMA(1, 1, At, B1); PG8_BAR;
            }
        }
        if constexpr (ALIGN_EPI) { if (wr == 0) PG8_BAR; }
        if constexpr (!Epi::AFTER_DRAIN) { E(acc, cur, wr, wc, fr, fq); S.done(cur); }
        if (!has_next) break;
#pragma unroll
        for (int a = 0; a < 2; ++a)
#pragma unroll
            for (int b = 0; b < 2; ++b)
#pragma unroll
                for (int m = 0; m < 4; ++m)
#pragma unroll
                    for (int n = 0; n < 2; ++n) acc[a][b][m][n] = (f32x4){0.f, 0.f, 0.f, 0.f};
        cur = nxt; cA = nA; cB = nB; ++ui;
        if constexpr (ALIGN_EPI) { if (wr == 1) PG8_BAR; }
    }
    PG8_WAIT_V(0);
    if constexpr (!ALIGN_EPI) { if (wr == 0) PG8_BAR; }
    PG8_BAR;
    if constexpr (Epi::AFTER_DRAIN) { E.fused(acc, cur, wr, wc, fr, fq, lds, wid, lane); S.done(cur); }
#undef PG8_SA
#undef PG8_SB
#undef PG8_STAGE
#undef PG8_LDA
#undef PG8_LDB
#undef PG8_MMA
#undef PG8_WAIT_V
#undef PG8_WAIT_L
#undef PG8_BAR
#undef PG8_SCHED
}
}
#define XB_TMO      128
#define XB_XCNT(j)  (256  + 64 * (j))
#define XB_XSUB(j)  (1280 + 64 * (j))
#define XB_XGEN(j)  (2304 + 64 * (j))
#define XB_TOP      3328
#define XB_TOPGEN   3392
#define XCD_BAR_WORDS 3456
#define XB_SPIN_CAP (1u << 18)

__device__ __forceinline__ unsigned xb_ld(unsigned* p)              { return __hip_atomic_load(p, __ATOMIC_RELAXED, __HIP_MEMORY_SCOPE_AGENT); }
__device__ __forceinline__ unsigned xb_add(unsigned* p, unsigned v) { return __hip_atomic_fetch_add(p, v, __ATOMIC_RELAXED, __HIP_MEMORY_SCOPE_AGENT); }
__device__ __forceinline__ unsigned xb_xcc_id() { return (unsigned)__builtin_amdgcn_s_getreg((3 << 11) | 20) & 0xFu; }
#define XB_SPIN(cond, bar) do { unsigned _sp = 0; while (cond) { __builtin_amdgcn_s_sleep(1); \
    if ((++_sp & 255u) == 0u) { if (xb_ld(&(bar)[XB_TMO])) break; if (_sp > XB_SPIN_CAP) { atomicAdd(&(bar)[XB_TMO], 1u); break; } } } } while (0)

struct XcdBarrier {
    unsigned* bar; unsigned x;
    volatile LAS unsigned* st;
};

__device__ __forceinline__ XcdBarrier xcd_barrier_post(unsigned* bar, volatile LAS unsigned* st) {
    XcdBarrier b; b.bar = bar; b.x = xb_xcc_id(); b.st = st;
    if (threadIdx.x == 0) (void)xb_add(&bar[XB_XCNT(b.x)], 1u);
    return b;
}
__device__ __forceinline__ void xcd_barrier_complete(unsigned* bar, unsigned x, unsigned& nloc, unsigned& nx) {
    const unsigned G = gridDim.x * gridDim.y * gridDim.z;
    unsigned sum, cnt, mine, sp = 0u;
    for (;;) {
        sum = 0u; cnt = 0u; mine = 0u;
#pragma unroll
        for (unsigned j = 0; j < 16; ++j) { const unsigned c = xb_ld(&bar[XB_XCNT(j)]); sum += c; cnt += (c > 0u) ? 1u : 0u; mine = (j == x) ? c : mine; }
        if (sum == G) break;
        __builtin_amdgcn_s_sleep(1);
        if ((++sp & 255u) == 0u) { if (xb_ld(&bar[XB_TMO])) break; if (sp > XB_SPIN_CAP) { atomicAdd(&bar[XB_TMO], 1u); break; } }
    }
    nloc = mine > 0u ? mine : 1u; nx = cnt > 0u ? cnt : 1u;
}

__device__ __forceinline__ void xcd_barrier(const XcdBarrier& b) {
    asm volatile("s_waitcnt vmcnt(0)" ::: "memory");
    __syncthreads();
    if (threadIdx.x == 0) {
        unsigned* bar = b.bar;
        __builtin_amdgcn_s_waitcnt(0);
        unsigned nloc = b.st[0], nx = b.st[1];
        if (nloc == 0u) { xcd_barrier_complete(bar, b.x, nloc, nx); b.st[0] = nloc; b.st[1] = nx; }
        const unsigned old = xb_add(&bar[XB_XSUB(b.x)], 1u);
        const unsigned gen = old / nloc;
        if (old + 1u == (gen + 1u) * nloc) {
            __builtin_amdgcn_fence(__ATOMIC_RELEASE, "agent");
            asm volatile("s_waitcnt vmcnt(0)" ::: "memory");
            const unsigned og = xb_add(&bar[XB_TOP], 1u);
            const unsigned tg = og / nx;
            if (og + 1u == (tg + 1u) * nx) xb_add(&bar[XB_TOPGEN], 1u);
            else XB_SPIN(xb_ld(&bar[XB_TOPGEN]) == tg, bar);
            __builtin_amdgcn_fence(__ATOMIC_ACQUIRE, "agent");
            xb_add(&bar[XB_XGEN(b.x)], 1u);
            asm volatile("s_waitcnt vmcnt(0)" ::: "memory");
        } else {
            XB_SPIN(xb_ld(&bar[XB_XGEN(b.x)]) == gen, bar);
            __builtin_amdgcn_fence(__ATOMIC_ACQUIRE, "agent");
            asm volatile("s_waitcnt vmcnt(0)" ::: "memory");
        }
    }
    __syncthreads();
}


typedef GAS unsigned gu32;
struct Args { const float* in[31]; float* out; unsigned char* ws; int ph_lo, ph_hi; };
typedef const __attribute__((address_space(4))) Args* KArgs;
struct Frame {
    LAS unsigned char* lds;
    volatile LAS unsigned* MISC;
    unsigned* ctl;
    int tid, lane, wave, G, bid;
    unsigned char* ws;
    float* out;
    KArgs ka;
    __device__ __forceinline__ const float* in(int k) const { return ka->in[k]; }
};
#define WSP(T, off) ((T*)(F.ws + (off)))

__device__ __forceinline__ int wq_next(Frame& F, int phase) {
    __syncthreads();
    if (F.tid == 0) F.MISC[16] = __hip_atomic_fetch_add(F.ctl + CW_WQ + 64 * phase, 1u, __ATOMIC_RELAXED, __HIP_MEMORY_SCOPE_AGENT);
    __syncthreads();
    return (int)F.MISC[16];
}

__device__ __forceinline__ void p0_gemv_tile(Frame& F, int idx) {
    const int l = idx / 768, rem = idx % 768, kc = rem / 24, nc = rem % 24, lane = F.lane;
    const int k = kc * 64 + lane;
    const float s0 = siluf_(F.in(6  )[k]), s1 = siluf_(F.in(5  )[k]), s2 = siluf_(F.in(5  )[2048 + k]);
    const float* W = F.in(7  ) + ((size_t)l * 2048 + kc * 64) * 6144 + nc * 256 + lane * 4;
    f32x4 a0 = {0.f, 0.f, 0.f, 0.f}, a1 = a0, a2 = a0;
#pragma unroll 16
    for (int r = 0; r < 64; ++r) {
        const f32x4 wv = *(const f32x4*)(W + (size_t)r * 6144);
        const float t0 = __shfl(s0, r), t1 = __shfl(s1, r), t2 = __shfl(s2, r);
        a0 += wv * t0; a1 += wv * t1; a2 += wv * t2;
    }
    float* o = WSP(float, WS_MODP) + ((size_t)(l * 32 + kc) * 3) * 6144 + nc * 256 + lane * 4;
    *(f32x4*)o = a0; *(f32x4*)(o + 6144) = a1; *(f32x4*)(o + 2 * 6144) = a2;
}
__device__ __forceinline__ int sigma_col(int n) {
    if (n < C_Q || n >= C_V) return n;
    const int hb = n & ~127, c = n & 127, p = c >> 1, e = c & 1;
    return hb + ((p < 32) ? p : p + 32) + 32 * e;
}
__device__ __forceinline__ void p0_transpose_item(const float* W, int N, bf16* WT, int Kd, int koff, bool perm, LAS float* scr, int item, int lane) {
    const int nblk = N / 32, kb = item / nblk, nb = item % nblk, k0 = 64 * kb, n0 = 32 * nb;
    const int ncol = perm ? sigma_col(n0 + (lane & 31)) : (n0 + (lane & 31));
#pragma unroll 8
    for (int i = 0; i < 32; ++i) { const int kk = 2 * i + (lane >> 5); scr[kk * 33 + (lane & 31)] = W[(size_t)(k0 + kk) * N + ncol]; }
    LDS_WAIT(); asm volatile("" ::: "memory");
    const int c = lane & 7;
#pragma unroll
    for (int j = 0; j < 4; ++j) { const int n = (lane >> 3) + 8 * j; const LAS float* s = scr + (8 * c) * 33 + n;
        u32x4 o; o.x = pk2(s[0 * 33], s[1 * 33]); o.y = pk2(s[2 * 33], s[3 * 33]); o.z = pk2(s[4 * 33], s[5 * 33]); o.w = pk2(s[6 * 33], s[7 * 33]);
        *(u32x4*)(WT + (size_t)(n0 + n) * Kd + koff + k0 + 8 * c) = o; }
    LDS_WAIT(); asm volatile("" ::: "memory");
}
__device__ __forceinline__ void p0_ssm_tables(Frame& F, int item) {
    const int l = item >> 5, g = item & 31, tid = F.tid;
    LAS float* apow = (LAS float*)F.lds;
    LAS float* Bb = apow + 2 * 33 * 64 * 2;
    LAS float* Cc = Bb + 2 * 64 * 16 * 2;
    __syncthreads();
    for (int idx = tid; idx < 2 * 33 * 64; idx += NT) {
        const int d = idx / (33 * 64), j = (idx / 64) % 33, p = idx & 63;
        const int pi = ((l * 2 + d) * 32 + g) * 64 + p;
        const double lr = (double)F.in(10  )[pi], li = (double)F.in(11  )[pi], dt = exp((double)F.in(12  )[(l * 2 + d) * 32 + g]);
        const double mag = exp(lr * dt * (double)j); double sn, cs; sincos(li * dt * (double)j, &sn, &cs);
        apow[idx * 2] = (float)(mag * cs); apow[idx * 2 + 1] = (float)(mag * sn);
        if (j == TCH) { float* at = WSP(float, WS_AT) + (size_t)((l * 32 + g) * 2 + d) * 128; at[p] = (float)(mag * cs); at[64 + p] = (float)(mag * sn); }
    }
    for (int idx = tid; idx < 2 * 64 * 16; idx += NT) {
        const int d = idx / 1024, p = (idx >> 4) & 63, cc = idx & 15;
        const int pi = ((l * 2 + d) * 32 + g) * 64 + p;
        const double lr = (double)F.in(10  )[pi], li = (double)F.in(11  )[pi], dt = exp((double)F.in(12  )[(l * 2 + d) * 32 + g]);
        const double mag = exp(lr * dt); double sn, cs; sincos(li * dt, &sn, &cs);
        const double are = mag * cs, aim = mag * sn, nr = are - 1.0, den = lr * lr + li * li;
        const double fre = (nr * lr + aim * li) / den, fim = (aim * lr - nr * li) / den;
        const double br = (double)F.in(13  )[(size_t)pi * 16 + cc], bi = (double)F.in(14  )[(size_t)pi * 16 + cc];
        Bb[idx * 2] = (float)(fre * br - fim * bi); Bb[idx * 2 + 1] = (float)(fre * bi + fim * br);
        const int ci = (((l * 2 + d) * 32 + g) * 16 + cc) * 64 + p;
        const int co = (d * 16 + cc) * 64 + p;
        Cc[co * 2] = F.in(15  )[ci]; Cc[co * 2 + 1] = F.in(16  )[ci];
    }
    __syncthreads();
    bf16* lagt = WSP(bf16, WS_LAG) + (size_t)(l * 32 + g) * 16384;
    for (int idx = tid; idx < 63 * 256; idx += NT) {
        const int L = idx >> 8, delta = L - 31, cc = (idx >> 4) & 15, c2 = idx & 15;
        float v = 0.f;
        if (delta >= 0) { const int j = delta;
            for (int p = 0; p < 64; ++p) { const float ar = apow[((0 * 33 + j) * 64 + p) * 2], ai = apow[((0 * 33 + j) * 64 + p) * 2 + 1];
                const float br = Bb[((0 * 64 + p) * 16 + c2) * 2], bi = Bb[((0 * 64 + p) * 16 + c2) * 2 + 1];
                const float zr = ar * br - ai * bi, zi = ar * bi + ai * br;
                v += Cc[((0 * 16 + cc) * 64 + p) * 2] * zr - Cc[((0 * 16 + cc) * 64 + p) * 2 + 1] * zi; } }
        if (delta <= 0) { const int j = -delta;
            for (int p = 0; p < 64; ++p) { const float ar = apow[((1 * 33 + j) * 64 + p) * 2], ai = apow[((1 * 33 + j) * 64 + p) * 2 + 1];
                const float br = Bb[((1 * 64 + p) * 16 + c2) * 2], bi = Bb[((1 * 64 + p) * 16 + c2) * 2 + 1];
                const float zr = ar * br - ai * bi, zi = ar * bi + ai * br;
                v += Cc[((1 * 16 + cc) * 64 + p) * 2] * zr - Cc[((1 * 16 + cc) * 64 + p) * 2 + 1] * zi; } }
        if (delta == 0 && cc == c2) v += F.in(17  )[l * 512 + g * 16 + cc];
        lagt[idx] = (bf16)f2bf(v);
    }
    bf16* wf = WSP(bf16, WS_WF) + (size_t)(l * 32 + g) * 131072;
    for (int idx = tid; idx < 256 * 512; idx += NT) {
        const int row = idx >> 9, col = idx & 511, d = row >> 7, ri = (row >> 6) & 1, p = row & 63, j = col >> 4, c2 = col & 15;
        const int pw = (d == 0) ? (TCH - 1 - j) : j;
        const float ar = apow[((d * 33 + pw) * 64 + p) * 2], ai = apow[((d * 33 + pw) * 64 + p) * 2 + 1];
        const float br = Bb[((d * 64 + p) * 16 + c2) * 2], bi = Bb[((d * 64 + p) * 16 + c2) * 2 + 1];
        wf[idx] = (bf16)f2bf(ri ? (ar * bi + ai * br) : (ar * br - ai * bi));
    }
    bf16* wy = WSP(bf16, WS_WY) + (size_t)(l * 32 + g) * 131072;
    for (int idx = tid; idx < 512 * 256; idx += NT) {
        const int row = idx >> 8, col = idx & 255, i = row >> 4, cc = row & 15, d = col >> 7, ri = (col >> 6) & 1, p = col & 63;
        const int pw = (d == 0) ? (i + 1) : (TCH - i);
        const float ar = apow[((d * 33 + pw) * 64 + p) * 2], ai = apow[((d * 33 + pw) * 64 + p) * 2 + 1];
        const float cr = Cc[((d * 16 + cc) * 64 + p) * 2], ci = Cc[((d * 16 + cc) * 64 + p) * 2 + 1];
        wy[idx] = (bf16)f2bf(ri ? -(cr * ai + ci * ar) : (cr * ar - ci * ai));
    }
    __syncthreads();
}
__device__ __forceinline__ void p0_prologue(Frame& F) {
    const int gw = F.bid * NW + F.wave, NGW = F.G * NW;
    for (int it = gw; it < 1536; it += NGW) p0_gemv_tile(F, it);
    for (int it = F.G - 1 - F.bid; it < 64; it += F.G) p0_ssm_tables(F, it);
    LAS float* scr = (LAS float*)(F.lds + F.wave * 16384);
    constexpr int I_IN = 32 * 352, I_PA = 8 * 64, I_PB = 16 * 64, I_PC = 8 * 64, I_OUT = 32 * 64, I_GLU = 8 * 16;
    constexpr int I_L = I_IN + I_PA + I_PB + I_PC + I_OUT + I_GLU;
    for (int it = gw; it < 2 * I_L; it += NGW) {
        const int l = it / I_L; int r = it % I_L;
        if (r < I_IN) { p0_transpose_item(F.in(9  ) + (size_t)l * 2048 * DIN, DIN, WSP(bf16, WS_WIN) + (size_t)l * DIN * 2048, 2048, 0, true, scr, r, F.lane); continue; } r -= I_IN;
        if (r < I_PA) { p0_transpose_item(F.in(25  ) + (size_t)l * 512 * 2048, 2048, WSP(bf16, WS_WP) + (size_t)l * 2048 * 2048, 2048, 0, false, scr, r, F.lane); continue; } r -= I_PA;
        if (r < I_PB) { p0_transpose_item(F.in(26  ) + (size_t)l * 1024 * 2048, 2048, WSP(bf16, WS_WP) + (size_t)l * 2048 * 2048, 2048, 512, false, scr, r, F.lane); continue; } r -= I_PB;
        if (r < I_PC) { p0_transpose_item(F.in(27  ) + (size_t)l * 512 * 2048, 2048, WSP(bf16, WS_WP) + (size_t)l * 2048 * 2048, 2048, 1536, false, scr, r, F.lane); continue; } r -= I_PC;
        if (r < I_OUT) { p0_transpose_item(F.in(28  ) + (size_t)l * 2048 * 2048, 2048, WSP(bf16, WS_WOUT) + (size_t)l * 2048 * 2048, 2048, 0, false, scr, r, F.lane); continue; } r -= I_OUT;
        p0_transpose_item(F.in(18  ) + (size_t)l * 512 * 512, 512, WSP(bf16, WS_WGLU) + (size_t)l * 512 * 512, 512, 0, false, scr, r, F.lane);
    }
    const int gt = F.bid * NT + F.tid, NGT = F.G * NT;
    for (int i = gt; i < 2 * 2 * 256 * 256; i += NGT) {
        const int col = i & 255, rowi = i >> 8;
        const int hb = col & 128, cc = col & 127, p = cc >> 1, e = cc & 1, src = hb + ((p < 32) ? p : p + 32) + 32 * e;
        WSP(bf16, WS_CK)[i] = (bf16)f2bf(F.in(2  )[(size_t)rowi * 256 + src]);
        WSP(bf16, WS_CV)[i] = (bf16)f2bf(F.in(3  )[i]);
    }
    for (int i = gt; i < 2 * 4 * 128 * 128; i += NGT) WSP(bf16, WS_WS)[i] = (bf16)f2bf(F.in(23  )[i]);
    for (int i = gt; i < 64 * 32; i += NGT) {
        const int pos = i >> 5, j = i & 31;
        const double inv = pow(10000.0, -(double)(2 * j) / 64.0); double sn, cs; sincos((double)pos * inv, &sn, &cs);
        WSP(float, WS_ROPE)[i * 2] = (float)cs; WSP(float, WS_ROPE)[i * 2 + 1] = (float)sn;
    }
}

__device__ __forceinline__ void ln_row(const float* xrow, f32x4 (&v)[8], int lane) {
    const f32x4* xr = (const f32x4*)xrow + lane; float s = 0.f;
#pragma unroll
    for (int j = 0; j < 8; ++j) { v[j] = xr[64 * j]; s += (v[j].x + v[j].y) + (v[j].z + v[j].w); }
    const float mean = wave_sum(s) * (1.f / DM); float s2 = 0.f;
#pragma unroll
    for (int j = 0; j < 8; ++j) { v[j] = v[j] - mean; s2 += (v[j].x * v[j].x + v[j].y * v[j].y) + (v[j].z * v[j].z + v[j].w * v[j].w); }
    const float rstd = 1.f / sqrtf(wave_sum(s2) * (1.f / DM) + LN_EPS);
#pragma unroll
    for (int j = 0; j < 8; ++j) v[j] = v[j] * rstd;
}
__device__ __forceinline__ void ln_renorm(f32x4 (&v)[8]) {
    float s = 0.f;
#pragma unroll
    for (int j = 0; j < 8; ++j) s += (v[j].x + v[j].y) + (v[j].z + v[j].w);
    const float mean = wave_sum(s) * (1.f / DM); float s2 = 0.f;
#pragma unroll
    for (int j = 0; j < 8; ++j) { v[j] = v[j] - mean; s2 += (v[j].x * v[j].x + v[j].y * v[j].y) + (v[j].z * v[j].z + v[j].w * v[j].w); }
    const float rstd = 1.f / sqrtf(wave_sum(s2) * (1.f / DM) + LN_EPS);
#pragma unroll
    for (int j = 0; j < 8; ++j) v[j] = v[j] * rstd;
}
__device__ __forceinline__ void store_h_row(bf16* hrow, const f32x4 (&v)[8], const LAS float* sc1p, const LAS float* sh, int lane) {
#pragma unroll
    for (int j = 0; j < 8; ++j) { const int c = lane * 4 + 256 * j;
        const f32x4 a = *(const LAS f32x4*)(sc1p + c), b = *(const LAS f32x4*)(sh + c);
        const f32x4 o = v[j] * a + b; u32x2 w; w.x = pk2(o.x, o.y); w.y = pk2(o.z, o.w);
        *(u32x2*)(hrow + c) = w; }
}
__device__ __forceinline__ void p1_lnmod(Frame& F) {
    const float* modp = WSP(float, WS_MODP); float* mod = WSP(float, WS_MOD);
    if (F.tid < 144) { const int idx = F.bid * 144 + F.tid; if (idx < 36864) { const int l = idx / 18432, r = idx % 18432, cv = r / 6144, n = r % 6144; float s = F.in(8  )[l * 6144 + n];
        for (int kc = 0; kc < 32; ++kc) s += modp[((size_t)(l * 32 + kc) * 3 + cv) * 6144 + n]; mod[idx] = s; } }
    const int row0 = F.bid * 64, cv = (row0 < MCTX) ? 0 : 1 + ((row0 - MCTX) >> 12);
    LAS float* sc1p = (LAS float*)F.lds; LAS float* sh = sc1p + 2048;
    for (int n = F.tid; n < 4096; n += NT) { float s = F.in(8  )[n];
        for (int kc = 0; kc < 32; ++kc) s += modp[((size_t)(0 * 32 + kc) * 3 + cv) * 6144 + n];
        if (n < 2048) sh[n] = s; else sc1p[n - 2048] = 1.0f + s; }
    __syncthreads();
    bf16* H = WSP(bf16, WS_H);
    for (int i = 0; i < 8; ++i) { const int row = row0 + F.wave * 8 + i;
        const float* xr = (row < MCTX) ? (F.in(0  ) + (size_t)row * DM) : (F.in(1  ) + (size_t)(row - MCTX) * DM);
        f32x4 v[8]; ln_row(xr, v, F.lane); store_h_row(H + (size_t)row * DM, v, sc1p, sh, F.lane); }
    __syncthreads();
}
__device__ __forceinline__ void pg_postln(Frame& F, int l) {
    const float* mod = WSP(float, WS_MOD);
    const int row0 = F.bid * 64, cv = (row0 < MCTX) ? 0 : 1 + ((row0 - MCTX) >> 12);
    LAS float* sc1p = (LAS float*)F.lds; LAS float* sh = sc1p + 2048; LAS float* lg = sh + 2048; LAS float* lb = lg + 2048;
    __syncthreads();
    for (int n = F.tid; n < 2048; n += NT) { lg[n] = F.in(29  )[l * 2048 + n]; lb[n] = F.in(30  )[l * 2048 + n];
        if (l == 0) { sh[n] = mod[(size_t)(1 * 3 + cv) * 6144 + n]; sc1p[n] = 1.0f + mod[(size_t)(1 * 3 + cv) * 6144 + 2048 + n]; } }
    __syncthreads();
    bf16* H = WSP(bf16, WS_H);
    for (int i = 0; i < 8; ++i) { const int row = row0 + F.wave * 8 + i;
        float* orow = F.out + (size_t)row * DM;
        f32x4 v[8]; ln_row(orow, v, F.lane);
#pragma unroll
        for (int j = 0; j < 8; ++j) { const int c = F.lane * 4 + 256 * j; v[j] = v[j] * *(const LAS f32x4*)(lg + c) + *(const LAS f32x4*)(lb + c); *(f32x4*)(orow + c) = v[j]; }
        if (l == 0) { ln_renorm(v); store_h_row(H + (size_t)row * DM, v, sc1p, sh, F.lane); } }
    __syncthreads();
}

__device__ __forceinline__ int crow(int r, int hi) { return (r & 3) + 8 * (r >> 2) + 4 * hi; }
constexpr int AK_PITCH = 272, AV_PITCH = 320, ATT_K_OFF = 0, ATT_V_OFF = 64 * AK_PITCH;
__device__ __forceinline__ s16x4 vtr(const LAS unsigned char* p) { typedef short v4i16_t __attribute__((ext_vector_type(4))); return __builtin_bit_cast(s16x4, __builtin_amdgcn_ds_read_tr16_b64_v4i16((LAS v4i16_t*)p)); }

__device__ __forceinline__ void attn_unit(Frame& F, int l, int kind, int b, int h, int qb) {
    const int lane = F.lane, w = F.wave, r32 = lane & 31, hi = lane >> 5, tid = F.tid;
    const bf16* P = WSP(bf16, WS_P);
    const int kvh = h >> 2;
    const int seq0 = kind ? (MCTX + b * 4096) : (b * 256);
    const int t0 = kind ? qb * 256 : 0;
    const int tq = t0 + 32 * w + r32;
    const size_t qrow = (size_t)(seq0 + tq);
    int tlo = 0, nloc = 4;
    if (kind) { const int lo = (t0 - 128) < 0 ? 0 : (t0 - 128), hi_ = (t0 + 384) > 4096 ? 4096 : (t0 + 384); tlo = lo >> 6; nloc = (hi_ >> 6) - tlo; }
    const int ntile = nloc + (kind ? 4 : 0);
    bf16x8 qf[8];
    { const bf16* qp = P + qrow * DIN + C_Q + h * 128 + hi * 8;
#pragma unroll
      for (int ks = 0; ks < 8; ++ks) qf[ks] = *(const bf16x8*)(qp + 16 * ks); }
    float mrun = F.in(20  )[l * 8 + h] * LOG2E, lrun = (hi == 0) ? 1.0f : 0.0f;
    f32x16 o[4];
#pragma unroll
    for (int i = 0; i < 4; ++i)
#pragma unroll
        for (int r = 0; r < 16; ++r) o[i][r] = 0.f;
    LAS unsigned char* ldsK = F.lds + ATT_K_OFF; LAS unsigned char* ldsV = F.lds + ATT_V_OFF;
    u32x4 kr[2], vr[2];
    const bf16* CK = WSP(bf16, WS_CK) + (size_t)((b * 2 + l) * 256) * 256 + kvh * 128;
    const bf16* CV = WSP(bf16, WS_CV) + (size_t)((b * 2 + l) * 256) * 256 + kvh * 128;
#define ATT_LOAD(i) do { \
        _Pragma("unroll") for (int q_ = 0; q_ < 2; ++q_) { const int c_ = tid + 512 * q_, kv_ = c_ >> 4, dch_ = c_ & 15; \
            if ((i) < nloc) { const bf16* src_ = P + (size_t)(seq0 + (tlo + (i)) * 64 + kv_) * DIN + kvh * 128 + dch_ * 8; kr[q_] = *(const u32x4*)(src_ + C_K); vr[q_] = *(const u32x4*)(src_ + C_V); } \
            else { const size_t off_ = (size_t)(((i) - nloc) * 64 + kv_) * 256 + dch_ * 8; kr[q_] = *(const u32x4*)(CK + off_); vr[q_] = *(const u32x4*)(CV + off_); } } } while (0)
    ATT_LOAD(0);
    for (int i = 0; i < ntile; ++i) {
        __syncthreads();
#pragma unroll
        for (int q_ = 0; q_ < 2; ++q_) { const int c_ = tid + 512 * q_, kv_ = c_ >> 4, dch_ = c_ & 15;
            *(LAS u32x4*)(ldsK + kv_ * AK_PITCH + dch_ * 16) = kr[q_]; *(LAS u32x4*)(ldsV + kv_ * AV_PITCH + dch_ * 16) = vr[q_]; }
        __syncthreads();
        if (i + 1 < ntile) ATT_LOAD(i + 1);
        const bool local = kind && (i < nloc);
        const int k0 = (tlo + i) * 64;
        bool need = true;
        if (local) { const int wq0 = t0 + 32 * w; need = (k0 + 63 >= wq0 - 128) && (k0 <= wq0 + 31 + 128); }
        if (need) {
            f32x16 s0, s1;
#pragma unroll
            for (int r = 0; r < 16; ++r) { s0[r] = 0.f; s1[r] = 0.f; }
#pragma unroll
            for (int ks = 0; ks < 8; ++ks) {
                const bf16x8 a0 = *(const LAS bf16x8*)(ldsK + r32 * AK_PITCH + ks * 32 + hi * 16);
                const bf16x8 a1 = *(const LAS bf16x8*)(ldsK + (32 + r32) * AK_PITCH + ks * 32 + hi * 16);
                s0 = __builtin_amdgcn_mfma_f32_32x32x16_bf16(a0, qf[ks], s0, 0, 0, 0);
                s1 = __builtin_amdgcn_mfma_f32_32x32x16_bf16(a1, qf[ks], s1, 0, 0, 0);
            }
            if (local) {
#pragma unroll
                for (int r = 0; r < 16; ++r) { const int kp = k0 + crow(r, hi); int d0 = kp - tq; d0 = d0 < 0 ? -d0 : d0; int d1 = kp + 32 - tq; d1 = d1 < 0 ? -d1 : d1;
                    if (d0 > 128) s0[r] = -INFINITY; if (d1 > 128) s1[r] = -INFINITY; }
            }
            float mx = fmaxf(s0[0], s1[0]);
#pragma unroll
            for (int r = 1; r < 16; ++r) mx = fmaxf(mx, fmaxf(s0[r], s1[r]));
            mx = fmaxf(mx, __shfl_xor(mx, 32));
            const float mnew = fmaxf(mrun, mx), alpha = __builtin_amdgcn_exp2f(mrun - mnew);
            mrun = mnew; lrun *= alpha;
#pragma unroll
            for (int i2 = 0; i2 < 4; ++i2)
#pragma unroll
                for (int r = 0; r < 16; ++r) o[i2][r] *= alpha;
            float ls = 0.f;
#pragma unroll
            for (int r = 0; r < 16; ++r) { s0[r] = __builtin_amdgcn_exp2f(s0[r] - mnew); s1[r] = __builtin_amdgcn_exp2f(s1[r] - mnew); ls += s0[r] + s1[r]; }
            lrun += ls;
            bf16x8 pb[4];
            { u32x4 t;
              t.x = pk2(s0[0], s0[1]); t.y = pk2(s0[2], s0[3]); t.z = pk2(s0[4], s0[5]); t.w = pk2(s0[6], s0[7]); pb[0] = __builtin_bit_cast(bf16x8, t);
              t.x = pk2(s0[8], s0[9]); t.y = pk2(s0[10], s0[11]); t.z = pk2(s0[12], s0[13]); t.w = pk2(s0[14], s0[15]); pb[1] = __builtin_bit_cast(bf16x8, t);
              t.x = pk2(s1[0], s1[1]); t.y = pk2(s1[2], s1[3]); t.z = pk2(s1[4], s1[5]); t.w = pk2(s1[6], s1[7]); pb[2] = __builtin_bit_cast(bf16x8, t);
              t.x = pk2(s1[8], s1[9]); t.y = pk2(s1[10], s1[11]); t.z = pk2(s1[12], s1[13]); t.w = pk2(s1[14], s1[15]); pb[3] = __builtin_bit_cast(bf16x8, t); }
            const LAS unsigned char* vb = ldsV + (4 * hi + ((lane & 15) >> 2)) * AV_PITCH + ((lane >> 4) & 1) * 32 + (lane & 3) * 8;
#pragma unroll
            for (int s = 0; s < 4; ++s)
#pragma unroll
                for (int db = 0; db < 4; ++db) {
                    const s16x4 lo = vtr(vb + (16 * s) * AV_PITCH + db * 64), hh = vtr(vb + (16 * s + 8) * AV_PITCH + db * 64);
                    const bf16x8 a = {lo[0], lo[1], lo[2], lo[3], hh[0], hh[1], hh[2], hh[3]};
                    o[db] = __builtin_amdgcn_mfma_f32_32x32x16_bf16(a, pb[s], o[db], 0, 0, 0);
                }
        }
    }
#undef ATT_LOAD
    const float ltot = lrun + __shfl_xor(lrun, 32), inv = 1.0f / ltot;
    bf16* YC = WSP(bf16, WS_H) + qrow * DM + 512 + h * 128;
    const bf16* zb = P + qrow * DIN + C_ZB + h * 128;
#pragma unroll
    for (int db = 0; db < 4; ++db)
#pragma unroll
        for (int rg = 0; rg < 4; ++rg) { const int d = 32 * db + 8 * rg + 4 * hi;
            const u32x2 z = *(const u32x2*)(zb + d);
            u32x2 wv; wv.x = pk2(o[db][4 * rg] * inv * bflo(z.x), o[db][4 * rg + 1] * inv * bfhi(z.x)); wv.y = pk2(o[db][4 * rg + 2] * inv * bflo(z.y), o[db][4 * rg + 3] * inv * bfhi(z.y));
            *(u32x2*)(YC + d) = wv; }
}

__device__ __forceinline__ void ssm_stage_u(Frame& F, int g, int rowbase) {
    const bf16* P = WSP(bf16, WS_P);
#pragma unroll
    for (int q = 0; q < 8; ++q) { const int c = F.tid + 512 * q, hh = c & 1, tok = c >> 1, n = tok >> 5, j = tok & 31;
        const u32x4 v = *(const u32x4*)(P + (size_t)(rowbase + tok) * DIN + C_XA + g * 16 + hh * 8);
        *(LAS u32x4*)(F.lds + ((j * 64 + n) * 32 + hh * 16)) = v; }
}
__device__ __forceinline__ void ssm_unit(Frame& F, int l, int g, int tb) {
    const int lane = F.lane, w = F.wave, r32 = lane & 31, hi = lane >> 5, tid = F.tid;
    const int unit = g * 4 + tb;
    const int rowblk = tb * 4096;
    const bool ctx = tb < 2;
    const int nchunk = ctx ? 8 : 128;
    float* Fb = WSP(float, WS_F) + (size_t)unit * 128 * 256;
    bf16* Sb = WSP(bf16, WS_SIN) + (size_t)unit * 128 * 256;
    const bf16* WF = WSP(bf16, WS_WF) + (size_t)(l * 32 + g) * 131072;
    const bf16* WY = WSP(bf16, WS_WY) + (size_t)(l * 32 + g) * 131072;
    LAS unsigned char* ldsU = F.lds;
    LAS unsigned char* ldsL = F.lds + 65536;
    __syncthreads();
    { const u32x4* src = (const u32x4*)(WSP(bf16, WS_LAG) + (size_t)(l * 32 + g) * 16384);
      for (int i = tid; i < 63 * 32; i += NT) *(LAS u32x4*)(ldsL + i * 16) = src[i]; }
    for (int half = 0; half < 2; ++half) {
        __syncthreads();
        ssm_stage_u(F, g, rowblk + half * 2048);
        __syncthreads();
        f32x16 acc[2];
#pragma unroll
        for (int r = 0; r < 16; ++r) { acc[0][r] = 0.f; acc[1][r] = 0.f; }
        const bf16* wfr = WF + (size_t)(32 * w + r32) * 512 + hi * 8;
#pragma unroll 8
        for (int j = 0; j < 32; ++j) {
            const bf16x8 a = *(const bf16x8*)(wfr + 16 * j);
            const bf16x8 b0 = *(const LAS bf16x8*)(ldsU + (j * 64 + r32) * 32 + hi * 16), b1 = *(const LAS bf16x8*)(ldsU + (j * 64 + 32 + r32) * 32 + hi * 16);
            acc[0] = __builtin_amdgcn_mfma_f32_32x32x16_bf16(a, b0, acc[0], 0, 0, 0);
            acc[1] = __builtin_amdgcn_mfma_f32_32x32x16_bf16(a, b1, acc[1], 0, 0, 0);
        }
#pragma unroll
        for (int ib = 0; ib < 2; ++ib)
#pragma unroll
            for (int rg = 0; rg < 4; ++rg) { float* o = Fb + (size_t)(half * 64 + ib * 32 + r32) * 256 + 32 * w + 8 * rg + 4 * hi;
                *(f32x4*)o = (f32x4){acc[ib][4 * rg], acc[ib][4 * rg + 1], acc[ib][4 * rg + 2], acc[ib][4 * rg + 3]}; }
    }
    __syncthreads();
    { const int nseq = ctx ? 16 : 1;
      const float* at = WSP(float, WS_AT) + (size_t)((l * 32 + g) * 2) * 128;
      for (int it = tid; it < nseq * 128; it += NT) {
          const int sq = it >> 7, d = (it >> 6) & 1, p = it & 63;
          const float ar = at[d * 128 + p], ai = at[d * 128 + 64 + p];
          float sr = 0.f, si = 0.f;
          if (!ctx) { const float* s0 = F.in(4  ) + (size_t)((((tb - 2) * 2 + l) * 2 + d) * 2) * 2048 + g * 64 + p; sr = s0[0]; si = s0[2048]; }
          for (int cI = 0; cI < nchunk; ++cI) {
              const int cc = d ? (nchunk - 1 - cI) : cI, n = sq * nchunk + cc;
              bf16* so = Sb + (size_t)n * 256 + d * 128 + p; so[0] = (bf16)f2bf(sr); so[64] = (bf16)f2bf(si);
              const float* f = Fb + (size_t)n * 256 + d * 128 + p; const float fr_ = f[0], fi_ = f[64];
              const float nr = ar * sr - ai * si + fr_, ni = ar * si + ai * sr + fi_; sr = nr; si = ni;
          }
          if (ctx) { const int bb = tb * 16 + sq; float* o = F.out + (size_t)M * DM + 2 * (size_t)(32 * 2 * 256 * 256) + (size_t)((((bb * 2 + l) * 2 + d) * 2) * 2048) + g * 64 + p; o[0] = sr; o[2048] = si; }
      } }
    bf16* YG = WSP(bf16, WS_YG);
    for (int half = 0; half < 2; ++half) {
        __syncthreads();
        ssm_stage_u(F, g, rowblk + half * 2048);
        __syncthreads();
        f32x16 acc[2][2];
#pragma unroll
        for (int a_ = 0; a_ < 2; ++a_)
#pragma unroll
            for (int b_ = 0; b_ < 2; ++b_)
#pragma unroll
                for (int r = 0; r < 16; ++r) acc[a_][b_][r] = 0.f;
        const LAS unsigned char* lagp = ldsL + (r32 & 15) * 32 + hi * 16;
#pragma unroll 4
        for (int j = 0; j < 32; ++j) {
            const bf16x8 b0 = *(const LAS bf16x8*)(ldsU + (j * 64 + r32) * 32 + hi * 16), b1 = *(const LAS bf16x8*)(ldsU + (j * 64 + 32 + r32) * 32 + hi * 16);
#pragma unroll
            for (int rr = 0; rr < 2; ++rr) { const int i = 2 * (2 * w + rr) + (r32 >> 4);
                const bf16x8 a = *(const LAS bf16x8*)(lagp + (i - j + 31) * 512);
                acc[rr][0] = __builtin_amdgcn_mfma_f32_32x32x16_bf16(a, b0, acc[rr][0], 0, 0, 0);
                acc[rr][1] = __builtin_amdgcn_mfma_f32_32x32x16_bf16(a, b1, acc[rr][1], 0, 0, 0); }
        }
#pragma unroll 4
        for (int ks = 0; ks < 16; ++ks) {
            const bf16x8 b0 = *(const bf16x8*)(Sb + (size_t)(half * 64 + r32) * 256 + 16 * ks + hi * 8), b1 = *(const bf16x8*)(Sb + (size_t)(half * 64 + 32 + r32) * 256 + 16 * ks + hi * 8);
#pragma unroll
            for (int rr = 0; rr < 2; ++rr) {
                const bf16x8 a = *(const bf16x8*)(WY + (size_t)(32 * (2 * w + rr) + r32) * 256 + 16 * ks + hi * 8);
                acc[rr][0] = __builtin_amdgcn_mfma_f32_32x32x16_bf16(a, b0, acc[rr][0], 0, 0, 0);
                acc[rr][1] = __builtin_amdgcn_mfma_f32_32x32x16_bf16(a, b1, acc[rr][1], 0, 0, 0); }
        }
#pragma unroll
        for (int rr = 0; rr < 2; ++rr)
#pragma unroll
            for (int ib = 0; ib < 2; ++ib)
#pragma unroll
                for (int rg = 0; rg < 4; ++rg) { const int i = 2 * (2 * w + rr) + (rg >> 1), c = 8 * (rg & 1) + 4 * hi, n = ib * 32 + r32;
                    const size_t row = (size_t)(rowblk + half * 2048 + n * 32 + i);
                    u32x2 wv; wv.x = pk2(geluf_(acc[rr][ib][4 * rg]), geluf_(acc[rr][ib][4 * rg + 1])); wv.y = pk2(geluf_(acc[rr][ib][4 * rg + 2]), geluf_(acc[rr][ib][4 * rg + 3]));
                    *(u32x2*)(YG + row * 512 + g * 16 + c) = wv; }
    }
}

constexpr int SG_PITCH = 272;
__device__ __forceinline__ void sgu_unit(Frame& F, int l, int ck, int g) {
    const int lane = F.lane, w = F.wave, r32 = lane & 31, hi = lane >> 5, tid = F.tid;
    const bf16* P = WSP(bf16, WS_P);
    const int row0 = ck * 128;
    LAS unsigned char* vnt = F.lds;
    __syncthreads();
    {
      const int q = tid >> 2, qq = tid & 3;
      const bf16* vrow = P + (size_t)(row0 + q) * DIN + C_VS + qq * 32;
      u32x4 mine[4]; float s = 0.f, s2 = 0.f;
#pragma unroll
      for (int gg = 0; gg < 4; ++gg)
#pragma unroll
          for (int k = 0; k < 4; ++k) { const u32x4 v = *(const u32x4*)(vrow + gg * 128 + k * 8); if (gg == g) mine[k] = v;
              const float f0 = bflo(v.x), f1 = bfhi(v.x), f2 = bflo(v.y), f3 = bfhi(v.y), f4 = bflo(v.z), f5 = bfhi(v.z), f6 = bflo(v.w), f7 = bfhi(v.w);
              s += ((f0 + f1) + (f2 + f3)) + ((f4 + f5) + (f6 + f7)); s2 += ((f0 * f0 + f1 * f1) + (f2 * f2 + f3 * f3)) + ((f4 * f4 + f5 * f5) + (f6 * f6 + f7 * f7)); }
      s += __shfl_xor(s, 1); s += __shfl_xor(s, 2); s2 += __shfl_xor(s2, 1); s2 += __shfl_xor(s2, 2);
      const float mean = s * (1.f / 512.f), var = fmaxf(s2 * (1.f / 512.f) - mean * mean, 0.f), rstd = 1.f / sqrtf(var + LN_EPS);
      const float* lgp = F.in(21  ) + l * 512 + g * 128 + qq * 32; const float* lbp = F.in(22  ) + l * 512 + g * 128 + qq * 32;
#pragma unroll
      for (int k = 0; k < 4; ++k) { const unsigned ww[4] = {mine[k].x, mine[k].y, mine[k].z, mine[k].w};
#pragma unroll
          for (int e = 0; e < 4; ++e) { const int c = qq * 32 + k * 8 + e * 2;
              const float v0 = (bflo(ww[e]) - mean) * rstd * lgp[k * 8 + e * 2] + lbp[k * 8 + e * 2], v1 = (bfhi(ww[e]) - mean) * rstd * lgp[k * 8 + e * 2 + 1] + lbp[k * 8 + e * 2 + 1];
              *(LAS unsigned short*)(vnt + c * SG_PITCH + q * 2) = (unsigned short)f2bf(v0); *(LAS unsigned short*)(vnt + (c + 1) * SG_PITCH + q * 2) = (unsigned short)f2bf(v1); } }
    }
    __syncthreads();
    const int pb = w >> 1, cb0 = 2 * (w & 1);
    const bf16* Ws = WSP(bf16, WS_WS) + (size_t)((l * 4 + g) * 128 + 32 * pb + r32) * 128 + hi * 8;
    f32x16 acc[2];
#pragma unroll
    for (int r = 0; r < 16; ++r) { acc[0][r] = 0.f; acc[1][r] = 0.f; }
#pragma unroll
    for (int ks = 0; ks < 8; ++ks) {
        const bf16x8 a = *(const bf16x8*)(Ws + 16 * ks);
        const bf16x8 b0 = *(const LAS bf16x8*)(vnt + (32 * cb0 + r32) * SG_PITCH + (16 * ks + 8 * hi) * 2), b1 = *(const LAS bf16x8*)(vnt + (32 * (cb0 + 1) + r32) * SG_PITCH + (16 * ks + 8 * hi) * 2);
        acc[0] = __builtin_amdgcn_mfma_f32_32x32x16_bf16(a, b0, acc[0], 0, 0, 0);
        acc[1] = __builtin_amdgcn_mfma_f32_32x32x16_bf16(a, b1, acc[1], 0, 0, 0);
    }
    bf16* YC = WSP(bf16, WS_H);
    const float* bs = F.in(24  ) + (l * 4 + g) * 128;
#pragma unroll
    for (int cbi = 0; cbi < 2; ++cbi)
#pragma unroll
        for (int r = 0; r < 16; ++r) { const int p = 32 * pb + crow(r, hi), c = 32 * (cb0 + cbi) + r32; const size_t row = (size_t)(row0 + p);
            const float u = bf2f(P[row * DIN + C_U + g * 128 + c]), z = bf2f(P[row * DIN + C_ZC + g * 128 + c]);
            YC[row * DM + 1536 + g * 128 + c] = (bf16)f2bf((acc[cbi][r] + bs[p]) * u * z); }
}

#ifndef PHASE_MASK
#define PHASE_MASK 0xff
#endif
#define PM(k) ((PHASE_MASK >> (k)) & 1)
#ifndef UNIT_MASK
#define UNIT_MASK 7
#endif
#define UM(k) ((UNIT_MASK >> (k)) & 1)
#ifndef REPEAT_PHASE
#define REPEAT_PHASE -1
#endif
constexpr int N_PHASES = 14;
__global__ void __launch_bounds__(NT, 2) fwd_kernel(Args args) {
    extern __shared__ __attribute__((aligned(16))) unsigned char lds[];
    Frame F;
    F.lds = (LAS unsigned char*)lds;
    F.MISC = (volatile LAS unsigned*)(F.lds + MISC_OFF);
    F.tid = threadIdx.x; F.lane = F.tid & 63; F.wave = __builtin_amdgcn_readfirstlane(F.tid >> 6);
    F.G = gridDim.x; F.bid = blockIdx.x;
    F.ws = args.ws; F.out = args.out; F.ctl = (unsigned*)(args.ws + WS_CTL);
    F.ka = (KArgs)__builtin_amdgcn_kernarg_segment_ptr();
    for (int u = F.tid; u < (LDS_BYTES - LDSCTL_OFF) / 4; u += NT) ((LAS unsigned*)(F.lds + LDSCTL_OFF))[u] = 0u;
    __syncthreads();
    XcdBarrier bar = xcd_barrier_post((unsigned*)(F.ctl + CW_BAR), F.MISC + 8);
    const int lo = args.ph_lo, hi = args.ph_hi;
#define IN(k) (lo <= (k) && (k) < hi)
#define FRESH() do { asm volatile("" : "+s"(F.ka)); asm volatile("" : "+v"(F.tid)); F.lane = F.tid & 63; F.wave = __builtin_amdgcn_readfirstlane(F.tid >> 6); } while (0)
#define SEAM(k) do { if (IN(k) && IN((k) + 1)) xcd_barrier(bar); } while (0)

#define REPS(k) ((REPEAT_PHASE == (k)) ? 2 : 1)
#define RSEAM(k) do { if (rep + 1 < REPS(k)) xcd_barrier(bar); } while (0)
    if (PM(0) && IN(0)) for (int rep = 0; rep < REPS(0); ++rep) { FRESH(); p0_prologue(F); RSEAM(0); }
    SEAM(0);
    if (PM(1) && IN(1)) for (int rep = 0; rep < REPS(1); ++rep) { FRESH(); p1_lnmod(F); RSEAM(1); }
    SEAM(1);
    for (int l = 0; l < 2; ++l) {
        const int pb = 2 + 6 * l;
        if (PM(2) && IN(pb)) for (int rep = 0; rep < REPS(2) - l * (REPS(2) - 1); ++rep) { FRESH();
            pg8::Gemm g{WSP(bf16, WS_H), WSP(bf16, WS_WIN) + (size_t)l * DIN * 2048, M, DIN, DM}; pg8::StaticOrder S; S.init(M, DIN, F.G, F.bid);
            float* okv = F.out + (size_t)M * DM + (size_t)l * 256 * 256;
            pg8::EpiInProj E{WSP(bf16, WS_P), okv, okv + (size_t)32 * 2 * 256 * 256, WSP(float, WS_ROPE)};
            pg8::gemm_phase<pg8::EpiInProj, pg8::StaticOrder, true, true>(F.lds, g, S, E);
            RSEAM(2);
        }
        SEAM(pb);
        if (PM(3) && IN(pb + 1)) for (int rep = 0; rep < REPS(3) - l * (REPS(3) - 1); ++rep) {
            for (;;) {
                int u = wq_next(F, pb + 1 + 32 * rep); FRESH();
                if (u >= 1152) break;
                if (u < 256) { if (UM(0)) attn_unit(F, l, 1, u >> 7, (u >> 4) & 7, u & 15); continue; } u -= 256;
                if (u < 128) { if (UM(1)) ssm_unit(F, l, u >> 2, u & 3); continue; } u -= 128;
                if (u < 256) { if (UM(0)) attn_unit(F, l, 0, u >> 3, u & 7, 0); continue; } u -= 256;
                if (UM(2)) sgu_unit(F, l, u >> 2, u & 3);
            }
            __syncthreads();
            RSEAM(3);
        }
        SEAM(pb + 1);
        if (PM(4) && IN(pb + 2)) for (int rep = 0; rep < REPS(4) - l * (REPS(4) - 1); ++rep) { FRESH();
            for (int t = F.bid; t < 128; t += F.G) {
                pg8::Gemm g{WSP(bf16, WS_YG), WSP(bf16, WS_WGLU) + (size_t)l * 512 * 512, M, 512, 512}; pg8::OneUnit S{{t >> 1, t & 1}};
                pg8::EpiGlu E{WSP(bf16, WS_YG), WSP(bf16, WS_P), WSP(bf16, WS_H), F.in(19  ) + l * 512};
                pg8::gemm_phase<pg8::EpiGlu, pg8::OneUnit, false, true>(F.lds, g, S, E);
            }
            RSEAM(4);
        }
        SEAM(pb + 2);
        if (PM(5) && IN(pb + 3)) for (int rep = 0; rep < REPS(5) - l * (REPS(5) - 1); ++rep) { FRESH();
            pg8::Gemm g{WSP(bf16, WS_H), WSP(bf16, WS_WP) + (size_t)l * 2048 * 2048, M, DM, DM}; pg8::StaticOrder S; S.init(M, DM, F.G, F.bid);
            pg8::EpiMerge E{WSP(bf16, WS_P), WSP(bf16, WS_MRG)};
            pg8::gemm_phase<pg8::EpiMerge, pg8::StaticOrder, true, true>(F.lds, g, S, E);
            RSEAM(5);
        }
        SEAM(pb + 3);
        if (PM(6) && IN(pb + 4)) for (int rep = 0; rep < REPS(6) - l * (REPS(6) - 1); ++rep) { FRESH();
            pg8::Gemm g{WSP(bf16, WS_MRG), WSP(bf16, WS_WOUT) + (size_t)l * 2048 * 2048, M, DM, DM}; pg8::StaticOrder S; S.init(M, DM, F.G, F.bid);
            const float* xa = (l == 0) ? F.in(0  ) : F.out; const float* xb = (l == 0) ? F.in(1  ) : (F.out + (size_t)MCTX * DM);
            pg8::EpiOut E{xa, xb, F.out, WSP(float, WS_MOD) + (size_t)l * 3 * 6144};
            pg8::gemm_phase<pg8::EpiOut, pg8::StaticOrder, true, true>(F.lds, g, S, E);
            RSEAM(6);
        }
        SEAM(pb + 4);
        if (PM(7) && IN(pb + 5)) { FRESH(); pg_postln(F, l); }
        if (l == 0) SEAM(pb + 5);
    }
#undef IN
#undef SEAM
}

#ifndef N_LAUNCH_MODE
#define N_LAUNCH_MODE 0
#endif
extern "C" void kernel_launch(void* const* d_in, const int* in_sizes, int n_in, void* d_out, int out_size, void* d_ws, size_t ws_size, hipStream_t stream) {
    static int grid = 0;
    if (grid == 0) {
        if (n_in != 31 || ws_size < WS_END) { fprintf(stderr, "kernel_launch: need 31 inputs and >= %zu bytes of workspace; got %d, %zu\n", (size_t)WS_END, n_in, ws_size); grid = -1; return; }
        int dev = 0, cus = 0, per_cu = 0;
        if (hipGetDevice(&dev) != hipSuccess || hipDeviceGetAttribute(&cus, hipDeviceAttributeMultiprocessorCount, dev) != hipSuccess) { grid = -1; return; }
        if (hipFuncSetAttribute((const void*)fwd_kernel, hipFuncAttributeMaxDynamicSharedMemorySize, LDS_BYTES) != hipSuccess) { fprintf(stderr, "kernel_launch: hipFuncSetAttribute failed\n"); grid = -1; return; }
        if (hipOccupancyMaxActiveBlocksPerMultiprocessor(&per_cu, (const void*)fwd_kernel, NT, LDS_BYTES) != hipSuccess || per_cu < 1) { fprintf(stderr, "kernel_launch: occupancy query says %d\n", per_cu); (void)hipGetLastError(); grid = -1; return; }
        grid = cus;
    }
    if (grid < 0) return;
    (void)hipMemsetAsync((char*)d_ws + WS_CTL, 0, CTL_ZERO_BYTES, stream);
    Args a{};
    for (int i = 0; i < 31; ++i) a.in[i] = (const float*)d_in[i];
    a.out = (float*)d_out; a.ws = (unsigned char*)d_ws;
#if N_LAUNCH_MODE == 0
    a.ph_lo = 0; a.ph_hi = N_PHASES;
    { void* params[] = {&a}; (void)params; hipLaunchKernelGGL(fwd_kernel, dim3(grid), dim3(NT), LDS_BYTES, stream, a); hipError_t e = hipPeekAtLastError();
      if (e != hipSuccess) fprintf(stderr, "launch failed: %s\n", hipGetErrorString(e)); }
#else
    for (int p = 0; p < N_PHASES; ++p) { a.ph_lo = p; a.ph_hi = p + 1;
        void* params[] = {&a}; hipError_t e = hipLaunchCooperativeKernel((const void*)fwd_kernel, dim3(grid), dim3(NT), params, LDS_BYTES, stream);
        if (e != hipSuccess) { fprintf(stderr, "launch %d failed: %s\n", p, hipGetErrorString(e)); break; } }
#endif
}
```

```cpp
#include <hip/hip_runtime.h>
#include <hip/hip_cooperative_groups.h>
#include <cstdio>
#include <cstdint>
#include <cmath>
namespace cg = cooperative_groups;

#define GAS __attribute__((address_space(1)))
#define LAS __attribute__((address_space(3)))
typedef unsigned short bf16;
typedef short bf16x8 __attribute__((ext_vector_type(8)));
typedef short s16x4 __attribute__((ext_vector_type(4)));
typedef float f32x2 __attribute__((ext_vector_type(2)));
typedef float f32x4 __attribute__((ext_vector_type(4)));
typedef float f32x16 __attribute__((ext_vector_type(16)));
typedef unsigned u32x2 __attribute__((ext_vector_type(2)));
typedef unsigned u32x4 __attribute__((ext_vector_type(4)));
typedef __bf16 bf16x2_t __attribute__((ext_vector_type(2)));

constexpr int DM = 2048, M = 16384, MCTX = 8192, DIN = 11264, NW = 8, NT = 512;
constexpr int C_XA = 0, C_ZA = 512, C_Q = 1024, C_K = 2048, C_V = 2304, C_ZB = 2560, C_U = 3584, C_VS = 4096, C_ZC = 4608, C_MG = 5120;
constexpr float LN_EPS = 1e-5f;
constexpr float DN_ALPHA = 1.41421356237309515f;
constexpr float LOG2E = 1.4426950408889634f;
constexpr float QSCALE = 0.08838834764831845f * LOG2E;
constexpr int TCH = 32;

constexpr size_t MiB = 1u << 20;
constexpr size_t WS_CTL = 0, CTL_ZERO_BYTES = 1 * MiB;
constexpr size_t WS_MODP = 1 * MiB;
constexpr size_t WS_ROPE = 6 * MiB;
constexpr size_t WS_AT = 6 * MiB + 65536;
constexpr size_t WS_MOD = 6 * MiB + 262144;
constexpr size_t WS_WS = 7 * MiB;
constexpr size_t WS_CK = 8 * MiB;
constexpr size_t WS_CV = 8 * MiB + 524288;
constexpr size_t WS_LAG = 9 * MiB;
constexpr size_t WS_WF = 11 * MiB;
constexpr size_t WS_WY = 27 * MiB;
constexpr size_t WS_WGLU = 43 * MiB;
constexpr size_t WS_WP = 44 * MiB;
constexpr size_t WS_WOUT = 60 * MiB;
constexpr size_t WS_WIN = 76 * MiB;
constexpr size_t WS_H = 164 * MiB;
constexpr size_t WS_MRG = 228 * MiB;
constexpr size_t WS_YG = 292 * MiB;
constexpr size_t WS_F = 308 * MiB;
constexpr size_t WS_SIN = 324 * MiB;
constexpr size_t WS_P = 332 * MiB;
constexpr size_t WS_END = 684 * MiB;
constexpr int CW_WQ = 64;
constexpr int CW_BAR = 8192;

constexpr int RING_BYTES = 131072;
constexpr int LDSCTL_OFF = RING_BYTES, MISC_OFF = LDSCTL_OFF + 320;
constexpr int LDS_BYTES = 147456;

__device__ __forceinline__ unsigned f2bf(float f) { unsigned u = __builtin_bit_cast(unsigned, f); return (u + 0x7fffu + ((u >> 16) & 1u)) >> 16; }
__device__ __forceinline__ unsigned pk2(float lo, float hi) { f32x2 v = {lo, hi}; bf16x2_t b = __builtin_convertvector(v, bf16x2_t); return __builtin_bit_cast(unsigned, b); }
__device__ __forceinline__ float bf2f(unsigned short h) { return __builtin_bit_cast(float, (unsigned)h << 16); }
__device__ __forceinline__ float bflo(unsigned w) { return __builtin_bit_cast(float, w << 16); }
__device__ __forceinline__ float bfhi(unsigned w) { return __builtin_bit_cast(float, w & 0xffff0000u); }
__device__ __forceinline__ float sigmoidf_(float x) { return __builtin_amdgcn_rcpf(1.0f + __expf(-x)); }
__device__ __forceinline__ float siluf_(float x) { return x * __builtin_amdgcn_rcpf(1.0f + __expf(-x)); }
__device__ __forceinline__ float geluf_(float x) { const float z = 1.5957691216057308f * (x + 0.044715f * x * x * x); return x * __builtin_amdgcn_rcpf(1.0f + __expf(-z)); }
__device__ __forceinline__ float wave_sum(float v) {
#pragma unroll
    for (int o = 1; o < 64; o <<= 1) v += __shfl_xor(v, o);
    return v;
}
#define LDS_WAIT() asm volatile("s_waitcnt lgkmcnt(0)" ::: "memory")
#define VM_WAIT() asm volatile("s_waitcnt vmcnt(0)" ::: "memory")
namespace pg8 {
#define PG8_LAS __attribute__((address_space(3)))
typedef unsigned short bf16_t;
typedef short bf16x8 __attribute__((ext_vector_type(8)));
typedef float f32x4 __attribute__((ext_vector_type(4)));
typedef unsigned u32x4 __attribute__((ext_vector_type(4)));
constexpr int BM = 256, BK = 64, HALF = 128, HTB = HALF * BK * 2  , STAGE_BYTES = 8 * HTB, NXCD = 8, WGM = 8;

__host__ __device__ __forceinline__ int lds_byte(int r, int c) { const int st = (r >> 4) * 2 + (c >> 5), rr = r & 15, cc = c & 31, ob = rr * 64 + cc * 2; return st * 1024 + (ob ^ (((ob >> 9) & 1) << 5)); }
__host__ __device__ __forceinline__ void stage_rc(int b, int& R, int& C) { const int st = b / 1024, sb = b % 1024, swz = sb ^ (((sb >> 9) & 1) << 5); R = (st >> 1) * 16 + swz / 64; C = (st & 1) * 32 + (swz % 64) / 2; }
__host__ __device__ __forceinline__ int perm32(int rho) { const int n = rho >> 4, i = rho & 15; return 8 * (i >> 2) + 4 * n + (i & 3); }

struct Unit { int pm, pn; };
struct Gemm { const bf16_t* A; const bf16_t* Bt; int M, N, K; };

struct StaticOrder {
    int nM, nN, nwg, G, c;
    __host__ __device__ void init(int M, int N, int G_, int c_) { nM = M / BM; nN = N / BM; nwg = nM * nN; G = G_; c = c_; }
    __host__ __device__ bool next(int i, Unit& u) const {
        const long L = (long)i * G + c; if (L >= nwg) return false;
        int wgid = (int)L; { const int q = nwg / NXCD, r = nwg % NXCD, xcd = wgid % NXCD, off = wgid / NXCD; wgid = (xcd < r ? xcd * (q + 1) : r * (q + 1) + (xcd - r) * q) + off; }
        const int nig = WGM * nN, gid = wgid / nig, fm = gid * WGM, gsz = (nM - fm) < WGM ? (nM - fm) : WGM;
        u.pm = fm + ((wgid % nig) % gsz); u.pn = (wgid % nig) / gsz; return true;
    }
    __device__ __forceinline__ void a_ready(const Unit&) const {}
    __device__ __forceinline__ void done(const Unit&) const {}
};


struct OneUnit {
    Unit u;
    __device__ __forceinline__ bool next(int i, Unit& o) const { if (i != 0) return false; o = u; return true; }
    __device__ __forceinline__ void a_ready(const Unit&) const {}
    __device__ __forceinline__ void done(const Unit&) const {}
};

struct EpiInProj {
    static constexpr bool PERM = true, AFTER_DRAIN = false, HAS_MID = false;
    bf16_t* P; float* outk; float* outv; const float* rope;
    __device__ __forceinline__ void operator()(const f32x4 (&acc)[2][2][4][2], const Unit& u, int wr, int wc, int fr, int fq) const {
        const int pn = u.pn;
        int kind;
        if (pn < 2) kind = 0; else if (pn < 4) kind = 1; else if (pn < 8) kind = 4; else if (pn == 8) kind = 5; else if (pn == 9) kind = 6;
        else if (pn < 14) kind = 1; else if (pn < 18) kind = 2; else if (pn < 20) kind = 1; else kind = 3;
        const bool lat = u.pm >= 32;
        int row0 = u.pm * BM + wr * 64 + fr; asm volatile("" : "+v"(row0)); const int colL = wc * 32 + 8 * fq;
        const int p0 = wc * 16 + 4 * fq;
        const int j0 = (wc < 2) ? p0 : p0 - 32;
        const int dbase = (wc < 2) ? p0 : p0 + 32;
#pragma unroll
        for (int ai = 0; ai < 2; ++ai)
#pragma unroll
            for (int m = 0; m < 4; ++m) {
                const int row = row0 + ai * HALF + m * 16;
                bf16_t* rowp = P + (size_t)row * DIN + pn * BM + colL;
                f32x4 cs0 = {1.f, 0.f, 1.f, 0.f}, cs1 = {1.f, 0.f, 1.f, 0.f};
                if ((kind == 4 || kind == 5) && lat) {
                    const int t = (row - MCTX) & 4095; const int pos = (wc < 2) ? (t >> 6) : (t & 63);
                    const float* rp = rope + (size_t)(pos * 32 + j0) * 2; cs0 = *(const f32x4*)rp; cs1 = *(const f32x4*)(rp + 4);
                }
#pragma unroll
                for (int bj = 0; bj < 2; ++bj) {
                    f32x4 v0 = acc[ai][bj][m][0], v1 = acc[ai][bj][m][1];
                    if (kind == 1) { for (int e = 0; e < 4; ++e) { v0[e] = siluf_(v0[e]); v1[e] = siluf_(v1[e]); } }
                    else if (kind == 2) { for (int e = 0; e < 4; ++e) { v0[e] = geluf_(v0[e]); v1[e] = geluf_(v1[e]); } }
                    else if (kind == 3) { for (int e = 0; e < 4; ++e) { v0[e] = sigmoidf_(fminf(fmaxf(v0[e], -30.f), 30.f)); v1[e] = sigmoidf_(fminf(fmaxf(v1[e], -30.f), 30.f)); } }
                    else if (kind == 4 || kind == 5) {
                        if (kind == 5 && !lat) {
                            const int b = row >> 8, t = row & 255;
                            float* o = outk + (size_t)b * (2 * 256 * 256) + t * 256 + bj * 128 + dbase;
                            *(f32x4*)o = (f32x4){v0[0], v0[2], v1[0], v1[2]}; *(f32x4*)(o + 32) = (f32x4){v0[1], v0[3], v1[1], v1[3]};
                        }
                        const float sc = (kind == 4) ? QSCALE : 1.0f;
                        f32x4 w0, w1;
                        w0[0] = (v0[0] * cs0[0] - v0[1] * cs0[1]) * sc; w0[1] = (v0[0] * cs0[1] + v0[1] * cs0[0]) * sc;
                        w0[2] = (v0[2] * cs0[2] - v0[3] * cs0[3]) * sc; w0[3] = (v0[2] * cs0[3] + v0[3] * cs0[2]) * sc;
                        w1[0] = (v1[0] * cs1[0] - v1[1] * cs1[1]) * sc; w1[1] = (v1[0] * cs1[1] + v1[1] * cs1[0]) * sc;
                        w1[2] = (v1[2] * cs1[2] - v1[3] * cs1[3]) * sc; w1[3] = (v1[2] * cs1[3] + v1[3] * cs1[2]) * sc;
                        v0 = w0; v1 = w1;
                    } else if (kind == 6) {
                        if (!lat) { const int b = row >> 8, t = row & 255; float* o = outv + (size_t)b * (2 * 256 * 256) + t * 256 + bj * 128 + colL; *(f32x4*)o = v0; *(f32x4*)(o + 4) = v1; }
                    }
                    u32x4 w; w.x = pk2(v0[0], v0[1]); w.y = pk2(v0[2], v0[3]); w.z = pk2(v1[0], v1[1]); w.w = pk2(v1[2], v1[3]);
                    *(u32x4*)(rowp + bj * HALF) = w;
                }
            }
    }
};

struct EpiGlu {
    static constexpr bool PERM = true, AFTER_DRAIN = false, HAS_MID = false;
    const bf16_t* YG; const bf16_t* P; bf16_t* YC; const float* bias;
    __device__ __forceinline__ void operator()(const f32x4 (&acc)[2][2][4][2], const Unit& u, int wr, int wc, int fr, int fq) const {
        int row0 = u.pm * BM + wr * 64 + fr; asm volatile("" : "+v"(row0)); const int col0 = u.pn * BM + wc * 32 + 8 * fq;
#pragma unroll
        for (int bj = 0; bj < 2; ++bj) {
            const int col = col0 + bj * HALF;
            const f32x4 b0 = *(const f32x4*)(bias + col), b1 = *(const f32x4*)(bias + col + 4);
#pragma unroll
            for (int ai = 0; ai < 2; ++ai)
#pragma unroll
                for (int m = 0; m < 4; ++m) {
                    const int row = row0 + ai * HALF + m * 16;
                    const u32x4 yg = *(const u32x4*)(YG + (size_t)row * 512 + col);
                    const u32x4 za = *(const u32x4*)(P + (size_t)row * DIN + C_ZA + col);
                    const f32x4 v0 = acc[ai][bj][m][0] + b0, v1 = acc[ai][bj][m][1] + b1;
                    u32x4 w;
                    w.x = pk2(bflo(yg.x) * sigmoidf_(v0[0]) * bflo(za.x), bfhi(yg.x) * sigmoidf_(v0[1]) * bfhi(za.x));
                    w.y = pk2(bflo(yg.y) * sigmoidf_(v0[2]) * bflo(za.y), bfhi(yg.y) * sigmoidf_(v0[3]) * bfhi(za.y));
                    w.z = pk2(bflo(yg.z) * sigmoidf_(v1[0]) * bflo(za.z), bfhi(yg.z) * sigmoidf_(v1[1]) * bfhi(za.z));
                    w.w = pk2(bflo(yg.w) * sigmoidf_(v1[2]) * bflo(za.w), bfhi(yg.w) * sigmoidf_(v1[3]) * bfhi(za.w));
                    *(u32x4*)(YC + (size_t)row * DM + col) = w;
                }
        }
    }
};

struct EpiMerge {
    static constexpr bool PERM = true, AFTER_DRAIN = false, HAS_MID = true;
    const bf16_t* P; bf16_t* O;
    __device__ __forceinline__ bool is_mid(int t) const { return t == 8 || t == 24; }
    __device__ __forceinline__ void mid(f32x4 (&acc)[2][2][4][2], const Unit& u, int wr, int wc, int fr, int fq, int t) const {
        const int s = (t == 8) ? 0 : 1;
        int row0 = u.pm * BM + wr * 64 + fr; asm volatile("" : "+v"(row0)); const int col0 = u.pn * BM + wc * 32 + 8 * fq;
#pragma unroll
        for (int ai = 0; ai < 2; ++ai)
#pragma unroll
            for (int m = 0; m < 4; ++m) {
                const bf16_t* gp = P + (size_t)(row0 + ai * HALF + m * 16) * DIN + C_MG + s * 2048 + col0;
#pragma unroll
                for (int bj = 0; bj < 2; ++bj) {
                    const u32x4 gn = *(const u32x4*)(gp + bj * HALF), gd = *(const u32x4*)(gp + 2048 + bj * HALF);
                    f32x4 r0, r1;
                    r0[0] = bflo(gn.x) * __builtin_amdgcn_rcpf(bflo(gd.x)); r0[1] = bfhi(gn.x) * __builtin_amdgcn_rcpf(bfhi(gd.x)); r0[2] = bflo(gn.y) * __builtin_amdgcn_rcpf(bflo(gd.y)); r0[3] = bfhi(gn.y) * __builtin_amdgcn_rcpf(bfhi(gd.y));
                    r1[0] = bflo(gn.z) * __builtin_amdgcn_rcpf(bflo(gd.z)); r1[1] = bfhi(gn.z) * __builtin_amdgcn_rcpf(bfhi(gd.z)); r1[2] = bflo(gn.w) * __builtin_amdgcn_rcpf(bflo(gd.w)); r1[3] = bfhi(gn.w) * __builtin_amdgcn_rcpf(bfhi(gd.w));
                    acc[ai][bj][m][0] *= r0; acc[ai][bj][m][1] *= r1;
                }
                asm volatile("" ::: "memory");
            }
    }
    __device__ __forceinline__ void operator()(const f32x4 (&acc)[2][2][4][2], const Unit& u, int wr, int wc, int fr, int fq) const {
        int row0 = u.pm * BM + wr * 64 + fr; asm volatile("" : "+v"(row0)); const int col0 = u.pn * BM + wc * 32 + 8 * fq;
#pragma unroll
        for (int ai = 0; ai < 2; ++ai)
#pragma unroll
            for (int m = 0; m < 4; ++m) {
                const int row = row0 + ai * HALF + m * 16;
                const bf16_t* gp = P + (size_t)row * DIN + C_MG + 2 * 2048 + col0;
#pragma unroll
                for (int bj = 0; bj < 2; ++bj) {
                    const u32x4 g = *(const u32x4*)(gp + bj * HALF);
                    const f32x4 v0 = acc[ai][bj][m][0], v1 = acc[ai][bj][m][1];
                    u32x4 w;
                    w.x = pk2(v0[0] * bflo(g.x), v0[1] * bfhi(g.x)); w.y = pk2(v0[2] * bflo(g.y), v0[3] * bfhi(g.y));
                    w.z = pk2(v1[0] * bflo(g.z), v1[1] * bfhi(g.z)); w.w = pk2(v1[2] * bflo(g.w), v1[3] * bfhi(g.w));
                    *(u32x4*)(O + (size_t)row * DM + col0 + bj * HALF) = w;
                }
            }
    }
};

struct EpiOut {
    static constexpr bool PERM = false, AFTER_DRAIN = false, HAS_MID = false;
    const float* xa; const float* xb;
    float* out; const float* gate;
    __device__ __forceinline__ void operator()(const f32x4 (&acc)[2][2][4][2], const Unit& u, int wr, int wc, int fr, int fq) const {
        int row0 = u.pm * BM + wr * 64 + fr; asm volatile("" : "+v"(row0)); const int col0 = u.pn * BM + wc * 32 + 4 * fq;
        const int cv = (u.pm < 32) ? 0 : ((u.pm < 48) ? 1 : 2);
        const float* gp = gate + (size_t)cv * 6144 + 4096 + col0;
#pragma unroll
        for (int bj = 0; bj < 2; ++bj)
#pragma unroll
            for (int n = 0; n < 2; ++n) {
                const f32x4 g = *(const f32x4*)(gp + bj * HALF + n * 16);
#pragma unroll
                for (int ai = 0; ai < 2; ++ai)
#pragma unroll
                    for (int m = 0; m < 4; ++m) {
                        const int row = row0 + ai * HALF + m * 16;
                        const float* xr = (row < MCTX) ? (xa + (size_t)row * DM) : (xb + (size_t)(row - MCTX) * DM);
                        const f32x4 x = *(const f32x4*)(xr + col0 + bj * HALF + n * 16);
                        const f32x4 o = x * DN_ALPHA + g * acc[ai][bj][m][n];
                        *(f32x4*)(out + (size_t)row * DM + col0 + bj * HALF + n * 16) = o;
                    }
            }
    }
};
template <class Epi, class Sched, bool ALIGN_EPI = false, bool SP2 = false>
__device__ __forceinline__ void gemm_phase(PG8_LAS unsigned char* lds, const Gemm g, const Sched& S, const Epi& E) {
    int tid_ = threadIdx.x; asm volatile("" : "+v"(tid_));
    const int tid = tid_, wid = __builtin_amdgcn_readfirstlane(tid >> 6), lane = tid & 63, wr = wid >> 2, wc = wid & 3, fr = lane & 15, fq = lane >> 4;
    const int K = g.K, nt = K / BK;
    unsigned voffA[2], voffB[2];
#pragma unroll
    for (int i = 0; i < 2; ++i) { int R, C; stage_rc(tid * 16 + i * 8192, R, C); const int Rb = Epi::PERM ? ((R & ~31) + perm32(R & 31)) : R;
        voffA[i] = (unsigned)(R * K + C) * 2u; voffB[i] = (unsigned)(Rb * K + C) * 2u; }
    const size_t kstep = (size_t)(BK * 2);
    const size_t hstep = (size_t)HALF * K * 2;
    const size_t tstep = 2 * hstep;
    const unsigned ldsw = (unsigned)wid * 1024u;
    const int aoff = lds_byte(wr * 64 + fr, fq * 8), boff = lds_byte(wc * 32 + fr, fq * 8);
#define PG8_SA(b, h) (((b) * 2 + (h)) * HTB)
#define PG8_SB(b, h) ((4 + (b) * 2 + (h)) * HTB)
#define PG8_STAGE(bufoff, gbase, voff) do { _Pragma("unroll") for (int _i = 0; _i < 2; ++_i) \
        __builtin_amdgcn_global_load_lds((const unsigned*)((const char*)(gbase) + (voff)[_i]), (PG8_LAS unsigned*)(lds + (bufoff) + ldsw + _i * 8192), 16, 0, 0); } while (0)
#define PG8_LDA(dst, b, h) do { _Pragma("unroll") for (int m = 0; m < 4; ++m) _Pragma("unroll") for (int k = 0; k < 2; ++k) dst[m][k] = *(const PG8_LAS bf16x8*)(lds + PG8_SA(b, h) + aoff + m * 2048 + k * 1024); } while (0)
#define PG8_LDB(dst, b, h) do { _Pragma("unroll") for (int n = 0; n < 2; ++n) _Pragma("unroll") for (int k = 0; k < 2; ++k) dst[n][k] = *(const PG8_LAS bf16x8*)(lds + PG8_SB(b, h) + boff + n * 2048 + k * 1024); } while (0)
#define PG8_MMA(ai, bj, At, Bt) do { __builtin_amdgcn_s_setprio(1); _Pragma("unroll") for (int m = 0; m < 4; ++m) _Pragma("unroll") for (int n = 0; n < 2; ++n) _Pragma("unroll") for (int k = 0; k < 2; ++k) \
        acc[ai][bj][m][n] = __builtin_amdgcn_mfma_f32_16x16x32_bf16(Bt[n][k], At[m][k], acc[ai][bj][m][n], 0, 0, 0); __builtin_amdgcn_s_setprio(0); } while (0)
#define PG8_WAIT_V(n) asm volatile("s_waitcnt vmcnt(" #n ")" ::: "memory")
#define PG8_WAIT_L(n) asm volatile("s_waitcnt lgkmcnt(" #n ")" ::: "memory")
#define PG8_BAR __builtin_amdgcn_s_barrier()
#define PG8_SCHED __builtin_amdgcn_sched_barrier(0)
    Unit cur, nxt; int ui = 0;
    if (!S.next(0, cur)) return;
    f32x4 acc[2][2][4][2];
#pragma unroll
    for (int a = 0; a < 2; ++a)
#pragma unroll
        for (int b = 0; b < 2; ++b)
#pragma unroll
            for (int m = 0; m < 4; ++m)
#pragma unroll
                for (int n = 0; n < 2; ++n) acc[a][b][m][n] = (f32x4){0.f, 0.f, 0.f, 0.f};
    bf16x8 At[4][2], B0[2][2], B1[2][2];
    const char* cA = (const char*)g.A + (size_t)cur.pm * tstep; const char* cB = (const char*)g.Bt + (size_t)cur.pn * tstep;
    S.a_ready(cur);
    if constexpr (SP2) {
        PG8_STAGE(PG8_SB(0, 0), cB, voffB); PG8_STAGE(PG8_SB(0, 1), cB + hstep, voffB); PG8_STAGE(PG8_SA(0, 0), cA, voffA); PG8_STAGE(PG8_SA(0, 1), cA + hstep, voffA);
        if (wr == 1) PG8_BAR;
        PG8_WAIT_V(2); PG8_BAR;
        PG8_STAGE(PG8_SB(1, 0), cB + kstep, voffB); PG8_STAGE(PG8_SA(1, 0), cA + kstep, voffA); PG8_STAGE(PG8_SB(1, 1), cB + hstep + kstep, voffB);
        PG8_WAIT_V(6); PG8_BAR;
    } else {
        PG8_STAGE(PG8_SB(0, 0), cB, voffB); PG8_STAGE(PG8_SA(0, 0), cA, voffA); PG8_STAGE(PG8_SB(0, 1), cB + hstep, voffB); PG8_STAGE(PG8_SA(0, 1), cA + hstep, voffA);
        if (wr == 1) PG8_BAR;
        PG8_WAIT_V(4); PG8_BAR;
        PG8_STAGE(PG8_SB(1, 0), cB + kstep, voffB); PG8_STAGE(PG8_SA(1, 0), cA + kstep, voffA); PG8_STAGE(PG8_SB(1, 1), cB + hstep + kstep, voffB);
        PG8_WAIT_V(6); PG8_BAR;
    }
    for (;;) {
        const bool has_next = S.next(ui + 1, nxt);
        const char* nA = has_next ? (const char*)g.A + (size_t)nxt.pm * tstep : cA; const char* nB = has_next ? (const char*)g.Bt + (size_t)nxt.pn * tstep : cB;
        for (int t = 0; t < nt; t += 2) {
            if constexpr (Epi::HAS_MID) { if (E.is_mid(t)) E.mid(acc, cur, wr, wc, fr, fq, t); }
            const bool last = (t == nt - 2);
            const char* a1 = cA + (size_t)(t + 1) * kstep;
            const char* a2 = last ? nA : cA + (size_t)(t + 2) * kstep; const char* b2 = last ? nB : cB + (size_t)(t + 2) * kstep;
            const char* a3 = a2 + kstep; const char* b3 = b2 + kstep;
            if (last && has_next) S.a_ready(nxt);
            if constexpr (SP2) {
            PG8_LDB(B0, 0, 0); PG8_LDB(B1, 0, 1); PG8_SCHED; PG8_LDA(At, 0, 0); PG8_STAGE(PG8_SA(1, 1), a1 + hstep, voffA);
            PG8_WAIT_V(8); PG8_WAIT_L(0); PG8_BAR; PG8_MMA(0, 0, At, B0); PG8_MMA(0, 1, At, B1); PG8_BAR; PG8_SCHED;
            PG8_LDA(At, 0, 1); PG8_STAGE(PG8_SB(0, 0), b2, voffB); PG8_STAGE(PG8_SB(0, 1), b2 + hstep, voffB); PG8_STAGE(PG8_SA(0, 0), a2, voffA);
            PG8_WAIT_V(8); PG8_WAIT_L(0); PG8_BAR; PG8_MMA(1, 0, At, B0); PG8_MMA(1, 1, At, B1); PG8_BAR; PG8_SCHED;
            PG8_LDB(B0, 1, 0); PG8_LDB(B1, 1, 1); PG8_SCHED; PG8_LDA(At, 1, 0); PG8_STAGE(PG8_SA(0, 1), a2 + hstep, voffA);
            PG8_WAIT_V(8); PG8_WAIT_L(0); PG8_BAR; PG8_MMA(0, 0, At, B0); PG8_MMA(0, 1, At, B1); PG8_BAR; PG8_SCHED;
            PG8_LDA(At, 1, 1); PG8_STAGE(PG8_SB(1, 0), b3, voffB); PG8_STAGE(PG8_SB(1, 1), b3 + hstep, voffB); PG8_STAGE(PG8_SA(1, 0), a3, voffA);
            PG8_WAIT_V(8); PG8_WAIT_L(0); PG8_BAR; PG8_MMA(1, 0, At, B0); PG8_MMA(1, 1, At, B1); PG8_BAR; PG8_SCHED;
            } else {
            PG8_LDB(B0, 0, 0); PG8_SCHED; PG8_LDA(At, 0, 0); PG8_STAGE(PG8_SA(1, 1), a1 + hstep, voffA);
            PG8_WAIT_L(8); PG8_BAR; PG8_WAIT_L(0); PG8_MMA(0, 0, At, B0); PG8_BAR; PG8_SCHED;
            PG8_LDB(B1, 0, 1); PG8_STAGE(PG8_SB(0, 0), b2, voffB);
            PG8_BAR; PG8_WAIT_L(0); PG8_MMA(0, 1, At, B1); PG8_BAR;
            PG8_LDA(At, 0, 1); PG8_STAGE(PG8_SA(0, 0), a2, voffA);
            PG8_BAR; PG8_WAIT_L(0); PG8_MMA(1, 0, At, B0); PG8_BAR; PG8_SCHED;
            PG8_STAGE(PG8_SB(0, 1), b2 + hstep, voffB);
            PG8_WAIT_V(6); PG8_BAR; PG8_MMA(1, 1, At, B1); PG8_BAR;
            PG8_LDB(B0, 1, 0); PG8_SCHED; PG8_LDA(At, 1, 0); PG8_STAGE(PG8_SA(0, 1), a2 + hstep, voffA);
            PG8_WAIT_L(8); PG8_BAR; PG8_WAIT_L(0); PG8_MMA(0, 0, At, B0); PG8_BAR; PG8_SCHED;
            PG8_LDB(B1, 1, 1); PG8_STAGE(PG8_SB(1, 0), b3, voffB);
            PG8_BAR; PG8_WAIT_L(0); PG8_MMA(0, 1, At, B1); PG8_BAR;
            PG8_LDA(At, 1, 1); PG8_STAGE(PG8_SA(1, 0), a3, voffA);
            PG8_BAR; PG8_WAIT_L(0); PG8_MMA(1, 0, At, B0); PG8_BAR; PG8_SCHED;
            PG8_STAGE(PG8_SB(1, 1), b3 + hstep, voffB);
            PG8_WAIT_V(6); PG8_BAR; PG8_MMA(1, 1, At, B1); PG8_BAR;
            }
        }
        if constexpr (ALIGN_EPI) { if (wr == 0) PG8_BAR; }
        if constexpr (!Epi::AFTER_DRAIN) { E(acc, cur, wr, wc, fr, fq); S.done(cur); }
        if (!has_next) break;
#pragma unroll
        for (int a = 0; a < 2; ++a)
#pragma unroll
            for (int b = 0; b < 2; ++b)
#pragma unroll
                for (int m = 0; m < 4; ++m)
#pragma unroll
                    for (int n = 0; n < 2; ++n) acc[a][b][m][n] = (f32x4){0.f, 0.f, 0.f, 0.f};
        cur = nxt; cA = nA; cB = nB; ++ui;
        if constexpr (ALIGN_EPI) { if (wr == 1) PG8_BAR; }
    }
    PG8_WAIT_V(0);
    if constexpr (!ALIGN_EPI) { if (wr == 0) PG8_BAR; }
    PG8_BAR;
    if constexpr (Epi::AFTER_DRAIN) { E.fused(acc, cur, wr, wc, fr, fq, lds, wid, lane); S.done(cur); }
#undef PG8_SA
#undef PG8_SB
#undef PG8_STAGE
#undef PG8_LDA
#undef PG8_LDB
#undef PG8_MMA
#undef PG8_WAIT_V
#undef PG8_WAIT_L
#undef PG8_BAR
#undef PG8_SCHED
}
}
#define XB_TMO      128
#define XB_XCNT(j)  (256  + 64 * (j))
#define XB_XSUB(j)  (1280 + 64 * (j))
#define XB_XGEN(j)  (2304 + 64 * (j))
#define XB_TOP      3328
#define XB_TOPGEN   3392
#define XCD_BAR_WORDS 3456
#define XB_SPIN_CAP (1u << 18)

__device__ __forceinline__ unsigned xb_ld(unsigned* p)              { return __hip_atomic_load(p, __ATOMIC_RELAXED, __HIP_MEMORY_SCOPE_AGENT); }
__device__ __forceinline__ unsigned xb_add(unsigned* p, unsigned v) { return __hip_atomic_fetch_add(p, v, __ATOMIC_RELAXED, __HIP_MEMORY_SCOPE_AGENT); }
__device__ __forceinline__ unsigned xb_xcc_id() { return (unsigned)__builtin_amdgcn_s_getreg((3 << 11) | 20) & 0xFu; }
#define XB_SPIN(cond, bar) do { unsigned _sp = 0; while (cond) { __builtin_amdgcn_s_sleep(1); \
    if ((++_sp & 255u) == 0u) { if (xb_ld(&(bar)[XB_TMO])) break; if (_sp > XB_SPIN_CAP) { atomicAdd(&(bar)[XB_TMO], 1u); break; } } } } while (0)

struct XcdBarrier {
    unsigned* bar; unsigned x;
    volatile LAS unsigned* st;
};

__device__ __forceinline__ XcdBarrier xcd_barrier_post(unsigned* bar, volatile LAS unsigned* st) {
    XcdBarrier b; b.bar = bar; b.x = xb_xcc_id(); b.st = st;
    if (threadIdx.x == 0) (void)xb_add(&bar[XB_XCNT(b.x)], 1u);
    return b;
}
__device__ __forceinline__ void xcd_barrier_complete(unsigned* bar, unsigned x, unsigned& nloc, unsigned& nx) {
    const unsigned G = gridDim.x * gridDim.y * gridDim.z;
    unsigned sum, cnt, mine, sp = 0u;
    for (;;) {
        sum = 0u; cnt = 0u; mine = 0u;
#pragma unroll
        for (unsigned j = 0; j < 16; ++j) { const unsigned c = xb_ld(&bar[XB_XCNT(j)]); sum += c; cnt += (c > 0u) ? 1u : 0u; mine = (j == x) ? c : mine; }
        if (sum == G) break;
        __builtin_amdgcn_s_sleep(1);
        if ((++sp & 255u) == 0u) { if (xb_ld(&bar[XB_TMO])) break; if (sp > XB_SPIN_CAP) { atomicAdd(&bar[XB_TMO], 1u); break; } }
    }
    nloc = mine > 0u ? mine : 1u; nx = cnt > 0u ? cnt : 1u;
}

__device__ __forceinline__ void xcd_barrier(const XcdBarrier& b) {
    asm volatile("s_waitcnt vmcnt(0)" ::: "memory");
    __syncthreads();
    if (threadIdx.x == 0) {
        unsigned* bar = b.bar;
        __builtin_amdgcn_s_waitcnt(0);
        unsigned nloc = b.st[0], nx = b.st[1];
        if (nloc == 0u) { xcd_barrier_complete(bar, b.x, nloc, nx); b.st[0] = nloc; b.st[1] = nx; }
        const unsigned old = xb_add(&bar[XB_XSUB(b.x)], 1u);
        const unsigned gen = old / nloc;
        if (old + 1u == (gen + 1u) * nloc) {
            __builtin_amdgcn_fence(__ATOMIC_RELEASE, "agent");
            asm volatile("s_waitcnt vmcnt(0)" ::: "memory");
            const unsigned og = xb_add(&bar[XB_TOP], 1u);
            const unsigned tg = og / nx;
            if (og + 1u == (tg + 1u) * nx) xb_add(&bar[XB_TOPGEN], 1u);
            else XB_SPIN(xb_ld(&bar[XB_TOPGEN]) == tg, bar);
            __builtin_amdgcn_fence(__ATOMIC_ACQUIRE, "agent");
            xb_add(&bar[XB_XGEN(b.x)], 1u);
            asm volatile("s_waitcnt vmcnt(0)" ::: "memory");
        } else {
            XB_SPIN(xb_ld(&bar[XB_XGEN(b.x)]) == gen, bar);
            __builtin_amdgcn_fence(__ATOMIC_ACQUIRE, "agent");
            asm volatile("s_waitcnt vmcnt(0)" ::: "memory");
        }
    }
    __syncthreads();
}


typedef GAS unsigned gu32;
struct Args { const float* in[31]; float* out; unsigned char* ws; int ph_lo, ph_hi; };
typedef const __attribute__((address_space(4))) Args* KArgs;
struct Frame {
    LAS unsigned char* lds;
    volatile LAS unsigned* MISC;
    unsigned* ctl;
    int tid, lane, wave, G, bid;
    unsigned char* ws;
    float* out;
    KArgs ka;
    __device__ __forceinline__ const float* in(int k) const { return ka->in[k]; }
};
#define WSP(T, off) ((T*)(F.ws + (off)))

__device__ __forceinline__ int wq_next(Frame& F, int phase) {
    __syncthreads();
    if (F.tid == 0) F.MISC[16] = __hip_atomic_fetch_add(F.ctl + CW_WQ + 64 * phase, 1u, __ATOMIC_RELAXED, __HIP_MEMORY_SCOPE_AGENT);
    __syncthreads();
    return (int)F.MISC[16];
}

__device__ __forceinline__ void p0_gemv_tile(Frame& F, int idx) {
    const int l = idx / 768, rem = idx % 768, kc = rem / 24, nc = rem % 24, lane = F.lane;
    const int k = kc * 64 + lane;
    const float s0 = siluf_(F.in(6  )[k]), s1 = siluf_(F.in(5  )[k]), s2 = siluf_(F.in(5  )[2048 + k]);
    const float* W = F.in(7  ) + ((size_t)l * 2048 + kc * 64) * 6144 + nc * 256 + lane * 4;
    f32x4 a0 = {0.f, 0.f, 0.f, 0.f}, a1 = a0, a2 = a0;
#pragma unroll 16
    for (int r = 0; r < 64; ++r) {
        const f32x4 wv = *(const f32x4*)(W + (size_t)r * 6144);
        const float t0 = __shfl(s0, r), t1 = __shfl(s1, r), t2 = __shfl(s2, r);
        a0 += wv * t0; a1 += wv * t1; a2 += wv * t2;
    }
    float* o = WSP(float, WS_MODP) + ((size_t)(l * 32 + kc) * 3) * 6144 + nc * 256 + lane * 4;
    *(f32x4*)o = a0; *(f32x4*)(o + 6144) = a1; *(f32x4*)(o + 2 * 6144) = a2;
}
__device__ __forceinline__ int sigma_col(int n) {
    if (n < C_Q || n >= C_V) return n;
    const int hb = n & ~127, c = n & 127, p = c >> 1, e = c & 1;
    return hb + ((p < 32) ? p : p + 32) + 32 * e;
}
__device__ __forceinline__ void p0_transpose_item(const float* W, int N, bf16* WT, int Kd, int koff, bool perm, LAS float* scr, int item, int lane) {
    const int nblk = N / 32, kb = item / nblk, nb = item % nblk, k0 = 64 * kb, n0 = 32 * nb;
    const int ncol = perm ? sigma_col(n0 + (lane & 31)) : (n0 + (lane & 31));
    float tv[32];
#pragma unroll
    for (int i = 0; i < 32; ++i) { const int kk = 2 * i + (lane >> 5); tv[i] = W[(size_t)(k0 + kk) * N + ncol]; }
#pragma unroll
    for (int i = 0; i < 32; ++i) { const int kk = 2 * i + (lane >> 5); scr[kk * 33 + (lane & 31)] = tv[i]; }
    LDS_WAIT(); asm volatile("" ::: "memory");
    const int c = lane & 7;
#pragma unroll
    for (int j = 0; j < 4; ++j) { const int n = (lane >> 3) + 8 * j; const LAS float* s = scr + (8 * c) * 33 + n;
        u32x4 o; o.x = pk2(s[0 * 33], s[1 * 33]); o.y = pk2(s[2 * 33], s[3 * 33]); o.z = pk2(s[4 * 33], s[5 * 33]); o.w = pk2(s[6 * 33], s[7 * 33]);
        *(u32x4*)(WT + (size_t)(n0 + n) * Kd + koff + k0 + 8 * c) = o; }
    LDS_WAIT(); asm volatile("" ::: "memory");
}
__device__ __forceinline__ void p0_ssm_tables(Frame& F, int item4) {
    const int item = item4 >> 2, part = item4 & 3, l = item >> 5, g = item & 31, tid = F.tid;
    LAS float* apow = (LAS float*)F.lds;
    LAS float* Bb = apow + 2 * 33 * 64 * 2;
    LAS float* Cc = Bb + 2 * 64 * 16 * 2;
    __syncthreads();
    for (int idx = tid; idx < 2 * 33 * 64; idx += NT) {
        const int d = idx / (33 * 64), j = (idx / 64) % 33, p = idx & 63;
        const int pi = ((l * 2 + d) * 32 + g) * 64 + p;
        const double lr = (double)F.in(10  )[pi], li = (double)F.in(11  )[pi], dt = exp((double)F.in(12  )[(l * 2 + d) * 32 + g]);
        const double mag = exp(lr * dt * (double)j); double sn, cs; sincos(li * dt * (double)j, &sn, &cs);
        apow[idx * 2] = (float)(mag * cs); apow[idx * 2 + 1] = (float)(mag * sn);
        if (j == TCH && part == 0) { float* at = WSP(float, WS_AT) + (size_t)((l * 32 + g) * 2 + d) * 128; at[p] = (float)(mag * cs); at[64 + p] = (float)(mag * sn); }
    }
    for (int idx = tid; idx < 2 * 64 * 16; idx += NT) {
        const int d = idx / 1024, p = (idx >> 4) & 63, cc = idx & 15;
        const int pi = ((l * 2 + d) * 32 + g) * 64 + p;
        const double lr = (double)F.in(10  )[pi], li = (double)F.in(11  )[pi], dt = exp((double)F.in(12  )[(l * 2 + d) * 32 + g]);
        const double mag = exp(lr * dt); double sn, cs; sincos(li * dt, &sn, &cs);
        const double are = mag * cs, aim = mag * sn, nr = are - 1.0, den = lr * lr + li * li;
        const double fre = (nr * lr + aim * li) / den, fim = (aim * lr - nr * li) / den;
        const double br = (double)F.in(13  )[(size_t)pi * 16 + cc], bi = (double)F.in(14  )[(size_t)pi * 16 + cc];
        Bb[idx * 2] = (float)(fre * br - fim * bi); Bb[idx * 2 + 1] = (float)(fre * bi + fim * br);
        const int ci = (((l * 2 + d) * 32 + g) * 16 + cc) * 64 + p;
        const int co = (d * 16 + cc) * 64 + p;
        Cc[co * 2] = F.in(15  )[ci]; Cc[co * 2 + 1] = F.in(16  )[ci];
    }
    __syncthreads();
    bf16* lagt = WSP(bf16, WS_LAG) + (size_t)(l * 32 + g) * 16384;
    for (int idx = part * 4032 + tid; idx < (part + 1) * 4032; idx += NT) {
        const int L = idx >> 8, delta = L - 31, cc = (idx >> 4) & 15, c2 = idx & 15;
        float v = 0.f;
        if (delta >= 0) { const int j = delta;
            for (int p = 0; p < 64; ++p) { const float ar = apow[((0 * 33 + j) * 64 + p) * 2], ai = apow[((0 * 33 + j) * 64 + p) * 2 + 1];
                const float br = Bb[((0 * 64 + p) * 16 + c2) * 2], bi = Bb[((0 * 64 + p) * 16 + c2) * 2 + 1];
                const float zr = ar * br - ai * bi, zi = ar * bi + ai * br;
                v += Cc[((0 * 16 + cc) * 64 + p) * 2] * zr - Cc[((0 * 16 + cc) * 64 + p) * 2 + 1] * zi; } }
        if (delta <= 0) { const int j = -delta;
            for (int p = 0; p < 64; ++p) { const float ar = apow[((1 * 33 + j) * 64 + p) * 2], ai = apow[((1 * 33 + j) * 64 + p) * 2 + 1];
                const float br = Bb[((1 * 64 + p) * 16 + c2) * 2], bi = Bb[((1 * 64 + p) * 16 + c2) * 2 + 1];
                const float zr = ar * br - ai * bi, zi = ar * bi + ai * br;
                v += Cc[((1 * 16 + cc) * 64 + p) * 2] * zr - Cc[((1 * 16 + cc) * 64 + p) * 2 + 1] * zi; } }
        if (delta == 0 && cc == c2) v += F.in(17  )[l * 512 + g * 16 + cc];
        lagt[idx] = (bf16)f2bf(v);
    }
    bf16* wf = WSP(bf16, WS_WF) + (size_t)(l * 32 + g) * 131072;
    for (int idx = part * 32768 + tid; idx < (part + 1) * 32768; idx += NT) {
        const int row = idx >> 9, col = idx & 511, d = row >> 7, ri = (row >> 6) & 1, p = row & 63, j = col >> 4, c2 = col & 15;
        const int pw = (d == 0) ? (TCH - 1 - j) : j;
        const float ar = apow[((d * 33 + pw) * 64 + p) * 2], ai = apow[((d * 33 + pw) * 64 + p) * 2 + 1];
        const float br = Bb[((d * 64 + p) * 16 + c2) * 2], bi = Bb[((d * 64 + p) * 16 + c2) * 2 + 1];
        wf[idx] = (bf16)f2bf(ri ? (ar * bi + ai * br) : (ar * br - ai * bi));
    }
    bf16* wy = WSP(bf16, WS_WY) + (size_t)(l * 32 + g) * 131072;
    for (int idx = part * 32768 + tid; idx < (part + 1) * 32768; idx += NT) {
        const int row = idx >> 8, col = idx & 255, i = row >> 4, cc = row & 15, d = col >> 7, ri = (col >> 6) & 1, p = col & 63;
        const int pw = (d == 0) ? (i + 1) : (TCH - i);
        const float ar = apow[((d * 33 + pw) * 64 + p) * 2], ai = apow[((d * 33 + pw) * 64 + p) * 2 + 1];
        const float cr = Cc[((d * 16 + cc) * 64 + p) * 2], ci = Cc[((d * 16 + cc) * 64 + p) * 2 + 1];
        wy[idx] = (bf16)f2bf(ri ? -(cr * ai + ci * ar) : (cr * ar - ci * ai));
    }
    __syncthreads();
}
__device__ __forceinline__ void p0_prologue(Frame& F) {
    const int gw = F.bid * NW + F.wave, NGW = F.G * NW;
    for (int it = gw; it < 1536; it += NGW) p0_gemv_tile(F, it);
    for (int it = F.bid; it < 256; it += F.G) p0_ssm_tables(F, it);
    LAS float* scr = (LAS float*)(F.lds + F.wave * 16384);
    constexpr int I_IN = 32 * 352, I_PA = 8 * 64, I_PB = 16 * 64, I_PC = 8 * 64, I_OUT = 32 * 64, I_GLU = 8 * 16;
    constexpr int I_L = I_IN + I_PA + I_PB + I_PC + I_OUT + I_GLU;
    for (int it = gw; it < 2 * I_L; it += NGW) {
        const int l = it / I_L; int r = it % I_L;
        if (r < I_IN) { p0_transpose_item(F.in(9  ) + (size_t)l * 2048 * DIN, DIN, WSP(bf16, WS_WIN) + (size_t)l * DIN * 2048, 2048, 0, true, scr, r, F.lane); continue; } r -= I_IN;
        if (r < I_PA) { p0_transpose_item(F.in(25  ) + (size_t)l * 512 * 2048, 2048, WSP(bf16, WS_WP) + (size_t)l * 2048 * 2048, 2048, 0, false, scr, r, F.lane); continue; } r -= I_PA;
        if (r < I_PB) { p0_transpose_item(F.in(26  ) + (size_t)l * 1024 * 2048, 2048, WSP(bf16, WS_WP) + (size_t)l * 2048 * 2048, 2048, 512, false, scr, r, F.lane); continue; } r -= I_PB;
        if (r < I_PC) { p0_transpose_item(F.in(27  ) + (size_t)l * 512 * 2048, 2048, WSP(bf16, WS_WP) + (size_t)l * 2048 * 2048, 2048, 1536, false, scr, r, F.lane); continue; } r -= I_PC;
        if (r < I_OUT) { p0_transpose_item(F.in(28  ) + (size_t)l * 2048 * 2048, 2048, WSP(bf16, WS_WOUT) + (size_t)l * 2048 * 2048, 2048, 0, false, scr, r, F.lane); continue; } r -= I_OUT;
        p0_transpose_item(F.in(18  ) + (size_t)l * 512 * 512, 512, WSP(bf16, WS_WGLU) + (size_t)l * 512 * 512, 512, 0, false, scr, r, F.lane);
    }
    const int gt = F.bid * NT + F.tid, NGT = F.G * NT;
    for (int i = gt; i < 2 * 2 * 256 * 256; i += NGT) {
        const int col = i & 255, rowi = i >> 8;
        const int hb = col & 128, cc = col & 127, p = cc >> 1, e = cc & 1, src = hb + ((p < 32) ? p : p + 32) + 32 * e;
        WSP(bf16, WS_CK)[i] = (bf16)f2bf(F.in(2  )[(size_t)rowi * 256 + src]);
        WSP(bf16, WS_CV)[i] = (bf16)f2bf(F.in(3  )[i]);
    }
    for (int i = gt; i < 2 * 4 * 128 * 128; i += NGT) WSP(bf16, WS_WS)[i] = (bf16)f2bf(F.in(23  )[i]);
    for (int i = gt; i < 64 * 32; i += NGT) {
        const int pos = i >> 5, j = i & 31;
        const double inv = pow(10000.0, -(double)(2 * j) / 64.0); double sn, cs; sincos((double)pos * inv, &sn, &cs);
        WSP(float, WS_ROPE)[i * 2] = (float)cs; WSP(float, WS_ROPE)[i * 2 + 1] = (float)sn;
    }
}

__device__ __forceinline__ void ln_row(const float* xrow, f32x4 (&v)[8], int lane) {
    const f32x4* xr = (const f32x4*)xrow + lane; float s = 0.f;
#pragma unroll
    for (int j = 0; j < 8; ++j) { v[j] = xr[64 * j]; s += (v[j].x + v[j].y) + (v[j].z + v[j].w); }
    const float mean = wave_sum(s) * (1.f / DM); float s2 = 0.f;
#pragma unroll
    for (int j = 0; j < 8; ++j) { v[j] = v[j] - mean; s2 += (v[j].x * v[j].x + v[j].y * v[j].y) + (v[j].z * v[j].z + v[j].w * v[j].w); }
    const float rstd = 1.f / sqrtf(wave_sum(s2) * (1.f / DM) + LN_EPS);
#pragma unroll
    for (int j = 0; j < 8; ++j) v[j] = v[j] * rstd;
}
__device__ __forceinline__ void ln_renorm(f32x4 (&v)[8]) {
    float s = 0.f;
#pragma unroll
    for (int j = 0; j < 8; ++j) s += (v[j].x + v[j].y) + (v[j].z + v[j].w);
    const float mean = wave_sum(s) * (1.f / DM); float s2 = 0.f;
#pragma unroll
    for (int j = 0; j < 8; ++j) { v[j] = v[j] - mean; s2 += (v[j].x * v[j].x + v[j].y * v[j].y) + (v[j].z * v[j].z + v[j].w * v[j].w); }
    const float rstd = 1.f / sqrtf(wave_sum(s2) * (1.f / DM) + LN_EPS);
#pragma unroll
    for (int j = 0; j < 8; ++j) v[j] = v[j] * rstd;
}
__device__ __forceinline__ void store_h_row(bf16* hrow, const f32x4 (&v)[8], const LAS float* sc1p, const LAS float* sh, int lane) {
#pragma unroll
    for (int j = 0; j < 8; ++j) { const int c = lane * 4 + 256 * j;
        const f32x4 a = *(const LAS f32x4*)(sc1p + c), b = *(const LAS f32x4*)(sh + c);
        const f32x4 o = v[j] * a + b; u32x2 w; w.x = pk2(o.x, o.y); w.y = pk2(o.z, o.w);
        *(u32x2*)(hrow + c) = w; }
}
__device__ __forceinline__ void p1_lnmod(Frame& F) {
    const float* modp = WSP(float, WS_MODP); float* mod = WSP(float, WS_MOD);
    if (F.tid < 144) { const int idx = F.bid * 144 + F.tid; if (idx < 36864) { const int l = idx / 18432, r = idx % 18432, cv = r / 6144, n = r % 6144; float s = F.in(8  )[l * 6144 + n];
        for (int kc = 0; kc < 32; ++kc) s += modp[((size_t)(l * 32 + kc) * 3 + cv) * 6144 + n]; mod[idx] = s; } }
    const int row0 = F.bid * 64, cv = (row0 < MCTX) ? 0 : 1 + ((row0 - MCTX) >> 12);
    LAS float* sc1p = (LAS float*)F.lds; LAS float* sh = sc1p + 2048;
    for (int n = F.tid; n < 4096; n += NT) { float s = F.in(8  )[n];
        for (int kc = 0; kc < 32; ++kc) s += modp[((size_t)(0 * 32 + kc) * 3 + cv) * 6144 + n];
        if (n < 2048) sh[n] = s; else sc1p[n - 2048] = 1.0f + s; }
    __syncthreads();
    bf16* H = WSP(bf16, WS_H);
    for (int i = 0; i < 8; ++i) { const int row = row0 + F.wave * 8 + i;
        const float* xr = (row < MCTX) ? (F.in(0  ) + (size_t)row * DM) : (F.in(1  ) + (size_t)(row - MCTX) * DM);
        f32x4 v[8]; ln_row(xr, v, F.lane); store_h_row(H + (size_t)row * DM, v, sc1p, sh, F.lane); }
    __syncthreads();
}
__device__ __forceinline__ void pg_postln(Frame& F, int l) {
    const float* mod = WSP(float, WS_MOD);
    const int row0 = F.bid * 64, cv = (row0 < MCTX) ? 0 : 1 + ((row0 - MCTX) >> 12);
    LAS float* sc1p = (LAS float*)F.lds; LAS float* sh = sc1p + 2048; LAS float* lg = sh + 2048; LAS float* lb = lg + 2048;
    __syncthreads();
    for (int n = F.tid; n < 2048; n += NT) { lg[n] = F.in(29  )[l * 2048 + n]; lb[n] = F.in(30  )[l * 2048 + n];
        if (l == 0) { sh[n] = mod[(size_t)(1 * 3 + cv) * 6144 + n]; sc1p[n] = 1.0f + mod[(size_t)(1 * 3 + cv) * 6144 + 2048 + n]; } }
    __syncthreads();
    bf16* H = WSP(bf16, WS_H);
    for (int i = 0; i < 8; ++i) { const int row = row0 + F.wave * 8 + i;
        float* orow = F.out + (size_t)row * DM;
        f32x4 v[8]; ln_row(orow, v, F.lane);
#pragma unroll
        for (int j = 0; j < 8; ++j) { const int c = F.lane * 4 + 256 * j; v[j] = v[j] * *(const LAS f32x4*)(lg + c) + *(const LAS f32x4*)(lb + c); *(f32x4*)(orow + c) = v[j]; }
        if (l == 0) { ln_renorm(v); store_h_row(H + (size_t)row * DM, v, sc1p, sh, F.lane); } }
    __syncthreads();
}

__device__ __forceinline__ int crow(int r, int hi) { return (r & 3) + 8 * (r >> 2) + 4 * hi; }
constexpr int AK_PITCH = 272, AV_PITCH = 320, ATT_K_OFF = 0, ATT_V_OFF = 64 * AK_PITCH;
__device__ __forceinline__ s16x4 vtr(const LAS unsigned char* p) { typedef short v4i16_t __attribute__((ext_vector_type(4))); return __builtin_bit_cast(s16x4, __builtin_amdgcn_ds_read_tr16_b64_v4i16((LAS v4i16_t*)p)); }

__device__ __forceinline__ void attn_unit(Frame& F, int l, int kind, int b, int h, int qb) {
    const int lane = F.lane, w = F.wave, r32 = lane & 31, hi = lane >> 5, tid = F.tid;
    const bf16* P = WSP(bf16, WS_P);
    const int kvh = h >> 2;
    const int seq0 = kind ? (MCTX + b * 4096) : (b * 256);
    const int t0 = kind ? qb * 256 : 0;
    const int tq = t0 + 32 * w + r32;
    const size_t qrow = (size_t)(seq0 + tq);
    int tlo = 0, nloc = 4;
    if (kind) { const int lo = (t0 - 128) < 0 ? 0 : (t0 - 128), hi_ = (t0 + 384) > 4096 ? 4096 : (t0 + 384); tlo = lo >> 6; nloc = (hi_ >> 6) - tlo; }
    const int ntile = nloc + (kind ? 4 : 0);
    bf16x8 qf[8];
    { const bf16* qp = P + qrow * DIN + C_Q + h * 128 + hi * 8;
#pragma unroll
      for (int ks = 0; ks < 8; ++ks) qf[ks] = *(const bf16x8*)(qp + 16 * ks); }
    float mrun = F.in(20  )[l * 8 + h] * LOG2E, lrun = (hi == 0) ? 1.0f : 0.0f;
    f32x16 o[4];
#pragma unroll
    for (int i = 0; i < 4; ++i)
#pragma unroll
        for (int r = 0; r < 16; ++r) o[i][r] = 0.f;
    LAS unsigned char* ldsK = F.lds + ATT_K_OFF; LAS unsigned char* ldsV = F.lds + ATT_V_OFF;
    u32x4 kr[2], vr[2];
    const bf16* CK = WSP(bf16, WS_CK) + (size_t)((b * 2 + l) * 256) * 256 + kvh * 128;
    const bf16* CV = WSP(bf16, WS_CV) + (size_t)((b * 2 + l) * 256) * 256 + kvh * 128;
#define ATT_LOAD(i) do { \
        _Pragma("unroll") for (int q_ = 0; q_ < 2; ++q_) { const int c_ = tid + 512 * q_, kv_ = c_ >> 4, dch_ = c_ & 15; \
            if ((i) < nloc) { const bf16* src_ = P + (size_t)(seq0 + (tlo + (i)) * 64 + kv_) * DIN + kvh * 128 + dch_ * 8; kr[q_] = *(const u32x4*)(src_ + C_K); vr[q_] = *(const u32x4*)(src_ + C_V); } \
            else { const size_t off_ = (size_t)(((i) - nloc) * 64 + kv_) * 256 + dch_ * 8; kr[q_] = *(const u32x4*)(CK + off_); vr[q_] = *(const u32x4*)(CV + off_); } } } while (0)
    ATT_LOAD(0);
    for (int i = 0; i < ntile; ++i) {
        __syncthreads();
#pragma unroll
        for (int q_ = 0; q_ < 2; ++q_) { const int c_ = tid + 512 * q_, kv_ = c_ >> 4, dch_ = c_ & 15;
            *(LAS u32x4*)(ldsK + kv_ * AK_PITCH + dch_ * 16) = kr[q_]; *(LAS u32x4*)(ldsV + kv_ * AV_PITCH + dch_ * 16) = vr[q_]; }
        __syncthreads();
        if (i + 1 < ntile) ATT_LOAD(i + 1);
        const bool local = kind && (i < nloc);
        const int k0 = (tlo + i) * 64;
        bool need = true;
        if (local) { const int wq0 = t0 + 32 * w; need = (k0 + 63 >= wq0 - 128) && (k0 <= wq0 + 31 + 128); }
        if (need) {
            f32x16 s0, s1;
#pragma unroll
            for (int r = 0; r < 16; ++r) { s0[r] = 0.f; s1[r] = 0.f; }
#pragma unroll
            for (int ks = 0; ks < 8; ++ks) {
                const bf16x8 a0 = *(const LAS bf16x8*)(ldsK + r32 * AK_PITCH + ks * 32 + hi * 16);
                const bf16x8 a1 = *(const LAS bf16x8*)(ldsK + (32 + r32) * AK_PITCH + ks * 32 + hi * 16);
                s0 = __builtin_amdgcn_mfma_f32_32x32x16_bf16(a0, qf[ks], s0, 0, 0, 0);
                s1 = __builtin_amdgcn_mfma_f32_32x32x16_bf16(a1, qf[ks], s1, 0, 0, 0);
            }
            if (local) {
#pragma unroll
                for (int r = 0; r < 16; ++r) { const int kp = k0 + crow(r, hi); int d0 = kp - tq; d0 = d0 < 0 ? -d0 : d0; int d1 = kp + 32 - tq; d1 = d1 < 0 ? -d1 : d1;
                    if (d0 > 128) s0[r] = -INFINITY; if (d1 > 128) s1[r] = -INFINITY; }
            }
            float mx = fmaxf(s0[0], s1[0]);
#pragma unroll
            for (int r = 1; r < 16; ++r) mx = fmaxf(mx, fmaxf(s0[r], s1[r]));
            mx = fmaxf(mx, __shfl_xor(mx, 32));
            const float mnew = fmaxf(mrun, mx), alpha = __builtin_amdgcn_exp2f(mrun - mnew);
            mrun = mnew; lrun *= alpha;
#pragma unroll
            for (int i2 = 0; i2 < 4; ++i2)
#pragma unroll
                for (int r = 0; r < 16; ++r) o[i2][r] *= alpha;
            float ls = 0.f;
#pragma unroll
            for (int r = 0; r < 16; ++r) { s0[r] = __builtin_amdgcn_exp2f(s0[r] - mnew); s1[r] = __builtin_amdgcn_exp2f(s1[r] - mnew); ls += s0[r] + s1[r]; }
            lrun += ls;
            bf16x8 pb[4];
            { u32x4 t;
              t.x = pk2(s0[0], s0[1]); t.y = pk2(s0[2], s0[3]); t.z = pk2(s0[4], s0[5]); t.w = pk2(s0[6], s0[7]); pb[0] = __builtin_bit_cast(bf16x8, t);
              t.x = pk2(s0[8], s0[9]); t.y = pk2(s0[10], s0[11]); t.z = pk2(s0[12], s0[13]); t.w = pk2(s0[14], s0[15]); pb[1] = __builtin_bit_cast(bf16x8, t);
              t.x = pk2(s1[0], s1[1]); t.y = pk2(s1[2], s1[3]); t.z = pk2(s1[4], s1[5]); t.w = pk2(s1[6], s1[7]); pb[2] = __builtin_bit_cast(bf16x8, t);
              t.x = pk2(s1[8], s1[9]); t.y = pk2(s1[10], s1[11]); t.z = pk2(s1[12], s1[13]); t.w = pk2(s1[14], s1[15]); pb[3] = __builtin_bit_cast(bf16x8, t); }
            const LAS unsigned char* vb = ldsV + (4 * hi + ((lane & 15) >> 2)) * AV_PITCH + ((lane >> 4) & 1) * 32 + (lane & 3) * 8;
#pragma unroll
            for (int s = 0; s < 4; ++s)
#pragma unroll
                for (int db = 0; db < 4; ++db) {
                    const s16x4 lo = vtr(vb + (16 * s) * AV_PITCH + db * 64), hh = vtr(vb + (16 * s + 8) * AV_PITCH + db * 64);
                    const bf16x8 a = {lo[0], lo[1], lo[2], lo[3], hh[0], hh[1], hh[2], hh[3]};
                    o[db] = __builtin_amdgcn_mfma_f32_32x32x16_bf16(a, pb[s], o[db], 0, 0, 0);
                }
        }
    }
#undef ATT_LOAD
    const float ltot = lrun + __shfl_xor(lrun, 32), inv = 1.0f / ltot;
    bf16* YC = WSP(bf16, WS_H) + qrow * DM + 512 + h * 128;
    const bf16* zb = P + qrow * DIN + C_ZB + h * 128;
#pragma unroll
    for (int db = 0; db < 4; ++db)
#pragma unroll
        for (int rg = 0; rg < 4; ++rg) { const int d = 32 * db + 8 * rg + 4 * hi;
            const u32x2 z = *(const u32x2*)(zb + d);
            u32x2 wv; wv.x = pk2(o[db][4 * rg] * inv * bflo(z.x), o[db][4 * rg + 1] * inv * bfhi(z.x)); wv.y = pk2(o[db][4 * rg + 2] * inv * bflo(z.y), o[db][4 * rg + 3] * inv * bfhi(z.y));
            *(u32x2*)(YC + d) = wv; }
}

__device__ __forceinline__ void ssm_stage_u(Frame& F, int g, int rowbase) {
    const bf16* P = WSP(bf16, WS_P);
#pragma unroll
    for (int q = 0; q < 8; ++q) { const int c = F.tid + 512 * q, hh = c & 1, tok = c >> 1, n = tok >> 5, j = tok & 31;
        const u32x4 v = *(const u32x4*)(P + (size_t)(rowbase + tok) * DIN + C_XA + g * 16 + hh * 8);
        *(LAS u32x4*)(F.lds + ((j * 64 + n) * 32 + hh * 16)) = v; }
}
__device__ __forceinline__ void ssm_unit(Frame& F, int l, int g, int tb) {
    const int lane = F.lane, w = F.wave, r32 = lane & 31, hi = lane >> 5, tid = F.tid;
    const int unit = g * 4 + tb;
    const int rowblk = tb * 4096;
    const bool ctx = tb < 2;
    const int nchunk = ctx ? 8 : 128;
    float* Fb = WSP(float, WS_F) + (size_t)unit * 128 * 256;
    bf16* Sb = WSP(bf16, WS_SIN) + (size_t)unit * 128 * 256;
    const bf16* WF = WSP(bf16, WS_WF) + (size_t)(l * 32 + g) * 131072;
    const bf16* WY = WSP(bf16, WS_WY) + (size_t)(l * 32 + g) * 131072;
    LAS unsigned char* ldsU = F.lds;
    LAS unsigned char* ldsL = F.lds + 65536;
    __syncthreads();
    { const u32x4* src = (const u32x4*)(WSP(bf16, WS_LAG) + (size_t)(l * 32 + g) * 16384);
      for (int i = tid; i < 63 * 32; i += NT) *(LAS u32x4*)(ldsL + i * 16) = src[i]; }
    for (int half = 0; half < 2; ++half) {
        const bf16* wfr = WF + (size_t)(32 * w + r32) * 512 + hi * 8;
        bf16x8 afr[32];
#pragma unroll
        for (int j = 0; j < 32; ++j) afr[j] = *(const bf16x8*)(wfr + 16 * j);
        __syncthreads();
        ssm_stage_u(F, g, rowblk + half * 2048);
        __syncthreads();
        f32x16 acc[2];
#pragma unroll
        for (int r = 0; r < 16; ++r) { acc[0][r] = 0.f; acc[1][r] = 0.f; }
#pragma unroll
        for (int j = 0; j < 32; ++j) {
            const bf16x8 b0 = *(const LAS bf16x8*)(ldsU + (j * 64 + r32) * 32 + hi * 16), b1 = *(const LAS bf16x8*)(ldsU + (j * 64 + 32 + r32) * 32 + hi * 16);
            acc[0] = __builtin_amdgcn_mfma_f32_32x32x16_bf16(afr[j], b0, acc[0], 0, 0, 0);
            acc[1] = __builtin_amdgcn_mfma_f32_32x32x16_bf16(afr[j], b1, acc[1], 0, 0, 0);
        }
#pragma unroll
        for (int ib = 0; ib < 2; ++ib)
#pragma unroll
            for (int rg = 0; rg < 4; ++rg) { float* o = Fb + (size_t)(half * 64 + ib * 32 + r32) * 256 + 32 * w + 8 * rg + 4 * hi;
                *(f32x4*)o = (f32x4){acc[ib][4 * rg], acc[ib][4 * rg + 1], acc[ib][4 * rg + 2], acc[ib][4 * rg + 3]}; }
    }
    __syncthreads();
    { const int nseq = ctx ? 16 : 1;
      const float* at = WSP(float, WS_AT) + (size_t)((l * 32 + g) * 2) * 128;
      for (int it = tid; it < nseq * 128; it += NT) {
          const int sq = it >> 7, d = (it >> 6) & 1, p = it & 63;
          const float ar = at[d * 128 + p], ai = at[d * 128 + 64 + p];
          float sr = 0.f, si = 0.f;
          if (!ctx) { const float* s0 = F.in(4  ) + (size_t)((((tb - 2) * 2 + l) * 2 + d) * 2) * 2048 + g * 64 + p; sr = s0[0]; si = s0[2048]; }
          float fr_[8], fi_[8], gr_[8], gi_[8];
#pragma unroll
          for (int e = 0; e < 8; ++e) { const int cc = d ? (nchunk - 1 - e) : e, n = sq * nchunk + cc; const float* f = Fb + (size_t)n * 256 + d * 128 + p; fr_[e] = f[0]; fi_[e] = f[64]; }
          for (int c0 = 0; c0 < nchunk; c0 += 8) {
              if (c0 + 8 < nchunk) {
#pragma unroll
                  for (int e = 0; e < 8; ++e) { const int cI = c0 + 8 + e, cc = d ? (nchunk - 1 - cI) : cI, n = sq * nchunk + cc; const float* f = Fb + (size_t)n * 256 + d * 128 + p; gr_[e] = f[0]; gi_[e] = f[64]; }
              }
#pragma unroll
              for (int e = 0; e < 8; ++e) { const int cI = c0 + e, cc = d ? (nchunk - 1 - cI) : cI, n = sq * nchunk + cc;
                  bf16* so = Sb + (size_t)n * 256 + d * 128 + p; so[0] = (bf16)f2bf(sr); so[64] = (bf16)f2bf(si);
                  const float nr = ar * sr - ai * si + fr_[e], ni = ar * si + ai * sr + fi_[e]; sr = nr; si = ni; }
#pragma unroll
              for (int e = 0; e < 8; ++e) { fr_[e] = gr_[e]; fi_[e] = gi_[e]; }
          }
          if (ctx) { const int bb = tb * 16 + sq; float* o = F.out + (size_t)M * DM + 2 * (size_t)(32 * 2 * 256 * 256) + (size_t)((((bb * 2 + l) * 2 + d) * 2) * 2048) + g * 64 + p; o[0] = sr; o[2048] = si; }
      } }
    bf16* YG = WSP(bf16, WS_YG);
    for (int half = 0; half < 2; ++half) {
        __syncthreads();
        ssm_stage_u(F, g, rowblk + half * 2048);
        __syncthreads();
        f32x16 acc[2][2];
#pragma unroll
        for (int a_ = 0; a_ < 2; ++a_)
#pragma unroll
            for (int b_ = 0; b_ < 2; ++b_)
#pragma unroll
                for (int r = 0; r < 16; ++r) acc[a_][b_][r] = 0.f;
        const LAS unsigned char* lagp = ldsL + (r32 & 15) * 32 + hi * 16;
#pragma unroll 4
        for (int j = 0; j < 32; ++j) {
            const bf16x8 b0 = *(const LAS bf16x8*)(ldsU + (j * 64 + r32) * 32 + hi * 16), b1 = *(const LAS bf16x8*)(ldsU + (j * 64 + 32 + r32) * 32 + hi * 16);
#pragma unroll
            for (int rr = 0; rr < 2; ++rr) { const int i = 2 * (2 * w + rr) + (r32 >> 4);
                const bf16x8 a = *(const LAS bf16x8*)(lagp + (i - j + 31) * 512);
                acc[rr][0] = __builtin_amdgcn_mfma_f32_32x32x16_bf16(a, b0, acc[rr][0], 0, 0, 0);
                acc[rr][1] = __builtin_amdgcn_mfma_f32_32x32x16_bf16(a, b1, acc[rr][1], 0, 0, 0); }
        }
#pragma unroll 8
        for (int ks = 0; ks < 16; ++ks) {
            const bf16x8 b0 = *(const bf16x8*)(Sb + (size_t)(half * 64 + r32) * 256 + 16 * ks + hi * 8), b1 = *(const bf16x8*)(Sb + (size_t)(half * 64 + 32 + r32) * 256 + 16 * ks + hi * 8);
#pragma unroll
            for (int rr = 0; rr < 2; ++rr) {
                const bf16x8 a = *(const bf16x8*)(WY + (size_t)(32 * (2 * w + rr) + r32) * 256 + 16 * ks + hi * 8);
                acc[rr][0] = __builtin_amdgcn_mfma_f32_32x32x16_bf16(a, b0, acc[rr][0], 0, 0, 0);
                acc[rr][1] = __builtin_amdgcn_mfma_f32_32x32x16_bf16(a, b1, acc[rr][1], 0, 0, 0); }
        }
#pragma unroll
        for (int rr = 0; rr < 2; ++rr)
#pragma unroll
            for (int ib = 0; ib < 2; ++ib)
#pragma unroll
                for (int rg = 0; rg < 4; ++rg) { const int i = 2 * (2 * w + rr) + (rg >> 1), c = 8 * (rg & 1) + 4 * hi, n = ib * 32 + r32;
                    const size_t row = (size_t)(rowblk + half * 2048 + n * 32 + i);
                    u32x2 wv; wv.x = pk2(geluf_(acc[rr][ib][4 * rg]), geluf_(acc[rr][ib][4 * rg + 1])); wv.y = pk2(geluf_(acc[rr][ib][4 * rg + 2]), geluf_(acc[rr][ib][4 * rg + 3]));
                    *(u32x2*)(YG + row * 512 + g * 16 + c) = wv; }
    }
}

constexpr int SG_PITCH = 272;
__device__ __forceinline__ void sgu_unit(Frame& F, int l, int ck, int g) {
    const int lane = F.lane, w = F.wave, r32 = lane & 31, hi = lane >> 5, tid = F.tid;
    const bf16* P = WSP(bf16, WS_P);
    const int row0 = ck * 128;
    LAS unsigned char* vnt = F.lds;
    __syncthreads();
    {
      const int q = tid >> 2, qq = tid & 3;
      const bf16* vrow = P + (size_t)(row0 + q) * DIN + C_VS + qq * 32;
      u32x4 mine[4]; float s = 0.f, s2 = 0.f;
#pragma unroll
      for (int gg = 0; gg < 4; ++gg)
#pragma unroll
          for (int k = 0; k < 4; ++k) { const u32x4 v = *(const u32x4*)(vrow + gg * 128 + k * 8); if (gg == g) mine[k] = v;
              const float f0 = bflo(v.x), f1 = bfhi(v.x), f2 = bflo(v.y), f3 = bfhi(v.y), f4 = bflo(v.z), f5 = bfhi(v.z), f6 = bflo(v.w), f7 = bfhi(v.w);
              s += ((f0 + f1) + (f2 + f3)) + ((f4 + f5) + (f6 + f7)); s2 += ((f0 * f0 + f1 * f1) + (f2 * f2 + f3 * f3)) + ((f4 * f4 + f5 * f5) + (f6 * f6 + f7 * f7)); }
      s += __shfl_xor(s, 1); s += __shfl_xor(s, 2); s2 += __shfl_xor(s2, 1); s2 += __shfl_xor(s2, 2);
      const float mean = s * (1.f / 512.f), var = fmaxf(s2 * (1.f / 512.f) - mean * mean, 0.f), rstd = 1.f / sqrtf(var + LN_EPS);
      const float* lgp = F.in(21  ) + l * 512 + g * 128 + qq * 32; const float* lbp = F.in(22  ) + l * 512 + g * 128 + qq * 32;
#pragma unroll
      for (int k = 0; k < 4; ++k) { const unsigned ww[4] = {mine[k].x, mine[k].y, mine[k].z, mine[k].w};
#pragma unroll
          for (int e = 0; e < 4; ++e) { const int c = qq * 32 + k * 8 + e * 2;
              const float v0 = (bflo(ww[e]) - mean) * rstd * lgp[k * 8 + e * 2] + lbp[k * 8 + e * 2], v1 = (bfhi(ww[e]) - mean) * rstd * lgp[k * 8 + e * 2 + 1] + lbp[k * 8 + e * 2 + 1];
              *(LAS unsigned short*)(vnt + c * SG_PITCH + q * 2) = (unsigned short)f2bf(v0); *(LAS unsigned short*)(vnt + (c + 1) * SG_PITCH + q * 2) = (unsigned short)f2bf(v1); } }
    }
    __syncthreads();
    const int pb = w >> 1, cb0 = 2 * (w & 1);
    const bf16* Ws = WSP(bf16, WS_WS) + (size_t)((l * 4 + g) * 128 + 32 * pb + r32) * 128 + hi * 8;
    f32x16 acc[2];
#pragma unroll
    for (int r = 0; r < 16; ++r) { acc[0][r] = 0.f; acc[1][r] = 0.f; }
#pragma unroll
    for (int ks = 0; ks < 8; ++ks) {
        const bf16x8 a = *(const bf16x8*)(Ws + 16 * ks);
        const bf16x8 b0 = *(const LAS bf16x8*)(vnt + (32 * cb0 + r32) * SG_PITCH + (16 * ks + 8 * hi) * 2), b1 = *(const LAS bf16x8*)(vnt + (32 * (cb0 + 1) + r32) * SG_PITCH + (16 * ks + 8 * hi) * 2);
        acc[0] = __builtin_amdgcn_mfma_f32_32x32x16_bf16(a, b0, acc[0], 0, 0, 0);
        acc[1] = __builtin_amdgcn_mfma_f32_32x32x16_bf16(a, b1, acc[1], 0, 0, 0);
    }
    bf16* YC = WSP(bf16, WS_H);
    const float* bs = F.in(24  ) + (l * 4 + g) * 128;
    LAS float* outt = (LAS float*)(F.lds + 36864);
#pragma unroll
    for (int cbi = 0; cbi < 2; ++cbi)
#pragma unroll
        for (int r = 0; r < 16; ++r) { const int p = 32 * pb + crow(r, hi), c = 32 * (cb0 + cbi) + r32; outt[p * 132 + c] = acc[cbi][r] + bs[p]; }
    __syncthreads();
    { const int p = tid >> 2, cq = (tid & 3) * 32; const size_t row = (size_t)(row0 + p);
#pragma unroll
      for (int k = 0; k < 4; ++k) { const int c = cq + 8 * k;
          const u32x4 u8 = *(const u32x4*)(P + row * DIN + C_U + g * 128 + c), z8 = *(const u32x4*)(P + row * DIN + C_ZC + g * 128 + c);
          const f32x4 o0 = *(const LAS f32x4*)(outt + p * 132 + c), o1 = *(const LAS f32x4*)(outt + p * 132 + c + 4);
          u32x4 wv;
          wv.x = pk2(o0[0] * bflo(u8.x) * bflo(z8.x), o0[1] * bfhi(u8.x) * bfhi(z8.x)); wv.y = pk2(o0[2] * bflo(u8.y) * bflo(z8.y), o0[3] * bfhi(u8.y) * bfhi(z8.y));
          wv.z = pk2(o1[0] * bflo(u8.z) * bflo(z8.z), o1[1] * bfhi(u8.z) * bfhi(z8.z)); wv.w = pk2(o1[2] * bflo(u8.w) * bflo(z8.w), o1[3] * bfhi(u8.w) * bfhi(z8.w));
          *(u32x4*)(YC + row * DM + 1536 + g * 128 + c) = wv; } }
}

#ifndef PHASE_MASK
#define PHASE_MASK 0xff
#endif
#define PM(k) ((PHASE_MASK >> (k)) & 1)
#ifndef UNIT_MASK
#define UNIT_MASK 7
#endif
#define UM(k) (((rep == 0 ? 7 : UNIT_MASK) >> (k)) & 1)
#ifndef REPEAT_PHASE
#define REPEAT_PHASE -1
#endif
constexpr int N_PHASES = 14;
__global__ void __launch_bounds__(NT, 2) fwd_kernel(Args args) {
    extern __shared__ __attribute__((aligned(16))) unsigned char lds[];
    Frame F;
    F.lds = (LAS unsigned char*)lds;
    F.MISC = (volatile LAS unsigned*)(F.lds + MISC_OFF);
    F.tid = threadIdx.x; F.lane = F.tid & 63; F.wave = __builtin_amdgcn_readfirstlane(F.tid >> 6);
    F.G = gridDim.x; F.bid = blockIdx.x;
    F.ws = args.ws; F.out = args.out; F.ctl = (unsigned*)(args.ws + WS_CTL);
    F.ka = (KArgs)__builtin_amdgcn_kernarg_segment_ptr();
    for (int u = F.tid; u < (LDS_BYTES - LDSCTL_OFF) / 4; u += NT) ((LAS unsigned*)(F.lds + LDSCTL_OFF))[u] = 0u;
    __syncthreads();
    XcdBarrier bar = xcd_barrier_post((unsigned*)(F.ctl + CW_BAR), F.MISC + 8);
    const int lo = args.ph_lo, hi = args.ph_hi;
#define IN(k) (lo <= (k) && (k) < hi)
#define FRESH() do { asm volatile("" : "+s"(F.ka)); asm volatile("" : "+v"(F.tid)); F.lane = F.tid & 63; F.wave = __builtin_amdgcn_readfirstlane(F.tid >> 6); } while (0)
#define SEAM(k) do { if (IN(k) && IN((k) + 1)) xcd_barrier(bar); } while (0)

#define REPS(k) ((REPEAT_PHASE == (k)) ? 2 : 1)
#define RSEAM(k) do { if (rep + 1 < REPS(k)) xcd_barrier(bar); } while (0)
    if (PM(0) && IN(0)) for (int rep = 0; rep < REPS(0); ++rep) { FRESH(); p0_prologue(F); RSEAM(0); }
    SEAM(0);
    if (PM(1) && IN(1)) for (int rep = 0; rep < REPS(1); ++rep) { FRESH(); p1_lnmod(F); RSEAM(1); }
    SEAM(1);
    for (int l = 0; l < 2; ++l) {
        const int pb = 2 + 6 * l;
        if (PM(2) && IN(pb)) for (int rep = 0; rep < REPS(2) - l * (REPS(2) - 1); ++rep) { FRESH();
            pg8::Gemm g{WSP(bf16, WS_H), WSP(bf16, WS_WIN) + (size_t)l * DIN * 2048, M, DIN, DM}; pg8::StaticOrder S; S.init(M, DIN, F.G, F.bid);
            float* okv = F.out + (size_t)M * DM + (size_t)l * 256 * 256;
            pg8::EpiInProj E{WSP(bf16, WS_P), okv, okv + (size_t)32 * 2 * 256 * 256, WSP(float, WS_ROPE)};
            pg8::gemm_phase<pg8::EpiInProj, pg8::StaticOrder, true, true>(F.lds, g, S, E);
            RSEAM(2);
        }
        SEAM(pb);
        if (PM(3) && IN(pb + 1)) for (int rep = 0; rep < REPS(3) - l * (REPS(3) - 1); ++rep) {
            for (;;) {
                int u = wq_next(F, pb + 1 + 32 * rep); FRESH();
                if (u >= 1152) break;
                if (u < 256) { if (UM(0)) attn_unit(F, l, 1, u >> 7, (u >> 4) & 7, u & 15); continue; } u -= 256;
                if (u < 128) { if (UM(1)) ssm_unit(F, l, u >> 2, u & 3); continue; } u -= 128;
                if (u < 256) { if (UM(0)) attn_unit(F, l, 0, u >> 3, u & 7, 0); continue; } u -= 256;
                if (UM(2)) sgu_unit(F, l, u >> 2, u & 3);
            }
            __syncthreads();
            RSEAM(3);
        }
        SEAM(pb + 1);
        if (PM(4) && IN(pb + 2)) for (int rep = 0; rep < REPS(4) - l * (REPS(4) - 1); ++rep) { FRESH();
            for (int t = F.bid; t < 128; t += F.G) {
                pg8::Gemm g{WSP(bf16, WS_YG), WSP(bf16, WS_WGLU) + (size_t)l * 512 * 512, M, 512, 512}; pg8::OneUnit S{{t >> 1, t & 1}};
                pg8::EpiGlu E{WSP(bf16, WS_YG), WSP(bf16, WS_P), WSP(bf16, WS_H), F.in(19  ) + l * 512};
                pg8::gemm_phase<pg8::EpiGlu, pg8::OneUnit, false, true>(F.lds, g, S, E);
            }
            RSEAM(4);
        }
        SEAM(pb + 2);
        if (PM(5) && IN(pb + 3)) for (int rep = 0; rep < REPS(5) - l * (REPS(5) - 1); ++rep) { FRESH();
            pg8::Gemm g{WSP(bf16, WS_H), WSP(bf16, WS_WP) + (size_t)l * 2048 * 2048, M, DM, DM}; pg8::StaticOrder S; S.init(M, DM, F.G, F.bid);
            pg8::EpiMerge E{WSP(bf16, WS_P), WSP(bf16, WS_MRG)};
            pg8::gemm_phase<pg8::EpiMerge, pg8::StaticOrder, true, true>(F.lds, g, S, E);
            RSEAM(5);
        }
        SEAM(pb + 3);
        if (PM(6) && IN(pb + 4)) for (int rep = 0; rep < REPS(6) - l * (REPS(6) - 1); ++rep) { FRESH();
            pg8::Gemm g{WSP(bf16, WS_MRG), WSP(bf16, WS_WOUT) + (size_t)l * 2048 * 2048, M, DM, DM}; pg8::StaticOrder S; S.init(M, DM, F.G, F.bid);
            const float* xa = (l == 0) ? F.in(0  ) : F.out; const float* xb = (l == 0) ? F.in(1  ) : (F.out + (size_t)MCTX * DM);
            pg8::EpiOut E{xa, xb, F.out, WSP(float, WS_MOD) + (size_t)l * 3 * 6144};
            pg8::gemm_phase<pg8::EpiOut, pg8::StaticOrder, true, true>(F.lds, g, S, E);
            RSEAM(6);
        }
        SEAM(pb + 4);
        if (PM(7) && IN(pb + 5)) { FRESH(); pg_postln(F, l); }
        if (l == 0) SEAM(pb + 5);
    }
#undef IN
#undef SEAM
}

#ifndef N_LAUNCH_MODE
#define N_LAUNCH_MODE 0
#endif
extern "C" void kernel_launch(void* const* d_in, const int* in_sizes, int n_in, void* d_out, int out_size, void* d_ws, size_t ws_size, hipStream_t stream) {
    static int grid = 0;
    if (grid == 0) {
        if (n_in != 31 || ws_size < WS_END) { fprintf(stderr, "kernel_launch: need 31 inputs and >= %zu bytes of workspace; got %d, %zu\n", (size_t)WS_END, n_in, ws_size); grid = -1; return; }
        int dev = 0, cus = 0, per_cu = 0;
        if (hipGetDevice(&dev) != hipSuccess || hipDeviceGetAttribute(&cus, hipDeviceAttributeMultiprocessorCount, dev) != hipSuccess) { grid = -1; return; }
        if (hipFuncSetAttribute((const void*)fwd_kernel, hipFuncAttributeMaxDynamicSharedMemorySize, LDS_BYTES) != hipSuccess) { fprintf(stderr, "kernel_launch: hipFuncSetAttribute failed\n"); grid = -1; return; }
        if (hipOccupancyMaxActiveBlocksPerMultiprocessor(&per_cu, (const void*)fwd_kernel, NT, LDS_BYTES) != hipSuccess || per_cu < 1) { fprintf(stderr, "kernel_launch: occupancy query says %d\n", per_cu); (void)hipGetLastError(); grid = -1; return; }
        grid = cus;
    }
    if (grid < 0) return;
    (void)hipMemsetAsync((char*)d_ws + WS_CTL, 0, CTL_ZERO_BYTES, stream);
    Args a{};
    for (int i = 0; i < 31; ++i) a.in[i] = (const float*)d_in[i];
    a.out = (float*)d_out; a.ws = (unsigned char*)d_ws;
#if N_LAUNCH_MODE == 0
    a.ph_lo = 0; a.ph_hi = N_PHASES;
    { void* params[] = {&a}; (void)params; hipLaunchKernelGGL(fwd_kernel, dim3(grid), dim3(NT), LDS_BYTES, stream, a); hipError_t e = hipPeekAtLastError();
      if (e != hipSuccess) fprintf(stderr, "launch failed: %s\n", hipGetErrorString(e)); }
#else
    for (int p = 0; p < N_PHASES; ++p) { a.ph_lo = p; a.ph_hi = p + 1;
        void* params[] = {&a}; hipError_t e = hipLaunchCooperativeKernel((const void*)fwd_kernel, dim3(grid), dim3(NT), params, LDS_BYTES, stream);
        if (e != hipSuccess) { fprintf(stderr, "launch %d failed: %s\n", p, hipGetErrorString(e)); break; } }
#endif
}
```

```cpp
#include <hip/hip_runtime.h>
#include <hip/hip_cooperative_groups.h>
#include <cstdio>
#include <cstdint>
#include <cmath>
namespace cg = cooperative_groups;

#define GAS __attribute__((address_space(1)))
#define LAS __attribute__((address_space(3)))
typedef unsigned short bf16;
typedef short bf16x8 __attribute__((ext_vector_type(8)));
typedef short s16x4 __attribute__((ext_vector_type(4)));
typedef float f32x2 __attribute__((ext_vector_type(2)));
typedef float f32x4 __attribute__((ext_vector_type(4)));
typedef float f32x16 __attribute__((ext_vector_type(16)));
typedef unsigned u32x2 __attribute__((ext_vector_type(2)));
typedef unsigned u32x4 __attribute__((ext_vector_type(4)));
typedef __bf16 bf16x2_t __attribute__((ext_vector_type(2)));

constexpr int DM = 2048, M = 16384, MCTX = 8192, DIN = 11264, NW = 8, NT = 512;
constexpr int C_XA = 0, C_ZA = 512, C_Q = 1024, C_K = 2048, C_V = 2304, C_ZB = 2560, C_U = 3584, C_VS = 4096, C_ZC = 4608, C_MG = 5120;
constexpr float LN_EPS = 1e-5f;
constexpr float DN_ALPHA = 1.41421356237309515f;
constexpr float LOG2E = 1.4426950408889634f;
constexpr float QSCALE = 0.08838834764831845f * LOG2E;
constexpr int TCH = 32;

constexpr size_t MiB = 1u << 20;
constexpr size_t WS_CTL = 0, CTL_ZERO_BYTES = 1 * MiB;
constexpr size_t WS_MODP = 1 * MiB;
constexpr size_t WS_ROPE = 6 * MiB;
constexpr size_t WS_AT = 6 * MiB + 65536;
constexpr size_t WS_MOD = 6 * MiB + 262144;
constexpr size_t WS_WS = 7 * MiB;
constexpr size_t WS_CK = 8 * MiB;
constexpr size_t WS_CV = 8 * MiB + 524288;
constexpr size_t WS_LAG = 9 * MiB;
constexpr size_t WS_WF = 11 * MiB;
constexpr size_t WS_WY = 27 * MiB;
constexpr size_t WS_WGLU = 43 * MiB;
constexpr size_t WS_WP = 44 * MiB;
constexpr size_t WS_WOUT = 60 * MiB;
constexpr size_t WS_WIN = 76 * MiB;
constexpr size_t WS_H = 164 * MiB;
constexpr size_t WS_MRG = 228 * MiB;
constexpr size_t WS_YG = 292 * MiB;
constexpr size_t WS_F = 308 * MiB;
constexpr size_t WS_SIN = 324 * MiB;
constexpr size_t WS_P = 332 * MiB;
constexpr size_t WS_END = 684 * MiB;
constexpr int CW_WQ = 64;
constexpr int CW_BAR = 8192;

constexpr int RING_BYTES = 131072;
constexpr int LDSCTL_OFF = RING_BYTES, MISC_OFF = LDSCTL_OFF + 320;
constexpr int LDS_BYTES = 147456;

__device__ __forceinline__ unsigned f2bf(float f) { unsigned u = __builtin_bit_cast(unsigned, f); return (u + 0x7fffu + ((u >> 16) & 1u)) >> 16; }
__device__ __forceinline__ unsigned pk2(float lo, float hi) { f32x2 v = {lo, hi}; bf16x2_t b = __builtin_convertvector(v, bf16x2_t); return __builtin_bit_cast(unsigned, b); }
__device__ __forceinline__ float bf2f(unsigned short h) { return __builtin_bit_cast(float, (unsigned)h << 16); }
__device__ __forceinline__ float bflo(unsigned w) { return __builtin_bit_cast(float, w << 16); }
__device__ __forceinline__ float bfhi(unsigned w) { return __builtin_bit_cast(float, w & 0xffff0000u); }
__device__ __forceinline__ float sigmoidf_(float x) { return __builtin_amdgcn_rcpf(1.0f + __expf(-x)); }
__device__ __forceinline__ float siluf_(float x) { return x * __builtin_amdgcn_rcpf(1.0f + __expf(-x)); }
__device__ __forceinline__ float geluf_(float x) { const float z = 1.5957691216057308f * (x + 0.044715f * x * x * x); return x * __builtin_amdgcn_rcpf(1.0f + __expf(-z)); }
__device__ __forceinline__ float wave_sum(float v) {
#pragma unroll
    for (int o = 1; o < 64; o <<= 1) v += __shfl_xor(v, o);
    return v;
}
#define LDS_WAIT() asm volatile("s_waitcnt lgkmcnt(0)" ::: "memory")
#define VM_WAIT() asm volatile("s_waitcnt vmcnt(0)" ::: "memory")
namespace pg8 {
#define PG8_LAS __attribute__((address_space(3)))
typedef unsigned short bf16_t;
typedef short bf16x8 __attribute__((ext_vector_type(8)));
typedef float f32x4 __attribute__((ext_vector_type(4)));
typedef unsigned u32x4 __attribute__((ext_vector_type(4)));
constexpr int BM = 256, BK = 64, HALF = 128, HTB = HALF * BK * 2  , STAGE_BYTES = 8 * HTB, NXCD = 8, WGM = 8;

__host__ __device__ __forceinline__ int lds_byte(int r, int c) { const int st = (r >> 4) * 2 + (c >> 5), rr = r & 15, cc = c & 31, ob = rr * 64 + cc * 2; return st * 1024 + (ob ^ (((ob >> 9) & 1) << 5)); }
__host__ __device__ __forceinline__ void stage_rc(int b, int& R, int& C) { const int st = b / 1024, sb = b % 1024, swz = sb ^ (((sb >> 9) & 1) << 5); R = (st >> 1) * 16 + swz / 64; C = (st & 1) * 32 + (swz % 64) / 2; }
__host__ __device__ __forceinline__ int perm32(int rho) { const int n = rho >> 4, i = rho & 15; return 8 * (i >> 2) + 4 * n + (i & 3); }

struct Unit { int pm, pn; };
struct Gemm { const bf16_t* A; const bf16_t* Bt; int M, N, K; };

struct StaticOrder {
    int nM, nN, nwg, G, c;
    __host__ __device__ void init(int M, int N, int G_, int c_) { nM = M / BM; nN = N / BM; nwg = nM * nN; G = G_; c = c_; }
    __host__ __device__ bool next(int i, Unit& u) const {
        const long L = (long)i * G + c; if (L >= nwg) return false;
        int wgid = (int)L; { const int q = nwg / NXCD, r = nwg % NXCD, xcd = wgid % NXCD, off = wgid / NXCD; wgid = (xcd < r ? xcd * (q + 1) : r * (q + 1) + (xcd - r) * q) + off; }
        const int nig = WGM * nN, gid = wgid / nig, fm = gid * WGM, gsz = (nM - fm) < WGM ? (nM - fm) : WGM;
        u.pm = fm + ((wgid % nig) % gsz); u.pn = (wgid % nig) / gsz; return true;
    }
    __device__ __forceinline__ void a_ready(const Unit&) const {}
    __device__ __forceinline__ void done(const Unit&) const {}
};


struct OneUnit {
    Unit u;
    __device__ __forceinline__ bool next(int i, Unit& o) const { if (i != 0) return false; o = u; return true; }
    __device__ __forceinline__ void a_ready(const Unit&) const {}
    __device__ __forceinline__ void done(const Unit&) const {}
};
#define EPI_ROW0(expr) int row0 = (expr); asm volatile("" : "+v"(row0))

struct EpiInProj {
    static constexpr bool PERM = true, AFTER_DRAIN = false, HAS_MID = false;
    bf16_t* P; float* outk; float* outv; const float* rope;
    template <int ACT> __device__ __forceinline__ void act_store(const f32x4 (&acc)[2][2][4][2], bf16_t* base) const {
#pragma unroll
        for (int ai = 0; ai < 2; ++ai)
#pragma unroll
            for (int m = 0; m < 4; ++m)
#pragma unroll
                for (int bj = 0; bj < 2; ++bj) {
                    f32x4 v0 = acc[ai][bj][m][0], v1 = acc[ai][bj][m][1];
#pragma unroll
                    for (int e = 0; e < 4; ++e) {
                        if (ACT == 1) { v0[e] = siluf_(v0[e]); v1[e] = siluf_(v1[e]); }
                        if (ACT == 2) { v0[e] = geluf_(v0[e]); v1[e] = geluf_(v1[e]); }
                        if (ACT == 3) { v0[e] = sigmoidf_(fminf(fmaxf(v0[e], -30.f), 30.f)); v1[e] = sigmoidf_(fminf(fmaxf(v1[e], -30.f), 30.f)); }
                    }
                    u32x4 w; w.x = pk2(v0[0], v0[1]); w.y = pk2(v0[2], v0[3]); w.z = pk2(v1[0], v1[1]); w.w = pk2(v1[2], v1[3]);
                    *(u32x4*)(base + (size_t)(ai * HALF + m * 16) * DIN + bj * HALF) = w;
                }
    }
    template <bool ROPE, bool KOUT> __device__ __forceinline__ void qk_store(const f32x4 (&acc)[2][2][4][2], bf16_t* base, int row0, int wc, int fq, float sc) const {
        const int p0 = wc * 16 + 4 * fq;
        const int j0 = (wc < 2) ? p0 : p0 - 32;
        const int dbase = (wc < 2) ? p0 : p0 + 32;
        f32x4 cs[8][2];
        if (ROPE) {
#pragma unroll
            for (int ai = 0; ai < 2; ++ai)
#pragma unroll
                for (int m = 0; m < 4; ++m) { const int t = (row0 + ai * HALF + m * 16 - MCTX) & 4095; const int pos = (wc < 2) ? (t >> 6) : (t & 63);
                    const float* rp = rope + (size_t)(pos * 32 + j0) * 2; cs[ai * 4 + m][0] = *(const f32x4*)rp; cs[ai * 4 + m][1] = *(const f32x4*)(rp + 4); }
        }
#pragma unroll
        for (int ai = 0; ai < 2; ++ai)
#pragma unroll
            for (int m = 0; m < 4; ++m)
#pragma unroll
                for (int bj = 0; bj < 2; ++bj) {
                    f32x4 v0 = acc[ai][bj][m][0], v1 = acc[ai][bj][m][1];
                    if (KOUT) { const int row = row0 + ai * HALF + m * 16; const int b = row >> 8, t = row & 255;
                        float* o = outk + (size_t)b * (2 * 256 * 256) + t * 256 + bj * 128 + dbase;
                        *(f32x4*)o = (f32x4){v0[0], v0[2], v1[0], v1[2]}; *(f32x4*)(o + 32) = (f32x4){v0[1], v0[3], v1[1], v1[3]}; }
                    if (ROPE) { const f32x4 c0 = cs[ai * 4 + m][0], c1 = cs[ai * 4 + m][1]; f32x4 w0, w1;
                        w0[0] = v0[0] * c0[0] - v0[1] * c0[1]; w0[1] = v0[0] * c0[1] + v0[1] * c0[0]; w0[2] = v0[2] * c0[2] - v0[3] * c0[3]; w0[3] = v0[2] * c0[3] + v0[3] * c0[2];
                        w1[0] = v1[0] * c1[0] - v1[1] * c1[1]; w1[1] = v1[0] * c1[1] + v1[1] * c1[0]; w1[2] = v1[2] * c1[2] - v1[3] * c1[3]; w1[3] = v1[2] * c1[3] + v1[3] * c1[2];
                        v0 = w0; v1 = w1; }
                    v0 = v0 * sc; v1 = v1 * sc;
                    u32x4 w; w.x = pk2(v0[0], v0[1]); w.y = pk2(v0[2], v0[3]); w.z = pk2(v1[0], v1[1]); w.w = pk2(v1[2], v1[3]);
                    *(u32x4*)(base + (size_t)(ai * HALF + m * 16) * DIN + bj * HALF) = w;
                }
    }
    __device__ __forceinline__ void operator()(const f32x4 (&acc)[2][2][4][2], const Unit& u, int wr, int wc, int fr, int fq) const {
        const int pn = u.pn;
        int kind;
        if (pn < 2) kind = 0; else if (pn < 4) kind = 1; else if (pn < 8) kind = 4; else if (pn == 8) kind = 5; else if (pn == 9) kind = 6;
        else if (pn < 14) kind = 1; else if (pn < 18) kind = 2; else if (pn < 20) kind = 1; else kind = 3;
        const bool lat = u.pm >= 32;
        EPI_ROW0(u.pm * BM + wr * 64 + fr);
        const int colL = wc * 32 + 8 * fq;
        bf16_t* base = P + (size_t)row0 * DIN + pn * BM + colL;
        if (kind == 3) act_store<3>(acc, base);
        else if (kind == 1) act_store<1>(acc, base);
        else if (kind == 2) act_store<2>(acc, base);
        else if (kind == 0) act_store<0>(acc, base);
        else if (kind == 4) { if (lat) qk_store<true, false>(acc, base, row0, wc, fq, QSCALE); else qk_store<false, false>(acc, base, row0, wc, fq, QSCALE); }
        else if (kind == 5) { if (lat) qk_store<true, false>(acc, base, row0, wc, fq, 1.0f); else qk_store<false, true>(acc, base, row0, wc, fq, 1.0f); }
        else {
            act_store<0>(acc, base);
            if (!lat) {
#pragma unroll
                for (int ai = 0; ai < 2; ++ai)
#pragma unroll
                    for (int m = 0; m < 4; ++m)
#pragma unroll
                        for (int bj = 0; bj < 2; ++bj) { const int row = row0 + ai * HALF + m * 16; const int b = row >> 8, t = row & 255;
                            float* o = outv + (size_t)b * (2 * 256 * 256) + t * 256 + bj * 128 + colL; *(f32x4*)o = acc[ai][bj][m][0]; *(f32x4*)(o + 4) = acc[ai][bj][m][1]; }
            }
        }
    }
};

struct EpiGlu {
    static constexpr bool PERM = true, AFTER_DRAIN = false, HAS_MID = false;
    const bf16_t* YG; const bf16_t* P; bf16_t* YC; const float* bias;
    __device__ __forceinline__ void operator()(const f32x4 (&acc)[2][2][4][2], const Unit& u, int wr, int wc, int fr, int fq) const {
        EPI_ROW0(u.pm * BM + wr * 64 + fr);
        const int col0 = u.pn * BM + wc * 32 + 8 * fq;
#pragma unroll
        for (int bj = 0; bj < 2; ++bj) {
            const int col = col0 + bj * HALF;
            const f32x4 b0 = *(const f32x4*)(bias + col), b1 = *(const f32x4*)(bias + col + 4);
            u32x4 yg[8], za[8];
#pragma unroll
            for (int i = 0; i < 8; ++i) { const size_t row = (size_t)(row0 + (i >> 2) * HALF + (i & 3) * 16); yg[i] = *(const u32x4*)(YG + row * 512 + col); za[i] = *(const u32x4*)(P + row * DIN + C_ZA + col); }
#pragma unroll
            for (int i = 0; i < 8; ++i) { const int ai = i >> 2, m = i & 3; const size_t row = (size_t)(row0 + ai * HALF + m * 16);
                const f32x4 v0 = acc[ai][bj][m][0] + b0, v1 = acc[ai][bj][m][1] + b1;
                u32x4 w;
                w.x = pk2(bflo(yg[i].x) * sigmoidf_(v0[0]) * bflo(za[i].x), bfhi(yg[i].x) * sigmoidf_(v0[1]) * bfhi(za[i].x));
                w.y = pk2(bflo(yg[i].y) * sigmoidf_(v0[2]) * bflo(za[i].y), bfhi(yg[i].y) * sigmoidf_(v0[3]) * bfhi(za[i].y));
                w.z = pk2(bflo(yg[i].z) * sigmoidf_(v1[0]) * bflo(za[i].z), bfhi(yg[i].z) * sigmoidf_(v1[1]) * bfhi(za[i].z));
                w.w = pk2(bflo(yg[i].w) * sigmoidf_(v1[2]) * bflo(za[i].w), bfhi(yg[i].w) * sigmoidf_(v1[3]) * bfhi(za[i].w));
                *(u32x4*)(YC + row * DM + col) = w; }
        }
    }
};

struct EpiMerge {
    static constexpr bool PERM = true, AFTER_DRAIN = false, HAS_MID = true;
    const bf16_t* P; bf16_t* O;
    __device__ __forceinline__ bool is_mid(int t) const { return t == 8 || t == 24; }
    __device__ __forceinline__ void mid(f32x4 (&acc)[2][2][4][2], const Unit& u, int wr, int wc, int fr, int fq, int t) const {
        const int s = (t == 8) ? 0 : 1;
        EPI_ROW0(u.pm * BM + wr * 64 + fr);
        const int col0 = u.pn * BM + wc * 32 + 8 * fq;
        const bf16_t* gbase = P + (size_t)row0 * DIN + C_MG + s * 2048 + col0;
#pragma unroll
        for (int ai = 0; ai < 2; ++ai) {
            u32x4 gn[8], gd[8];
#pragma unroll
            for (int i = 0; i < 8; ++i) { const bf16_t* gp = gbase + (size_t)(ai * HALF + (i >> 1) * 16) * DIN + (i & 1) * HALF; gn[i] = *(const u32x4*)gp; gd[i] = *(const u32x4*)(gp + 2048); }
#pragma unroll
            for (int i = 0; i < 8; ++i) { const int m = i >> 1, bj = i & 1; f32x4 r0, r1;
                r0[0] = bflo(gn[i].x) * __builtin_amdgcn_rcpf(bflo(gd[i].x)); r0[1] = bfhi(gn[i].x) * __builtin_amdgcn_rcpf(bfhi(gd[i].x)); r0[2] = bflo(gn[i].y) * __builtin_amdgcn_rcpf(bflo(gd[i].y)); r0[3] = bfhi(gn[i].y) * __builtin_amdgcn_rcpf(bfhi(gd[i].y));
                r1[0] = bflo(gn[i].z) * __builtin_amdgcn_rcpf(bflo(gd[i].z)); r1[1] = bfhi(gn[i].z) * __builtin_amdgcn_rcpf(bfhi(gd[i].z)); r1[2] = bflo(gn[i].w) * __builtin_amdgcn_rcpf(bflo(gd[i].w)); r1[3] = bfhi(gn[i].w) * __builtin_amdgcn_rcpf(bfhi(gd[i].w));
                acc[ai][bj][m][0] *= r0; acc[ai][bj][m][1] *= r1; }
            asm volatile("" ::: "memory");
        }
    }
    __device__ __forceinline__ void operator()(const f32x4 (&acc)[2][2][4][2], const Unit& u, int wr, int wc, int fr, int fq) const {
        EPI_ROW0(u.pm * BM + wr * 64 + fr);
        const int col0 = u.pn * BM + wc * 32 + 8 * fq;
        const bf16_t* gbase = P + (size_t)row0 * DIN + C_MG + 2 * 2048 + col0;
        bf16_t* obase = O + (size_t)row0 * DM + col0;
#pragma unroll
        for (int ai = 0; ai < 2; ++ai) {
            u32x4 g[8];
#pragma unroll
            for (int i = 0; i < 8; ++i) g[i] = *(const u32x4*)(gbase + (size_t)(ai * HALF + (i >> 1) * 16) * DIN + (i & 1) * HALF);
#pragma unroll
            for (int i = 0; i < 8; ++i) { const int m = i >> 1, bj = i & 1;
                const f32x4 v0 = acc[ai][bj][m][0], v1 = acc[ai][bj][m][1];
                u32x4 w;
                w.x = pk2(v0[0] * bflo(g[i].x), v0[1] * bfhi(g[i].x)); w.y = pk2(v0[2] * bflo(g[i].y), v0[3] * bfhi(g[i].y));
                w.z = pk2(v1[0] * bflo(g[i].z), v1[1] * bfhi(g[i].z)); w.w = pk2(v1[2] * bflo(g[i].w), v1[3] * bfhi(g[i].w));
                *(u32x4*)(obase + (size_t)(ai * HALF + m * 16) * DM + bj * HALF) = w; }
        }
    }
};

struct EpiOut {
    static constexpr bool PERM = false, AFTER_DRAIN = false, HAS_MID = false;
    const float* xa; const float* xb;
    float* out; const float* gate;
    __device__ __forceinline__ void operator()(const f32x4 (&acc)[2][2][4][2], const Unit& u, int wr, int wc, int fr, int fq) const {
        EPI_ROW0(u.pm * BM + wr * 64 + fr);
        const int col0 = u.pn * BM + wc * 32 + 4 * fq;
        const int cv = (u.pm < 32) ? 0 : ((u.pm < 48) ? 1 : 2);
        const float* gp = gate + (size_t)cv * 6144 + 4096 + col0;
        const float* xbase = ((u.pm < 32) ? (xa + (size_t)row0 * DM) : (xb + (size_t)(row0 - MCTX) * DM)) + col0;
        float* obase = out + (size_t)row0 * DM + col0;
#pragma unroll
        for (int bj = 0; bj < 2; ++bj) {
            const f32x4 g0 = *(const f32x4*)(gp + bj * HALF), g1 = *(const f32x4*)(gp + bj * HALF + 16);
            f32x4 x[16];
#pragma unroll
            for (int i = 0; i < 16; ++i) x[i] = *(const f32x4*)(xbase + (size_t)((i >> 3) * HALF + ((i >> 1) & 3) * 16) * DM + bj * HALF + (i & 1) * 16);
#pragma unroll
            for (int i = 0; i < 16; ++i) { const int ai = i >> 3, m = (i >> 1) & 3, n = i & 1;
                const f32x4 o = x[i] * DN_ALPHA + ((n == 0) ? g0 : g1) * acc[ai][bj][m][n];
                *(f32x4*)(obase + (size_t)(ai * HALF + m * 16) * DM + bj * HALF + n * 16) = o; }
        }
    }
};

struct EpiNull {
    static constexpr bool PERM = true, AFTER_DRAIN = false, HAS_MID = false;
    float* sink;
    __device__ __forceinline__ void operator()(const f32x4 (&acc)[2][2][4][2], const Unit& u, int wr, int wc, int fr, int fq) const {
        float s = 0.f;
#pragma unroll
        for (int ai = 0; ai < 2; ++ai)
#pragma unroll
            for (int bj = 0; bj < 2; ++bj)
#pragma unroll
                for (int m = 0; m < 4; ++m)
#pragma unroll
                    for (int n = 0; n < 2; ++n) s += (acc[ai][bj][m][n][0] + acc[ai][bj][m][n][1]) + (acc[ai][bj][m][n][2] + acc[ai][bj][m][n][3]);
        if (s == 123456.789f) sink[u.pm * 64 + fr] = s;
    }
};
template <class Epi, class Sched, bool ALIGN_EPI = false, bool SP2 = false>
__device__ __forceinline__ void gemm_phase(PG8_LAS unsigned char* lds, const Gemm g, const Sched& S, const Epi& E, int tid_in) {
    int tid_ = tid_in; asm volatile("" : "+v"(tid_));
    const int tid = tid_, wid = __builtin_amdgcn_readfirstlane(tid >> 6), lane = tid & 63, wr = wid >> 2, wc = wid & 3, fr = lane & 15, fq = lane >> 4;
    const int K = g.K, nt = K / BK;
    unsigned voffA[2], voffB[2];
#pragma unroll
    for (int i = 0; i < 2; ++i) { int R, C; stage_rc(tid * 16 + i * 8192, R, C); const int Rb = Epi::PERM ? ((R & ~31) + perm32(R & 31)) : R;
        voffA[i] = (unsigned)(R * K + C) * 2u; voffB[i] = (unsigned)(Rb * K + C) * 2u; }
    const size_t kstep = (size_t)(BK * 2);
    const size_t hstep = (size_t)HALF * K * 2;
    const size_t tstep = 2 * hstep;
    const unsigned ldsw = (unsigned)wid * 1024u;
    const int aoff = lds_byte(wr * 64 + fr, fq * 8), boff = lds_byte(wc * 32 + fr, fq * 8);
#define PG8_SA(b, h) (((b) * 2 + (h)) * HTB)
#define PG8_SB(b, h) ((4 + (b) * 2 + (h)) * HTB)
#define PG8_STAGE(bufoff, gbase, voff) do { _Pragma("unroll") for (int _i = 0; _i < 2; ++_i) \
        __builtin_amdgcn_global_load_lds((const unsigned*)((const char*)(gbase) + (voff)[_i]), (PG8_LAS unsigned*)(lds + (bufoff) + ldsw + _i * 8192), 16, 0, 0); } while (0)
#define PG8_LDA(dst, b, h) do { _Pragma("unroll") for (int m = 0; m < 4; ++m) _Pragma("unroll") for (int k = 0; k < 2; ++k) dst[m][k] = *(const PG8_LAS bf16x8*)(lds + PG8_SA(b, h) + aoff + m * 2048 + k * 1024); } while (0)
#define PG8_LDB(dst, b, h) do { _Pragma("unroll") for (int n = 0; n < 2; ++n) _Pragma("unroll") for (int k = 0; k < 2; ++k) dst[n][k] = *(const PG8_LAS bf16x8*)(lds + PG8_SB(b, h) + boff + n * 2048 + k * 1024); } while (0)
#define PG8_MMA(ai, bj, At, Bt) do { __builtin_amdgcn_s_setprio(1); _Pragma("unroll") for (int m = 0; m < 4; ++m) _Pragma("unroll") for (int n = 0; n < 2; ++n) _Pragma("unroll") for (int k = 0; k < 2; ++k) \
        acc[ai][bj][m][n] = __builtin_amdgcn_mfma_f32_16x16x32_bf16(Bt[n][k], At[m][k], acc[ai][bj][m][n], 0, 0, 0); __builtin_amdgcn_s_setprio(0); } while (0)
#define PG8_WAIT_V(n) asm volatile("s_waitcnt vmcnt(" #n ")" ::: "memory")
#define PG8_WAIT_L(n) asm volatile("s_waitcnt lgkmcnt(" #n ")" ::: "memory")
#define PG8_BAR __builtin_amdgcn_s_barrier()
#define PG8_SCHED __builtin_amdgcn_sched_barrier(0)
    Unit cur, nxt; int ui = 0;
    if (!S.next(0, cur)) return;
    f32x4 acc[2][2][4][2];
#pragma unroll
    for (int a = 0; a < 2; ++a)
#pragma unroll
        for (int b = 0; b < 2; ++b)
#pragma unroll
            for (int m = 0; m < 4; ++m)
#pragma unroll
                for (int n = 0; n < 2; ++n) acc[a][b][m][n] = (f32x4){0.f, 0.f, 0.f, 0.f};
    bf16x8 At[4][2], B0[2][2], B1[2][2];
    const char* cA = (const char*)g.A + (size_t)cur.pm * tstep; const char* cB = (const char*)g.Bt + (size_t)cur.pn * tstep;
    S.a_ready(cur);
    if constexpr (SP2) {
        PG8_STAGE(PG8_SB(0, 0), cB, voffB); PG8_STAGE(PG8_SB(0, 1), cB + hstep, voffB); PG8_STAGE(PG8_SA(0, 0), cA, voffA); PG8_STAGE(PG8_SA(0, 1), cA + hstep, voffA);
        if (wr == 1) PG8_BAR;
        PG8_WAIT_V(2); PG8_BAR;
        PG8_STAGE(PG8_SB(1, 0), cB + kstep, voffB); PG8_STAGE(PG8_SA(1, 0), cA + kstep, voffA); PG8_STAGE(PG8_SB(1, 1), cB + hstep + kstep, voffB);
        PG8_WAIT_V(6); PG8_BAR;
    } else {
        PG8_STAGE(PG8_SB(0, 0), cB, voffB); PG8_STAGE(PG8_SA(0, 0), cA, voffA); PG8_STAGE(PG8_SB(0, 1), cB + hstep, voffB); PG8_STAGE(PG8_SA(0, 1), cA + hstep, voffA);
        if (wr == 1) PG8_BAR;
        PG8_WAIT_V(4); PG8_BAR;
        PG8_STAGE(PG8_SB(1, 0), cB + kstep, voffB); PG8_STAGE(PG8_SA(1, 0), cA + kstep, voffA); PG8_STAGE(PG8_SB(1, 1), cB + hstep + kstep, voffB);
        PG8_WAIT_V(6); PG8_BAR;
    }
    for (;;) {
        const bool has_next = S.next(ui + 1, nxt);
        const char* nA = has_next ? (const char*)g.A + (size_t)nxt.pm * tstep : cA; const char* nB = has_next ? (const char*)g.Bt + (size_t)nxt.pn * tstep : cB;
        for (int t = 0; t < nt; t += 2) {
            if constexpr (Epi::HAS_MID) { if (E.is_mid(t)) E.mid(acc, cur, wr, wc, fr, fq, t); }
            const bool last = (t == nt - 2);
            const char* a1 = cA + (size_t)(t + 1) * kstep;
            const char* a2 = last ? nA : cA + (size_t)(t + 2) * kstep; const char* b2 = last ? nB : cB + (size_t)(t + 2) * kstep;
            const char* a3 = a2 + kstep; const char* b3 = b2 + kstep;
            if (last && has_next) S.a_ready(nxt);
            if constexpr (SP2) {
            PG8_LDB(B0, 0, 0); PG8_LDB(B1, 0, 1); PG8_SCHED; PG8_LDA(At, 0, 0); PG8_STAGE(PG8_SA(1, 1), a1 + hstep, voffA);
            PG8_WAIT_V(8); PG8_WAIT_L(0); PG8_BAR; PG8_MMA(0, 0, At, B0); PG8_MMA(0, 1, At, B1); PG8_BAR; PG8_SCHED;
            PG8_LDA(At, 0, 1); PG8_STAGE(PG8_SB(0, 0), b2, voffB); PG8_STAGE(PG8_SB(0, 1), b2 + hstep, voffB); PG8_STAGE(PG8_SA(0, 0), a2, voffA);
            PG8_WAIT_V(8); PG8_WAIT_L(0); PG8_BAR; PG8_MMA(1, 0, At, B0); PG8_MMA(1, 1, At, B1); PG8_BAR; PG8_SCHED;
            PG8_LDB(B0, 1, 0); PG8_LDB(B1, 1, 1); PG8_SCHED; PG8_LDA(At, 1, 0); PG8_STAGE(PG8_SA(0, 1), a2 + hstep, voffA);
            PG8_WAIT_V(8); PG8_WAIT_L(0); PG8_BAR; PG8_MMA(0, 0, At, B0); PG8_MMA(0, 1, At, B1); PG8_BAR; PG8_SCHED;
            PG8_LDA(At, 1, 1); PG8_STAGE(PG8_SB(1, 0), b3, voffB); PG8_STAGE(PG8_SB(1, 1), b3 + hstep, voffB); PG8_STAGE(PG8_SA(1, 0), a3, voffA);
            PG8_WAIT_V(8); PG8_WAIT_L(0); PG8_BAR; PG8_MMA(1, 0, At, B0); PG8_MMA(1, 1, At, B1); PG8_BAR; PG8_SCHED;
            } else {
            PG8_LDB(B0, 0, 0); PG8_SCHED; PG8_LDA(At, 0, 0); PG8_STAGE(PG8_SA(1, 1), a1 + hstep, voffA);
            PG8_WAIT_L(8); PG8_BAR; PG8_WAIT_L(0); PG8_MMA(0, 0, At, B0); PG8_BAR; PG8_SCHED;
            PG8_LDB(B1, 0, 1); PG8_STAGE(PG8_SB(0, 0), b2, voffB);
            PG8_BAR; PG8_WAIT_L(0); PG8_MMA(0, 1, At, B1); PG8_BAR;
            PG8_LDA(At, 0, 1); PG8_STAGE(PG8_SA(0, 0), a2, voffA);
            PG8_BAR; PG8_WAIT_L(0); PG8_MMA(1, 0, At, B0); PG8_BAR; PG8_SCHED;
            PG8_STAGE(PG8_SB(0, 1), b2 + hstep, voffB);
            PG8_WAIT_V(6); PG8_BAR; PG8_MMA(1, 1, At, B1); PG8_BAR;
            PG8_LDB(B0, 1, 0); PG8_SCHED; PG8_LDA(At, 1, 0); PG8_STAGE(PG8_SA(0, 1), a2 + hstep, voffA);
            PG8_WAIT_L(8); PG8_BAR; PG8_WAIT_L(0); PG8_MMA(0, 0, At, B0); PG8_BAR; PG8_SCHED;
            PG8_LDB(B1, 1, 1); PG8_STAGE(PG8_SB(1, 0), b3, voffB);
            PG8_BAR; PG8_WAIT_L(0); PG8_MMA(0, 1, At, B1); PG8_BAR;
            PG8_LDA(At, 1, 1); PG8_STAGE(PG8_SA(1, 0), a3, voffA);
            PG8_BAR; PG8_WAIT_L(0); PG8_MMA(1, 0, At, B0); PG8_BAR; PG8_SCHED;
            PG8_STAGE(PG8_SB(1, 1), b3 + hstep, voffB);
            PG8_WAIT_V(6); PG8_BAR; PG8_MMA(1, 1, At, B1); PG8_BAR;
            }
        }
        if constexpr (ALIGN_EPI) { if (wr == 0) PG8_BAR; }
        if constexpr (!Epi::AFTER_DRAIN) { E(acc, cur, wr, wc, fr, fq); S.done(cur); }
        if (!has_next) break;
#pragma unroll
        for (int a = 0; a < 2; ++a)
#pragma unroll
            for (int b = 0; b < 2; ++b)
#pragma unroll
                for (int m = 0; m < 4; ++m)
#pragma unroll
                    for (int n = 0; n < 2; ++n) acc[a][b][m][n] = (f32x4){0.f, 0.f, 0.f, 0.f};
        cur = nxt; cA = nA; cB = nB; ++ui;
        if constexpr (ALIGN_EPI) { if (wr == 1) PG8_BAR; }
    }
    PG8_WAIT_V(0);
    if constexpr (!ALIGN_EPI) { if (wr == 0) PG8_BAR; }
    PG8_BAR;
    if constexpr (Epi::AFTER_DRAIN) { E.fused(acc, cur, wr, wc, fr, fq, lds, wid, lane); S.done(cur); }
#undef PG8_SA
#undef PG8_SB
#undef PG8_STAGE
#undef PG8_LDA
#undef PG8_LDB
#undef PG8_MMA
#undef PG8_WAIT_V
#undef PG8_WAIT_L
#undef PG8_BAR
#undef PG8_SCHED
}
}
#define XB_TMO      128
#define XB_XCNT(j)  (256  + 64 * (j))
#define XB_XSUB(j)  (1280 + 64 * (j))
#define XB_XGEN(j)  (2304 + 64 * (j))
#define XB_TOP      3328
#define XB_TOPGEN   3392
#define XCD_BAR_WORDS 3456
#define XB_SPIN_CAP (1u << 18)

__device__ __forceinline__ unsigned xb_ld(unsigned* p)              { return __hip_atomic_load(p, __ATOMIC_RELAXED, __HIP_MEMORY_SCOPE_AGENT); }
__device__ __forceinline__ unsigned xb_add(unsigned* p, unsigned v) { return __hip_atomic_fetch_add(p, v, __ATOMIC_RELAXED, __HIP_MEMORY_SCOPE_AGENT); }
__device__ __forceinline__ unsigned xb_xcc_id() { return (unsigned)__builtin_amdgcn_s_getreg((3 << 11) | 20) & 0xFu; }
#define XB_SPIN(cond, bar) do { unsigned _sp = 0; while (cond) { __builtin_amdgcn_s_sleep(1); \
    if ((++_sp & 255u) == 0u) { if (xb_ld(&(bar)[XB_TMO])) break; if (_sp > XB_SPIN_CAP) { atomicAdd(&(bar)[XB_TMO], 1u); break; } } } } while (0)

struct XcdBarrier {
    unsigned* bar; unsigned x;
    volatile LAS unsigned* st;
};

__device__ __forceinline__ XcdBarrier xcd_barrier_post(unsigned* bar, volatile LAS unsigned* st) {
    XcdBarrier b; b.bar = bar; b.x = xb_xcc_id(); b.st = st;
    if (threadIdx.x == 0) (void)xb_add(&bar[XB_XCNT(b.x)], 1u);
    return b;
}
__device__ __forceinline__ void xcd_barrier_complete(unsigned* bar, unsigned x, unsigned& nloc, unsigned& nx) {
    const unsigned G = gridDim.x * gridDim.y * gridDim.z;
    unsigned sum, cnt, mine, sp = 0u;
    for (;;) {
        sum = 0u; cnt = 0u; mine = 0u;
#pragma unroll
        for (unsigned j = 0; j < 16; ++j) { const unsigned c = xb_ld(&bar[XB_XCNT(j)]); sum += c; cnt += (c > 0u) ? 1u : 0u; mine = (j == x) ? c : mine; }
        if (sum == G) break;
        __builtin_amdgcn_s_sleep(1);
        if ((++sp & 255u) == 0u) { if (xb_ld(&bar[XB_TMO])) break; if (sp > XB_SPIN_CAP) { atomicAdd(&bar[XB_TMO], 1u); break; } }
    }
    nloc = mine > 0u ? mine : 1u; nx = cnt > 0u ? cnt : 1u;
}

__device__ __forceinline__ void xcd_barrier(const XcdBarrier& b) {
    asm volatile("s_waitcnt vmcnt(0)" ::: "memory");
    __syncthreads();
    if (threadIdx.x == 0) {
        unsigned* bar = b.bar;
        __builtin_amdgcn_s_waitcnt(0);
        unsigned nloc = b.st[0], nx = b.st[1];
        if (nloc == 0u) { xcd_barrier_complete(bar, b.x, nloc, nx); b.st[0] = nloc; b.st[1] = nx; }
        const unsigned old = xb_add(&bar[XB_XSUB(b.x)], 1u);
        const unsigned gen = old / nloc;
        if (old + 1u == (gen + 1u) * nloc) {
            __builtin_amdgcn_fence(__ATOMIC_RELEASE, "agent");
            asm volatile("s_waitcnt vmcnt(0)" ::: "memory");
            const unsigned og = xb_add(&bar[XB_TOP], 1u);
            const unsigned tg = og / nx;
            if (og + 1u == (tg + 1u) * nx) xb_add(&bar[XB_TOPGEN], 1u);
            else XB_SPIN(xb_ld(&bar[XB_TOPGEN]) == tg, bar);
            __builtin_amdgcn_fence(__ATOMIC_ACQUIRE, "agent");
            xb_add(&bar[XB_XGEN(b.x)], 1u);
            asm volatile("s_waitcnt vmcnt(0)" ::: "memory");
        } else {
            XB_SPIN(xb_ld(&bar[XB_XGEN(b.x)]) == gen, bar);
            __builtin_amdgcn_fence(__ATOMIC_ACQUIRE, "agent");
            asm volatile("s_waitcnt vmcnt(0)" ::: "memory");
        }
    }
    __syncthreads();
}


typedef GAS unsigned gu32;
struct Args { const float* in[31]; float* out; unsigned char* ws; int ph_lo, ph_hi; };
typedef const __attribute__((address_space(4))) Args* KArgs;
struct Frame {
    LAS unsigned char* lds;
    volatile LAS unsigned* MISC;
    unsigned* ctl;
    int tid, lane, wave, G, bid;
    unsigned char* ws;
    float* out;
    KArgs ka;
    __device__ __forceinline__ const float* in(int k) const { return ka->in[k]; }
};
#define WSP(T, off) ((T*)(F.ws + (off)))

__device__ __forceinline__ int wq_next(Frame& F, int phase) {
    __syncthreads();
    if (F.tid == 0) F.MISC[16] = __hip_atomic_fetch_add(F.ctl + CW_WQ + 64 * phase, 1u, __ATOMIC_RELAXED, __HIP_MEMORY_SCOPE_AGENT);
    __syncthreads();
    return (int)F.MISC[16];
}

__device__ __forceinline__ void p0_gemv_tile(Frame& F, int idx) {
    const int l = idx / 768, rem = idx % 768, kc = rem / 24, nc = rem % 24, lane = F.lane;
    const int k = kc * 64 + lane;
    const float s0 = siluf_(F.in(6  )[k]), s1 = siluf_(F.in(5  )[k]), s2 = siluf_(F.in(5  )[2048 + k]);
    const float* W = F.in(7  ) + ((size_t)l * 2048 + kc * 64) * 6144 + nc * 256 + lane * 4;
    f32x4 a0 = {0.f, 0.f, 0.f, 0.f}, a1 = a0, a2 = a0;
#pragma unroll 16
    for (int r = 0; r < 64; ++r) {
        const f32x4 wv = *(const f32x4*)(W + (size_t)r * 6144);
        const float t0 = __shfl(s0, r), t1 = __shfl(s1, r), t2 = __shfl(s2, r);
        a0 += wv * t0; a1 += wv * t1; a2 += wv * t2;
    }
    float* o = WSP(float, WS_MODP) + ((size_t)(l * 32 + kc) * 3) * 6144 + nc * 256 + lane * 4;
    *(f32x4*)o = a0; *(f32x4*)(o + 6144) = a1; *(f32x4*)(o + 2 * 6144) = a2;
}
__device__ __forceinline__ int sigma_col(int n) {
    if (n < C_Q || n >= C_V) return n;
    const int hb = n & ~127, c = n & 127, p = c >> 1, e = c & 1;
    return hb + ((p < 32) ? p : p + 32) + 32 * e;
}
__device__ __forceinline__ void p0_transpose_item(const float* W, int N, bf16* WT, int Kd, int koff, bool perm, LAS float* scr, int item, int lane) {
    const int nblk = N / 32, kb = item / nblk, nb = item % nblk, k0 = 64 * kb, n0 = 32 * nb;
    const int ncol = perm ? sigma_col(n0 + (lane & 31)) : (n0 + (lane & 31));
    float tv[32];
#pragma unroll
    for (int i = 0; i < 32; ++i) { const int kk = 2 * i + (lane >> 5); tv[i] = W[(size_t)(k0 + kk) * N + ncol]; }
#pragma unroll
    for (int i = 0; i < 32; ++i) { const int kk = 2 * i + (lane >> 5); scr[kk * 33 + (lane & 31)] = tv[i]; }
    LDS_WAIT(); asm volatile("" ::: "memory");
    const int c = lane & 7;
#pragma unroll
    for (int j = 0; j < 4; ++j) { const int n = (lane >> 3) + 8 * j; const LAS float* s = scr + (8 * c) * 33 + n;
        u32x4 o; o.x = pk2(s[0 * 33], s[1 * 33]); o.y = pk2(s[2 * 33], s[3 * 33]); o.z = pk2(s[4 * 33], s[5 * 33]); o.w = pk2(s[6 * 33], s[7 * 33]);
        *(u32x4*)(WT + (size_t)(n0 + n) * Kd + koff + k0 + 8 * c) = o; }
    LDS_WAIT(); asm volatile("" ::: "memory");
}
__device__ __forceinline__ void p0_ssm_tables(Frame& F, int item4) {
    const int item = item4 >> 2, part = item4 & 3, l = item >> 5, g = item & 31, tid = F.tid;
    LAS float* apow = (LAS float*)F.lds;
    LAS float* Bb = apow + 2 * 33 * 64 * 2;
    LAS float* Cc = Bb + 2 * 64 * 16 * 2;
    __syncthreads();
    for (int idx = tid; idx < 2 * 33 * 64; idx += NT) {
        const int d = idx / (33 * 64), j = (idx / 64) % 33, p = idx & 63;
        const int pi = ((l * 2 + d) * 32 + g) * 64 + p;
        const double lr = (double)F.in(10  )[pi], li = (double)F.in(11  )[pi], dt = exp((double)F.in(12  )[(l * 2 + d) * 32 + g]);
        const double mag = exp(lr * dt * (double)j); double sn, cs; sincos(li * dt * (double)j, &sn, &cs);
        apow[idx * 2] = (float)(mag * cs); apow[idx * 2 + 1] = (float)(mag * sn);
        if (j == TCH && part == 0) { float* at = WSP(float, WS_AT) + (size_t)((l * 32 + g) * 2 + d) * 128; at[p] = (float)(mag * cs); at[64 + p] = (float)(mag * sn); }
    }
    for (int idx = tid; idx < 2 * 64 * 16; idx += NT) {
        const int d = idx / 1024, p = (idx >> 4) & 63, cc = idx & 15;
        const int pi = ((l * 2 + d) * 32 + g) * 64 + p;
        const double lr = (double)F.in(10  )[pi], li = (double)F.in(11  )[pi], dt = exp((double)F.in(12  )[(l * 2 + d) * 32 + g]);
        const double mag = exp(lr * dt); double sn, cs; sincos(li * dt, &sn, &cs);
        const double are = mag * cs, aim = mag * sn, nr = are - 1.0, den = lr * lr + li * li;
        const double fre = (nr * lr + aim * li) / den, fim = (aim * lr - nr * li) / den;
        const double br = (double)F.in(13  )[(size_t)pi * 16 + cc], bi = (double)F.in(14  )[(size_t)pi * 16 + cc];
        Bb[idx * 2] = (float)(fre * br - fim * bi); Bb[idx * 2 + 1] = (float)(fre * bi + fim * br);
        const int ci = (((l * 2 + d) * 32 + g) * 16 + cc) * 64 + p;
        const int co = (d * 16 + cc) * 64 + p;
        Cc[co * 2] = F.in(15  )[ci]; Cc[co * 2 + 1] = F.in(16  )[ci];
    }
    __syncthreads();
    bf16* lagt = WSP(bf16, WS_LAG) + (size_t)(l * 32 + g) * 16384;
    for (int idx = part * 4032 + tid; idx < (part + 1) * 4032; idx += NT) {
        const int L = idx >> 8, delta = L - 31, cc = (idx >> 4) & 15, c2 = idx & 15;
        float v = 0.f;
        if (delta >= 0) { const int j = delta;
            for (int p = 0; p < 64; ++p) { const float ar = apow[((0 * 33 + j) * 64 + p) * 2], ai = apow[((0 * 33 + j) * 64 + p) * 2 + 1];
                const float br = Bb[((0 * 64 + p) * 16 + c2) * 2], bi = Bb[((0 * 64 + p) * 16 + c2) * 2 + 1];
                const float zr = ar * br - ai * bi, zi = ar * bi + ai * br;
                v += Cc[((0 * 16 + cc) * 64 + p) * 2] * zr - Cc[((0 * 16 + cc) * 64 + p) * 2 + 1] * zi; } }
        if (delta <= 0) { const int j = -delta;
            for (int p = 0; p < 64; ++p) { const float ar = apow[((1 * 33 + j) * 64 + p) * 2], ai = apow[((1 * 33 + j) * 64 + p) * 2 + 1];
                const float br = Bb[((1 * 64 + p) * 16 + c2) * 2], bi = Bb[((1 * 64 + p) * 16 + c2) * 2 + 1];
                const float zr = ar * br - ai * bi, zi = ar * bi + ai * br;
                v += Cc[((1 * 16 + cc) * 64 + p) * 2] * zr - Cc[((1 * 16 + cc) * 64 + p) * 2 + 1] * zi; } }
        if (delta == 0 && cc == c2) v += F.in(17  )[l * 512 + g * 16 + cc];
        lagt[idx] = (bf16)f2bf(v);
    }
    bf16* wf = WSP(bf16, WS_WF) + (size_t)(l * 32 + g) * 131072;
    for (int idx = part * 32768 + tid; idx < (part + 1) * 32768; idx += NT) {
        const int row = idx >> 9, col = idx & 511, d = row >> 7, ri = (row >> 6) & 1, p = row & 63, j = col >> 4, c2 = col & 15;
        const int pw = (d == 0) ? (TCH - 1 - j) : j;
        const float ar = apow[((d * 33 + pw) * 64 + p) * 2], ai = apow[((d * 33 + pw) * 64 + p) * 2 + 1];
        const float br = Bb[((d * 64 + p) * 16 + c2) * 2], bi = Bb[((d * 64 + p) * 16 + c2) * 2 + 1];
        wf[idx] = (bf16)f2bf(ri ? (ar * bi + ai * br) : (ar * br - ai * bi));
    }
    bf16* wy = WSP(bf16, WS_WY) + (size_t)(l * 32 + g) * 131072;
    for (int idx = part * 32768 + tid; idx < (part + 1) * 32768; idx += NT) {
        const int row = idx >> 8, col = idx & 255, i = row >> 4, cc = row & 15, d = col >> 7, ri = (col >> 6) & 1, p = col & 63;
        const int pw = (d == 0) ? (i + 1) : (TCH - i);
        const float ar = apow[((d * 33 + pw) * 64 + p) * 2], ai = apow[((d * 33 + pw) * 64 + p) * 2 + 1];
        const float cr = Cc[((d * 16 + cc) * 64 + p) * 2], ci = Cc[((d * 16 + cc) * 64 + p) * 2 + 1];
        wy[idx] = (bf16)f2bf(ri ? -(cr * ai + ci * ar) : (cr * ar - ci * ai));
    }
    __syncthreads();
}
__device__ __forceinline__ void p0_prologue(Frame& F) {
    const int gw = F.bid * NW + F.wave, NGW = F.G * NW;
    for (int it = gw; it < 1536; it += NGW) p0_gemv_tile(F, it);
    for (int it = F.bid; it < 256; it += F.G) p0_ssm_tables(F, it);
    LAS float* scr = (LAS float*)(F.lds + F.wave * 16384);
    constexpr int I_IN = 32 * 352, I_PA = 8 * 64, I_PB = 16 * 64, I_PC = 8 * 64, I_OUT = 32 * 64, I_GLU = 8 * 16;
    constexpr int I_L = I_IN + I_PA + I_PB + I_PC + I_OUT + I_GLU;
    for (int it = gw; it < 2 * I_L; it += NGW) {
        const int l = it / I_L; int r = it % I_L;
        if (r < I_IN) { p0_transpose_item(F.in(9  ) + (size_t)l * 2048 * DIN, DIN, WSP(bf16, WS_WIN) + (size_t)l * DIN * 2048, 2048, 0, true, scr, r, F.lane); continue; } r -= I_IN;
        if (r < I_PA) { p0_transpose_item(F.in(25  ) + (size_t)l * 512 * 2048, 2048, WSP(bf16, WS_WP) + (size_t)l * 2048 * 2048, 2048, 0, false, scr, r, F.lane); continue; } r -= I_PA;
        if (r < I_PB) { p0_transpose_item(F.in(26  ) + (size_t)l * 1024 * 2048, 2048, WSP(bf16, WS_WP) + (size_t)l * 2048 * 2048, 2048, 512, false, scr, r, F.lane); continue; } r -= I_PB;
        if (r < I_PC) { p0_transpose_item(F.in(27  ) + (size_t)l * 512 * 2048, 2048, WSP(bf16, WS_WP) + (size_t)l * 2048 * 2048, 2048, 1536, false, scr, r, F.lane); continue; } r -= I_PC;
        if (r < I_OUT) { p0_transpose_item(F.in(28  ) + (size_t)l * 2048 * 2048, 2048, WSP(bf16, WS_WOUT) + (size_t)l * 2048 * 2048, 2048, 0, false, scr, r, F.lane); continue; } r -= I_OUT;
        p0_transpose_item(F.in(18  ) + (size_t)l * 512 * 512, 512, WSP(bf16, WS_WGLU) + (size_t)l * 512 * 512, 512, 0, false, scr, r, F.lane);
    }
    const int gt = F.bid * NT + F.tid, NGT = F.G * NT;
    for (int i = gt; i < 2 * 2 * 256 * 256; i += NGT) {
        const int col = i & 255, rowi = i >> 8;
        const int hb = col & 128, cc = col & 127, p = cc >> 1, e = cc & 1, src = hb + ((p < 32) ? p : p + 32) + 32 * e;
        WSP(bf16, WS_CK)[i] = (bf16)f2bf(F.in(2  )[(size_t)rowi * 256 + src]);
        WSP(bf16, WS_CV)[i] = (bf16)f2bf(F.in(3  )[i]);
    }
    for (int i = gt; i < 2 * 4 * 128 * 128; i += NGT) WSP(bf16, WS_WS)[i] = (bf16)f2bf(F.in(23  )[i]);
    for (int i = gt; i < 64 * 32; i += NGT) {
        const int pos = i >> 5, j = i & 31;
        const double inv = pow(10000.0, -(double)(2 * j) / 64.0); double sn, cs; sincos((double)pos * inv, &sn, &cs);
        WSP(float, WS_ROPE)[i * 2] = (float)cs; WSP(float, WS_ROPE)[i * 2 + 1] = (float)sn;
    }
}

__device__ __forceinline__ void ln_row(const float* xrow, f32x4 (&v)[8], int lane) {
    const f32x4* xr = (const f32x4*)xrow + lane; float s = 0.f;
#pragma unroll
    for (int j = 0; j < 8; ++j) { v[j] = xr[64 * j]; s += (v[j].x + v[j].y) + (v[j].z + v[j].w); }
    const float mean = wave_sum(s) * (1.f / DM); float s2 = 0.f;
#pragma unroll
    for (int j = 0; j < 8; ++j) { v[j] = v[j] - mean; s2 += (v[j].x * v[j].x + v[j].y * v[j].y) + (v[j].z * v[j].z + v[j].w * v[j].w); }
    const float rstd = 1.f / sqrtf(wave_sum(s2) * (1.f / DM) + LN_EPS);
#pragma unroll
    for (int j = 0; j < 8; ++j) v[j] = v[j] * rstd;
}
__device__ __forceinline__ void ln_renorm(f32x4 (&v)[8]) {
    float s = 0.f;
#pragma unroll
    for (int j = 0; j < 8; ++j) s += (v[j].x + v[j].y) + (v[j].z + v[j].w);
    const float mean = wave_sum(s) * (1.f / DM); float s2 = 0.f;
#pragma unroll
    for (int j = 0; j < 8; ++j) { v[j] = v[j] - mean; s2 += (v[j].x * v[j].x + v[j].y * v[j].y) + (v[j].z * v[j].z + v[j].w * v[j].w); }
    const float rstd = 1.f / sqrtf(wave_sum(s2) * (1.f / DM) + LN_EPS);
#pragma unroll
    for (int j = 0; j < 8; ++j) v[j] = v[j] * rstd;
}
__device__ __forceinline__ void store_h_row(bf16* hrow, const f32x4 (&v)[8], const LAS float* sc1p, const LAS float* sh, int lane) {
#pragma unroll
    for (int j = 0; j < 8; ++j) { const int c = lane * 4 + 256 * j;
        const f32x4 a = *(const LAS f32x4*)(sc1p + c), b = *(const LAS f32x4*)(sh + c);
        const f32x4 o = v[j] * a + b; u32x2 w; w.x = pk2(o.x, o.y); w.y = pk2(o.z, o.w);
        *(u32x2*)(hrow + c) = w; }
}
__device__ __forceinline__ void p1_lnmod(Frame& F) {
    const float* modp = WSP(float, WS_MODP); float* mod = WSP(float, WS_MOD);
    if (F.tid < 144) { const int idx = F.bid * 144 + F.tid; if (idx < 36864) { const int l = idx / 18432, r = idx % 18432, cv = r / 6144, n = r % 6144; float s = F.in(8  )[l * 6144 + n];
        for (int kc = 0; kc < 32; ++kc) s += modp[((size_t)(l * 32 + kc) * 3 + cv) * 6144 + n]; mod[idx] = s; } }
    const int row0 = F.bid * 64, cv = (row0 < MCTX) ? 0 : 1 + ((row0 - MCTX) >> 12);
    LAS float* sc1p = (LAS float*)F.lds; LAS float* sh = sc1p + 2048;
    for (int n = F.tid; n < 4096; n += NT) { float s = F.in(8  )[n];
        for (int kc = 0; kc < 32; ++kc) s += modp[((size_t)(0 * 32 + kc) * 3 + cv) * 6144 + n];
        if (n < 2048) sh[n] = s; else sc1p[n - 2048] = 1.0f + s; }
    __syncthreads();
    bf16* H = WSP(bf16, WS_H);
    for (int i = 0; i < 8; ++i) { const int row = row0 + F.wave * 8 + i;
        const float* xr = (row < MCTX) ? (F.in(0  ) + (size_t)row * DM) : (F.in(1  ) + (size_t)(row - MCTX) * DM);
        f32x4 v[8]; ln_row(xr, v, F.lane); store_h_row(H + (size_t)row * DM, v, sc1p, sh, F.lane); }
    __syncthreads();
}
__device__ __forceinline__ void pg_postln(Frame& F, int l) {
    const float* mod = WSP(float, WS_MOD);
    const int row0 = F.bid * 64, cv = (row0 < MCTX) ? 0 : 1 + ((row0 - MCTX) >> 12);
    LAS float* sc1p = (LAS float*)F.lds; LAS float* sh = sc1p + 2048; LAS float* lg = sh + 2048; LAS float* lb = lg + 2048;
    __syncthreads();
    for (int n = F.tid; n < 2048; n += NT) { lg[n] = F.in(29  )[l * 2048 + n]; lb[n] = F.in(30  )[l * 2048 + n];
        if (l == 0) { sh[n] = mod[(size_t)(1 * 3 + cv) * 6144 + n]; sc1p[n] = 1.0f + mod[(size_t)(1 * 3 + cv) * 6144 + 2048 + n]; } }
    __syncthreads();
    bf16* H = WSP(bf16, WS_H);
    for (int i = 0; i < 8; ++i) { const int row = row0 + F.wave * 8 + i;
        float* orow = F.out + (size_t)row * DM;
        f32x4 v[8]; ln_row(orow, v, F.lane);
#pragma unroll
        for (int j = 0; j < 8; ++j) { const int c = F.lane * 4 + 256 * j; v[j] = v[j] * *(const LAS f32x4*)(lg + c) + *(const LAS f32x4*)(lb + c); *(f32x4*)(orow + c) = v[j]; }
        if (l == 0) { ln_renorm(v); store_h_row(H + (size_t)row * DM, v, sc1p, sh, F.lane); } }
    __syncthreads();
}

__device__ __forceinline__ int crow(int r, int hi) { return (r & 3) + 8 * (r >> 2) + 4 * hi; }
constexpr int AK_PITCH = 272, AV_PITCH = 320, ATT_K_OFF = 0, ATT_V_OFF = 64 * AK_PITCH;
__device__ __forceinline__ s16x4 vtr(const LAS unsigned char* p) { typedef short v4i16_t __attribute__((ext_vector_type(4))); return __builtin_bit_cast(s16x4, __builtin_amdgcn_ds_read_tr16_b64_v4i16((LAS v4i16_t*)p)); }

__device__ __forceinline__ void attn_unit(Frame& F, int l, int kind, int b, int h, int qb) {
    const int lane = F.lane, w = F.wave, r32 = lane & 31, hi = lane >> 5, tid = F.tid;
    const bf16* P = WSP(bf16, WS_P);
    const int kvh = h >> 2;
    const int seq0 = kind ? (MCTX + b * 4096) : (b * 256);
    const int t0 = kind ? qb * 256 : 0;
    const int tq = t0 + 32 * w + r32;
    const size_t qrow = (size_t)(seq0 + tq);
    int tlo = 0, nloc = 4;
    if (kind) { const int lo = (t0 - 128) < 0 ? 0 : (t0 - 128), hi_ = (t0 + 384) > 4096 ? 4096 : (t0 + 384); tlo = lo >> 6; nloc = (hi_ >> 6) - tlo; }
    const int ntile = nloc + (kind ? 4 : 0);
    bf16x8 qf[8];
    { const bf16* qp = P + qrow * DIN + C_Q + h * 128 + hi * 8;
#pragma unroll
      for (int ks = 0; ks < 8; ++ks) qf[ks] = *(const bf16x8*)(qp + 16 * ks); }
    float mrun = F.in(20  )[l * 8 + h] * LOG2E, lrun = (hi == 0) ? 1.0f : 0.0f;
    f32x16 o[4];
#pragma unroll
    for (int i = 0; i < 4; ++i)
#pragma unroll
        for (int r = 0; r < 16; ++r) o[i][r] = 0.f;
    LAS unsigned char* ldsK = F.lds + ATT_K_OFF; LAS unsigned char* ldsV = F.lds + ATT_V_OFF;
    u32x4 kr[2], vr[2];
    const bf16* CK = WSP(bf16, WS_CK) + (size_t)((b * 2 + l) * 256) * 256 + kvh * 128;
    const bf16* CV = WSP(bf16, WS_CV) + (size_t)((b * 2 + l) * 256) * 256 + kvh * 128;
#define ATT_LOAD(i) do { \
        _Pragma("unroll") for (int q_ = 0; q_ < 2; ++q_) { const int c_ = tid + 512 * q_, kv_ = c_ >> 4, dch_ = c_ & 15; \
            if ((i) < nloc) { const bf16* src_ = P + (size_t)(seq0 + (tlo + (i)) * 64 + kv_) * DIN + kvh * 128 + dch_ * 8; kr[q_] = *(const u32x4*)(src_ + C_K); vr[q_] = *(const u32x4*)(src_ + C_V); } \
            else { const size_t off_ = (size_t)(((i) - nloc) * 64 + kv_) * 256 + dch_ * 8; kr[q_] = *(const u32x4*)(CK + off_); vr[q_] = *(const u32x4*)(CV + off_); } } } while (0)
    ATT_LOAD(0);
    for (int i = 0; i < ntile; ++i) {
        __syncthreads();
#pragma unroll
        for (int q_ = 0; q_ < 2; ++q_) { const int c_ = tid + 512 * q_, kv_ = c_ >> 4, dch_ = c_ & 15;
            *(LAS u32x4*)(ldsK + kv_ * AK_PITCH + dch_ * 16) = kr[q_]; *(LAS u32x4*)(ldsV + kv_ * AV_PITCH + dch_ * 16) = vr[q_]; }
        __syncthreads();
        if (i + 1 < ntile) ATT_LOAD(i + 1);
        const bool local = kind && (i < nloc);
        const int k0 = (tlo + i) * 64;
        bool need = true;
        if (local) { const int wq0 = t0 + 32 * w; need = (k0 + 63 >= wq0 - 128) && (k0 <= wq0 + 31 + 128); }
        if (need) {
            f32x16 s0, s1;
#pragma unroll
            for (int r = 0; r < 16; ++r) { s0[r] = 0.f; s1[r] = 0.f; }
#pragma unroll
            for (int ks = 0; ks < 8; ++ks) {
                const bf16x8 a0 = *(const LAS bf16x8*)(ldsK + r32 * AK_PITCH + ks * 32 + hi * 16);
                const bf16x8 a1 = *(const LAS bf16x8*)(ldsK + (32 + r32) * AK_PITCH + ks * 32 + hi * 16);
                s0 = __builtin_amdgcn_mfma_f32_32x32x16_bf16(a0, qf[ks], s0, 0, 0, 0);
                s1 = __builtin_amdgcn_mfma_f32_32x32x16_bf16(a1, qf[ks], s1, 0, 0, 0);
            }
            if (local) {
#pragma unroll
                for (int r = 0; r < 16; ++r) { const int kp = k0 + crow(r, hi); int d0 = kp - tq; d0 = d0 < 0 ? -d0 : d0; int d1 = kp + 32 - tq; d1 = d1 < 0 ? -d1 : d1;
                    if (d0 > 128) s0[r] = -INFINITY; if (d1 > 128) s1[r] = -INFINITY; }
            }
            float mx = fmaxf(s0[0], s1[0]);
#pragma unroll
            for (int r = 1; r < 16; ++r) mx = fmaxf(mx, fmaxf(s0[r], s1[r]));
            mx = fmaxf(mx, __shfl_xor(mx, 32));
            const float mnew = fmaxf(mrun, mx), alpha = __builtin_amdgcn_exp2f(mrun - mnew);
            mrun = mnew; lrun *= alpha;
#pragma unroll
            for (int i2 = 0; i2 < 4; ++i2)
#pragma unroll
                for (int r = 0; r < 16; ++r) o[i2][r] *= alpha;
            float ls = 0.f;
#pragma unroll
            for (int r = 0; r < 16; ++r) { s0[r] = __builtin_amdgcn_exp2f(s0[r] - mnew); s1[r] = __builtin_amdgcn_exp2f(s1[r] - mnew); ls += s0[r] + s1[r]; }
            lrun += ls;
            bf16x8 pb[4];
            { u32x4 t;
              t.x = pk2(s0[0], s0[1]); t.y = pk2(s0[2], s0[3]); t.z = pk2(s0[4], s0[5]); t.w = pk2(s0[6], s0[7]); pb[0] = __builtin_bit_cast(bf16x8, t);
              t.x = pk2(s0[8], s0[9]); t.y = pk2(s0[10], s0[11]); t.z = pk2(s0[12], s0[13]); t.w = pk2(s0[14], s0[15]); pb[1] = __builtin_bit_cast(bf16x8, t);
              t.x = pk2(s1[0], s1[1]); t.y = pk2(s1[2], s1[3]); t.z = pk2(s1[4], s1[5]); t.w = pk2(s1[6], s1[7]); pb[2] = __builtin_bit_cast(bf16x8, t);
              t.x = pk2(s1[8], s1[9]); t.y = pk2(s1[10], s1[11]); t.z = pk2(s1[12], s1[13]); t.w = pk2(s1[14], s1[15]); pb[3] = __builtin_bit_cast(bf16x8, t); }
            const LAS unsigned char* vb = ldsV + (4 * hi + ((lane & 15) >> 2)) * AV_PITCH + ((lane >> 4) & 1) * 32 + (lane & 3) * 8;
#pragma unroll
            for (int s = 0; s < 4; ++s)
#pragma unroll
                for (int db = 0; db < 4; ++db) {
                    const s16x4 lo = vtr(vb + (16 * s) * AV_PITCH + db * 64), hh = vtr(vb + (16 * s + 8) * AV_PITCH + db * 64);
                    const bf16x8 a = {lo[0], lo[1], lo[2], lo[3], hh[0], hh[1], hh[2], hh[3]};
                    o[db] = __builtin_amdgcn_mfma_f32_32x32x16_bf16(a, pb[s], o[db], 0, 0, 0);
                }
        }
    }
#undef ATT_LOAD
    const float ltot = lrun + __shfl_xor(lrun, 32), inv = 1.0f / ltot;
    bf16* YC = WSP(bf16, WS_H) + qrow * DM + 512 + h * 128;
    const bf16* zb = P + qrow * DIN + C_ZB + h * 128;
#pragma unroll
    for (int db = 0; db < 4; ++db)
#pragma unroll
        for (int rg = 0; rg < 4; ++rg) { const int d = 32 * db + 8 * rg + 4 * hi;
            const u32x2 z = *(const u32x2*)(zb + d);
            u32x2 wv; wv.x = pk2(o[db][4 * rg] * inv * bflo(z.x), o[db][4 * rg + 1] * inv * bfhi(z.x)); wv.y = pk2(o[db][4 * rg + 2] * inv * bflo(z.y), o[db][4 * rg + 3] * inv * bfhi(z.y));
            *(u32x2*)(YC + d) = wv; }
}

__device__ __forceinline__ void ssm_stage_u(Frame& F, int g, int rowbase) {
    const bf16* P = WSP(bf16, WS_P);
#pragma unroll
    for (int q = 0; q < 8; ++q) { const int c = F.tid + 512 * q, hh = c & 1, tok = c >> 1, n = tok >> 5, j = tok & 31;
        const u32x4 v = *(const u32x4*)(P + (size_t)(rowbase + tok) * DIN + C_XA + g * 16 + hh * 8);
        *(LAS u32x4*)(F.lds + ((j * 64 + n) * 32 + hh * 16)) = v; }
}
__device__ __forceinline__ void ssm_unit(Frame& F, int l, int g, int tb) {
    const int lane = F.lane, w = F.wave, r32 = lane & 31, hi = lane >> 5, tid = F.tid;
    const int unit = g * 4 + tb;
    const int rowblk = tb * 4096;
    const bool ctx = tb < 2;
    const int nchunk = ctx ? 8 : 128;
    float* Fb = WSP(float, WS_F) + (size_t)unit * 128 * 256;
    bf16* Sb = WSP(bf16, WS_SIN) + (size_t)unit * 128 * 256;
    const bf16* WF = WSP(bf16, WS_WF) + (size_t)(l * 32 + g) * 131072;
    const bf16* WY = WSP(bf16, WS_WY) + (size_t)(l * 32 + g) * 131072;
    LAS unsigned char* ldsU = F.lds;
    LAS unsigned char* ldsL = F.lds + 65536;
    __syncthreads();
    { const u32x4* src = (const u32x4*)(WSP(bf16, WS_LAG) + (size_t)(l * 32 + g) * 16384);
      for (int i = tid; i < 63 * 32; i += NT) *(LAS u32x4*)(ldsL + i * 16) = src[i]; }
    for (int half = 0; half < 2; ++half) {
        const bf16* wfr = WF + (size_t)(32 * w + r32) * 512 + hi * 8;
        bf16x8 afr[32];
#pragma unroll
        for (int j = 0; j < 32; ++j) afr[j] = *(const bf16x8*)(wfr + 16 * j);
        __syncthreads();
        ssm_stage_u(F, g, rowblk + half * 2048);
        __syncthreads();
        f32x16 acc[2];
#pragma unroll
        for (int r = 0; r < 16; ++r) { acc[0][r] = 0.f; acc[1][r] = 0.f; }
#pragma unroll
        for (int j = 0; j < 32; ++j) {
            const bf16x8 b0 = *(const LAS bf16x8*)(ldsU + (j * 64 + r32) * 32 + hi * 16), b1 = *(const LAS bf16x8*)(ldsU + (j * 64 + 32 + r32) * 32 + hi * 16);
            acc[0] = __builtin_amdgcn_mfma_f32_32x32x16_bf16(afr[j], b0, acc[0], 0, 0, 0);
            acc[1] = __builtin_amdgcn_mfma_f32_32x32x16_bf16(afr[j], b1, acc[1], 0, 0, 0);
        }
#pragma unroll
        for (int ib = 0; ib < 2; ++ib)
#pragma unroll
            for (int rg = 0; rg < 4; ++rg) { float* o = Fb + (size_t)(half * 64 + ib * 32 + r32) * 256 + 32 * w + 8 * rg + 4 * hi;
                *(f32x4*)o = (f32x4){acc[ib][4 * rg], acc[ib][4 * rg + 1], acc[ib][4 * rg + 2], acc[ib][4 * rg + 3]}; }
    }
    __syncthreads();
    { const int nseq = ctx ? 16 : 1;
      const float* at = WSP(float, WS_AT) + (size_t)((l * 32 + g) * 2) * 128;
      for (int it = tid; it < nseq * 128; it += NT) {
          const int sq = it >> 7, d = (it >> 6) & 1, p = it & 63;
          const float ar = at[d * 128 + p], ai = at[d * 128 + 64 + p];
          float sr = 0.f, si = 0.f;
          if (!ctx) { const float* s0 = F.in(4  ) + (size_t)((((tb - 2) * 2 + l) * 2 + d) * 2) * 2048 + g * 64 + p; sr = s0[0]; si = s0[2048]; }
          float fr_[8], fi_[8], gr_[8], gi_[8];
#pragma unroll
          for (int e = 0; e < 8; ++e) { const int cc = d ? (nchunk - 1 - e) : e, n = sq * nchunk + cc; const float* f = Fb + (size_t)n * 256 + d * 128 + p; fr_[e] = f[0]; fi_[e] = f[64]; }
          for (int c0 = 0; c0 < nchunk; c0 += 8) {
              if (c0 + 8 < nchunk) {
#pragma unroll
                  for (int e = 0; e < 8; ++e) { const int cI = c0 + 8 + e, cc = d ? (nchunk - 1 - cI) : cI, n = sq * nchunk + cc; const float* f = Fb + (size_t)n * 256 + d * 128 + p; gr_[e] = f[0]; gi_[e] = f[64]; }
              }
#pragma unroll
              for (int e = 0; e < 8; ++e) { const int cI = c0 + e, cc = d ? (nchunk - 1 - cI) : cI, n = sq * nchunk + cc;
                  bf16* so = Sb + (size_t)n * 256 + d * 128 + p; so[0] = (bf16)f2bf(sr); so[64] = (bf16)f2bf(si);
                  const float nr = ar * sr - ai * si + fr_[e], ni = ar * si + ai * sr + fi_[e]; sr = nr; si = ni; }
#pragma unroll
              for (int e = 0; e < 8; ++e) { fr_[e] = gr_[e]; fi_[e] = gi_[e]; }
          }
          if (ctx) { const int bb = tb * 16 + sq; float* o = F.out + (size_t)M * DM + 2 * (size_t)(32 * 2 * 256 * 256) + (size_t)((((bb * 2 + l) * 2 + d) * 2) * 2048) + g * 64 + p; o[0] = sr; o[2048] = si; }
      } }
    bf16* YG = WSP(bf16, WS_YG);
    for (int half = 0; half < 2; ++half) {
        __syncthreads();
        ssm_stage_u(F, g, rowblk + half * 2048);
        __syncthreads();
        f32x16 acc[2][2];
#pragma unroll
        for (int a_ = 0; a_ < 2; ++a_)
#pragma unroll
            for (int b_ = 0; b_ < 2; ++b_)
#pragma unroll
                for (int r = 0; r < 16; ++r) acc[a_][b_][r] = 0.f;
        const LAS unsigned char* lagp = ldsL + (r32 & 15) * 32 + hi * 16;
#pragma unroll 4
        for (int j = 0; j < 32; ++j) {
            const bf16x8 b0 = *(const LAS bf16x8*)(ldsU + (j * 64 + r32) * 32 + hi * 16), b1 = *(const LAS bf16x8*)(ldsU + (j * 64 + 32 + r32) * 32 + hi * 16);
#pragma unroll
            for (int rr = 0; rr < 2; ++rr) { const int i = 2 * (2 * w + rr) + (r32 >> 4);
                const bf16x8 a = *(const LAS bf16x8*)(lagp + (i - j + 31) * 512);
                acc[rr][0] = __builtin_amdgcn_mfma_f32_32x32x16_bf16(a, b0, acc[rr][0], 0, 0, 0);
                acc[rr][1] = __builtin_amdgcn_mfma_f32_32x32x16_bf16(a, b1, acc[rr][1], 0, 0, 0); }
        }
#pragma unroll 8
        for (int ks = 0; ks < 16; ++ks) {
            const bf16x8 b0 = *(const bf16x8*)(Sb + (size_t)(half * 64 + r32) * 256 + 16 * ks + hi * 8), b1 = *(const bf16x8*)(Sb + (size_t)(half * 64 + 32 + r32) * 256 + 16 * ks + hi * 8);
#pragma unroll
            for (int rr = 0; rr < 2; ++rr) {
                const bf16x8 a = *(const bf16x8*)(WY + (size_t)(32 * (2 * w + rr) + r32) * 256 + 16 * ks + hi * 8);
                acc[rr][0] = __builtin_amdgcn_mfma_f32_32x32x16_bf16(a, b0, acc[rr][0], 0, 0, 0);
                acc[rr][1] = __builtin_amdgcn_mfma_f32_32x32x16_bf16(a, b1, acc[rr][1], 0, 0, 0); }
        }
#pragma unroll
        for (int rr = 0; rr < 2; ++rr)
#pragma unroll
            for (int ib = 0; ib < 2; ++ib)
#pragma unroll
                for (int rg = 0; rg < 4; ++rg) { const int i = 2 * (2 * w + rr) + (rg >> 1), c = 8 * (rg & 1) + 4 * hi, n = ib * 32 + r32;
                    const size_t row = (size_t)(rowblk + half * 2048 + n * 32 + i);
                    u32x2 wv; wv.x = pk2(geluf_(acc[rr][ib][4 * rg]), geluf_(acc[rr][ib][4 * rg + 1])); wv.y = pk2(geluf_(acc[rr][ib][4 * rg + 2]), geluf_(acc[rr][ib][4 * rg + 3]));
                    *(u32x2*)(YG + row * 512 + g * 16 + c) = wv; }
    }
}

constexpr int SG_PITCH = 272;
__device__ __forceinline__ void sgu_unit(Frame& F, int l, int ck, int g) {
    const int lane = F.lane, w = F.wave, r32 = lane & 31, hi = lane >> 5, tid = F.tid;
    const bf16* P = WSP(bf16, WS_P);
    const int row0 = ck * 128;
    LAS unsigned char* vnt = F.lds;
    __syncthreads();
    {
      const int q = tid >> 2, qq = tid & 3;
      const bf16* vrow = P + (size_t)(row0 + q) * DIN + C_VS + qq * 32;
      u32x4 mine[4]; float s = 0.f, s2 = 0.f;
#pragma unroll
      for (int gg = 0; gg < 4; ++gg)
#pragma unroll
          for (int k = 0; k < 4; ++k) { const u32x4 v = *(const u32x4*)(vrow + gg * 128 + k * 8); if (gg == g) mine[k] = v;
              const float f0 = bflo(v.x), f1 = bfhi(v.x), f2 = bflo(v.y), f3 = bfhi(v.y), f4 = bflo(v.z), f5 = bfhi(v.z), f6 = bflo(v.w), f7 = bfhi(v.w);
              s += ((f0 + f1) + (f2 + f3)) + ((f4 + f5) + (f6 + f7)); s2 += ((f0 * f0 + f1 * f1) + (f2 * f2 + f3 * f3)) + ((f4 * f4 + f5 * f5) + (f6 * f6 + f7 * f7)); }
      s += __shfl_xor(s, 1); s += __shfl_xor(s, 2); s2 += __shfl_xor(s2, 1); s2 += __shfl_xor(s2, 2);
      const float mean = s * (1.f / 512.f), var = fmaxf(s2 * (1.f / 512.f) - mean * mean, 0.f), rstd = 1.f / sqrtf(var + LN_EPS);
      const float* lgp = F.in(21  ) + l * 512 + g * 128 + qq * 32; const float* lbp = F.in(22  ) + l * 512 + g * 128 + qq * 32;
#pragma unroll
      for (int k = 0; k < 4; ++k) { const unsigned ww[4] = {mine[k].x, mine[k].y, mine[k].z, mine[k].w};
#pragma unroll
          for (int e = 0; e < 4; ++e) { const int c = qq * 32 + k * 8 + e * 2;
              const float v0 = (bflo(ww[e]) - mean) * rstd * lgp[k * 8 + e * 2] + lbp[k * 8 + e * 2], v1 = (bfhi(ww[e]) - mean) * rstd * lgp[k * 8 + e * 2 + 1] + lbp[k * 8 + e * 2 + 1];
              *(LAS unsigned short*)(vnt + c * SG_PITCH + q * 2) = (unsigned short)f2bf(v0); *(LAS unsigned short*)(vnt + (c + 1) * SG_PITCH + q * 2) = (unsigned short)f2bf(v1); } }
    }
    __syncthreads();
    const int pb = w >> 1, cb0 = 2 * (w & 1);
    const bf16* Ws = WSP(bf16, WS_WS) + (size_t)((l * 4 + g) * 128 + 32 * pb + r32) * 128 + hi * 8;
    f32x16 acc[2];
#pragma unroll
    for (int r = 0; r < 16; ++r) { acc[0][r] = 0.f; acc[1][r] = 0.f; }
#pragma unroll
    for (int ks = 0; ks < 8; ++ks) {
        const bf16x8 a = *(const bf16x8*)(Ws + 16 * ks);
        const bf16x8 b0 = *(const LAS bf16x8*)(vnt + (32 * cb0 + r32) * SG_PITCH + (16 * ks + 8 * hi) * 2), b1 = *(const LAS bf16x8*)(vnt + (32 * (cb0 + 1) + r32) * SG_PITCH + (16 * ks + 8 * hi) * 2);
        acc[0] = __builtin_amdgcn_mfma_f32_32x32x16_bf16(a, b0, acc[0], 0, 0, 0);
        acc[1] = __builtin_amdgcn_mfma_f32_32x32x16_bf16(a, b1, acc[1], 0, 0, 0);
    }
    bf16* YC = WSP(bf16, WS_H);
    const float* bs = F.in(24  ) + (l * 4 + g) * 128;
    LAS float* outt = (LAS float*)(F.lds + 36864);
#pragma unroll
    for (int cbi = 0; cbi < 2; ++cbi)
#pragma unroll
        for (int r = 0; r < 16; ++r) { const int p = 32 * pb + crow(r, hi), c = 32 * (cb0 + cbi) + r32; outt[p * 132 + c] = acc[cbi][r] + bs[p]; }
    __syncthreads();
    { const int p = tid >> 2, cq = (tid & 3) * 32; const size_t row = (size_t)(row0 + p);
#pragma unroll
      for (int k = 0; k < 4; ++k) { const int c = cq + 8 * k;
          const u32x4 u8 = *(const u32x4*)(P + row * DIN + C_U + g * 128 + c), z8 = *(const u32x4*)(P + row * DIN + C_ZC + g * 128 + c);
          const f32x4 o0 = *(const LAS f32x4*)(outt + p * 132 + c), o1 = *(const LAS f32x4*)(outt + p * 132 + c + 4);
          u32x4 wv;
          wv.x = pk2(o0[0] * bflo(u8.x) * bflo(z8.x), o0[1] * bfhi(u8.x) * bfhi(z8.x)); wv.y = pk2(o0[2] * bflo(u8.y) * bflo(z8.y), o0[3] * bfhi(u8.y) * bfhi(z8.y));
          wv.z = pk2(o1[0] * bflo(u8.z) * bflo(z8.z), o1[1] * bfhi(u8.z) * bfhi(z8.z)); wv.w = pk2(o1[2] * bflo(u8.w) * bflo(z8.w), o1[3] * bfhi(u8.w) * bfhi(z8.w));
          *(u32x4*)(YC + row * DM + 1536 + g * 128 + c) = wv; } }
}

#ifndef PHASE_MASK
#define PHASE_MASK 0xff
#endif
#define PM(k) ((PHASE_MASK >> (k)) & 1)
#ifndef UNIT_MASK
#define UNIT_MASK 7
#endif
#define UM(k) (((rep == 0 ? 7 : UNIT_MASK) >> (k)) & 1)
#ifndef REPEAT_PHASE
#define REPEAT_PHASE -1
#endif
constexpr int N_PHASES = 14;
__global__ void __launch_bounds__(NT, 2) fwd_kernel(Args args) {
    extern __shared__ __attribute__((aligned(16))) unsigned char lds[];
    Frame F;
    F.lds = (LAS unsigned char*)lds;
    F.MISC = (volatile LAS unsigned*)(F.lds + MISC_OFF);
    F.tid = threadIdx.x; F.lane = F.tid & 63; F.wave = __builtin_amdgcn_readfirstlane(F.tid >> 6);
    F.G = gridDim.x; F.bid = blockIdx.x;
    F.ws = args.ws; F.out = args.out; F.ctl = (unsigned*)(args.ws + WS_CTL);
    F.ka = (KArgs)__builtin_amdgcn_kernarg_segment_ptr();
    for (int u = F.tid; u < (LDS_BYTES - LDSCTL_OFF) / 4; u += NT) ((LAS unsigned*)(F.lds + LDSCTL_OFF))[u] = 0u;
    __syncthreads();
    XcdBarrier bar = xcd_barrier_post((unsigned*)(F.ctl + CW_BAR), F.MISC + 8);
    const int lo = args.ph_lo, hi = args.ph_hi;
#define IN(k) (lo <= (k) && (k) < hi)
#define FRESH() do { asm volatile("" : "+s"(F.ka)); asm volatile("" : "+v"(F.tid)); F.lane = F.tid & 63; F.wave = __builtin_amdgcn_readfirstlane(F.tid >> 6); } while (0)
#define SEAM(k) do { if (IN(k) && IN((k) + 1)) xcd_barrier(bar); } while (0)

#define REPS(k) ((REPEAT_PHASE == (k)) ? 2 : 1)
#define RSEAM(k) do { if (rep + 1 < REPS(k)) xcd_barrier(bar); } while (0)
    if (PM(0) && IN(0)) for (int rep = 0; rep < REPS(0); ++rep) { FRESH(); p0_prologue(F); RSEAM(0); }
    SEAM(0);
    if (PM(1) && IN(1)) for (int rep = 0; rep < REPS(1); ++rep) { FRESH(); p1_lnmod(F); RSEAM(1); }
    SEAM(1);
    for (int l = 0; l < 2; ++l) {
        const int pb = 2 + 6 * l;
        if (PM(2) && IN(pb)) for (int rep = 0; rep < REPS(2) - l * (REPS(2) - 1); ++rep) { FRESH();
            pg8::Gemm g{WSP(bf16, WS_H), WSP(bf16, WS_WIN) + (size_t)l * DIN * 2048, M, DIN, DM}; pg8::StaticOrder S; S.init(M, DIN, F.G, F.bid);
            float* okv = F.out + (size_t)M * DM + (size_t)l * 256 * 256;
            pg8::EpiInProj E{WSP(bf16, WS_P), okv, okv + (size_t)32 * 2 * 256 * 256, WSP(float, WS_ROPE)};
            pg8::gemm_phase<pg8::EpiInProj, pg8::StaticOrder, true, true>(F.lds, g, S, E, F.tid);
            RSEAM(2);
        }
        if (REPEAT_PHASE >= 8 && l == 0 && IN(pb)) { xcd_barrier(bar); FRESH();
            const int NN = (REPEAT_PHASE == 8) ? DIN : DM;
            pg8::Gemm g{WSP(bf16, WS_H), WSP(bf16, WS_WIN), M, NN, DM}; pg8::StaticOrder S; S.init(M, NN, F.G, F.bid);
            pg8::EpiNull E{WSP(float, WS_F)};
            pg8::gemm_phase<pg8::EpiNull, pg8::StaticOrder, true, true>(F.lds, g, S, E, F.tid);
        }
        SEAM(pb);
        if (PM(3) && IN(pb + 1)) for (int rep = 0; rep < REPS(3) - l * (REPS(3) - 1); ++rep) {
            for (;;) {
                int u = wq_next(F, pb + 1 + 32 * rep); FRESH();
                if (u >= 1152) break;
                if (u < 256) { if (UM(0)) attn_unit(F, l, 1, u >> 7, (u >> 4) & 7, u & 15); continue; } u -= 256;
                if (u < 128) { if (UM(1)) ssm_unit(F, l, u >> 2, u & 3); continue; } u -= 128;
                if (u < 256) { if (UM(0)) attn_unit(F, l, 0, u >> 3, u & 7, 0); continue; } u -= 256;
                if (UM(2)) sgu_unit(F, l, u >> 2, u & 3);
            }
            __syncthreads();
            RSEAM(3);
        }
        SEAM(pb + 1);
        if (PM(4) && IN(pb + 2)) for (int rep = 0; rep < REPS(4) - l * (REPS(4) - 1); ++rep) { FRESH();
            for (int t = F.bid; t < 128; t += F.G) {
                pg8::Gemm g{WSP(bf16, WS_YG), WSP(bf16, WS_WGLU) + (size_t)l * 512 * 512, M, 512, 512}; pg8::OneUnit S{{t >> 1, t & 1}};
                pg8::EpiGlu E{WSP(bf16, WS_YG), WSP(bf16, WS_P), WSP(bf16, WS_H), F.in(19  ) + l * 512};
                pg8::gemm_phase<pg8::EpiGlu, pg8::OneUnit, false, true>(F.lds, g, S, E, F.tid);
            }
            RSEAM(4);
        }
        SEAM(pb + 2);
        if (PM(5) && IN(pb + 3)) for (int rep = 0; rep < REPS(5) - l * (REPS(5) - 1); ++rep) { FRESH();
            pg8::Gemm g{WSP(bf16, WS_H), WSP(bf16, WS_WP) + (size_t)l * 2048 * 2048, M, DM, DM}; pg8::StaticOrder S; S.init(M, DM, F.G, F.bid);
            pg8::EpiMerge E{WSP(bf16, WS_P), WSP(bf16, WS_MRG)};
            pg8::gemm_phase<pg8::EpiMerge, pg8::StaticOrder, true, true>(F.lds, g, S, E, F.tid);
            RSEAM(5);
        }
        SEAM(pb + 3);
        if (PM(6) && IN(pb + 4)) for (int rep = 0; rep < REPS(6) - l * (REPS(6) - 1); ++rep) { FRESH();
            pg8::Gemm g{WSP(bf16, WS_MRG), WSP(bf16, WS_WOUT) + (size_t)l * 2048 * 2048, M, DM, DM}; pg8::StaticOrder S; S.init(M, DM, F.G, F.bid);
            const float* xa = (l == 0) ? F.in(0  ) : F.out; const float* xb = (l == 0) ? F.in(1  ) : (F.out + (size_t)MCTX * DM);
            pg8::EpiOut E{xa, xb, F.out, WSP(float, WS_MOD) + (size_t)l * 3 * 6144};
            pg8::gemm_phase<pg8::EpiOut, pg8::StaticOrder, true, true>(F.lds, g, S, E, F.tid);
            RSEAM(6);
        }
        SEAM(pb + 4);
        if (PM(7) && IN(pb + 5)) { FRESH(); pg_postln(F, l); }
        if (l == 0) SEAM(pb + 5);
    }
#undef IN
#undef SEAM
}

#ifndef N_LAUNCH_MODE
#define N_LAUNCH_MODE 0
#endif
extern "C" void kernel_launch(void* const* d_in, const int* in_sizes, int n_in, void* d_out, int out_size, void* d_ws, size_t ws_size, hipStream_t stream) {
    static int grid = 0;
    if (grid == 0) {
        if (n_in != 31 || ws_size < WS_END) { fprintf(stderr, "kernel_launch: need 31 inputs and >= %zu bytes of workspace; got %d, %zu\n", (size_t)WS_END, n_in, ws_size); grid = -1; return; }
        int dev = 0, cus = 0, per_cu = 0;
        if (hipGetDevice(&dev) != hipSuccess || hipDeviceGetAttribute(&cus, hipDeviceAttributeMultiprocessorCount, dev) != hipSuccess) { grid = -1; return; }
        if (hipFuncSetAttribute((const void*)fwd_kernel, hipFuncAttributeMaxDynamicSharedMemorySize, LDS_BYTES) != hipSuccess) { fprintf(stderr, "kernel_launch: hipFuncSetAttribute failed\n"); grid = -1; return; }
        if (hipOccupancyMaxActiveBlocksPerMultiprocessor(&per_cu, (const void*)fwd_kernel, NT, LDS_BYTES) != hipSuccess || per_cu < 1) { fprintf(stderr, "kernel_launch: occupancy query says %d\n", per_cu); (void)hipGetLastError(); grid = -1; return; }
        grid = cus;
    }
    if (grid < 0) return;
    (void)hipMemsetAsync((char*)d_ws + WS_CTL, 0, CTL_ZERO_BYTES, stream);
    Args a{};
    for (int i = 0; i < 31; ++i) a.in[i] = (const float*)d_in[i];
    a.out = (float*)d_out; a.ws = (unsigned char*)d_ws;
#if N_LAUNCH_MODE == 0
    a.ph_lo = 0; a.ph_hi = N_PHASES;
    { void* params[] = {&a}; (void)params; hipLaunchKernelGGL(fwd_kernel, dim3(grid), dim3(NT), LDS_BYTES, stream, a); hipError_t e = hipPeekAtLastError();
      if (e != hipSuccess) fprintf(stderr, "launch failed: %s\n", hipGetErrorString(e)); }
#else
    for (int p = 0; p < N_PHASES; ++p) { a.ph_lo = p; a.ph_hi = p + 1;
        void* params[] = {&a}; hipError_t e = hipLaunchCooperativeKernel((const void*)fwd_kernel, dim3(grid), dim3(NT), params, LDS_BYTES, stream);
        if (e != hipSuccess) { fprintf(stderr, "launch %d failed: %s\n", p, hipGetErrorString(e)); break; } }
#endif
}
```

```cpp
#include <hip/hip_runtime.h>
#include <hip/hip_cooperative_groups.h>
#include <cstdio>
#include <cstdint>
#include <cmath>
namespace cg = cooperative_groups;

#define GAS __attribute__((address_space(1)))
#define LAS __attribute__((address_space(3)))
typedef unsigned short bf16;
typedef short bf16x8 __attribute__((ext_vector_type(8)));
typedef short s16x4 __attribute__((ext_vector_type(4)));
typedef float f32x2 __attribute__((ext_vector_type(2)));
typedef float f32x4 __attribute__((ext_vector_type(4)));
typedef float f32x16 __attribute__((ext_vector_type(16)));
typedef unsigned u32x2 __attribute__((ext_vector_type(2)));
typedef unsigned u32x4 __attribute__((ext_vector_type(4)));
typedef __bf16 bf16x2_t __attribute__((ext_vector_type(2)));

constexpr int DM = 2048, M = 16384, MCTX = 8192, DIN = 11264, PP = 5120, NW = 8, NT = 512;
constexpr int C_XA = 0, C_ZA = 512, C_Q = 1024, C_K = 2048, C_V = 2304, C_ZB = 2560, C_U = 3584, C_VS = 4096, C_ZC = 4608, C_MG = 5120;
constexpr float LN_EPS = 1e-5f;
constexpr float DN_ALPHA = 1.41421356237309515f;
constexpr float LOG2E = 1.4426950408889634f;
constexpr float QSCALE = 0.08838834764831845f * LOG2E;
constexpr int TCH = 32;

constexpr size_t MiB = 1u << 20;
constexpr size_t WS_CTL = 0, CTL_ZERO_BYTES = 1 * MiB;
constexpr size_t WS_MODP = 1 * MiB;
constexpr size_t WS_ROPE = 6 * MiB;
constexpr size_t WS_AT = 6 * MiB + 65536;
constexpr size_t WS_MOD = 6 * MiB + 262144;
constexpr size_t WS_WS = 7 * MiB;
constexpr size_t WS_CK = 8 * MiB;
constexpr size_t WS_CV = 8 * MiB + 524288;
constexpr size_t WS_LAG = 9 * MiB;
constexpr size_t WS_WF = 11 * MiB;
constexpr size_t WS_WY = 27 * MiB;
constexpr size_t WS_WGLU = 43 * MiB;
constexpr size_t WS_WP = 44 * MiB;
constexpr size_t WS_WOUT = 60 * MiB;
constexpr size_t WS_WIN = 76 * MiB;
constexpr size_t WS_H = 164 * MiB;
constexpr size_t WS_MRG = 228 * MiB;
constexpr size_t WS_YG = 292 * MiB;
constexpr size_t WS_F = 308 * MiB;
constexpr size_t WS_SIN = 324 * MiB;
constexpr size_t WS_P = 332 * MiB;
constexpr size_t WS_GT = 492 * MiB;
constexpr size_t WS_END = 684 * MiB;
constexpr int CW_WQ = 64;
constexpr int CW_BAR = 8192;

constexpr int RING_BYTES = 131072;
constexpr int LDSCTL_OFF = RING_BYTES, MISC_OFF = LDSCTL_OFF + 320;
constexpr int LDS_BYTES = 147456;

__device__ __forceinline__ unsigned f2bf(float f) { unsigned u = __builtin_bit_cast(unsigned, f); return (u + 0x7fffu + ((u >> 16) & 1u)) >> 16; }
__device__ __forceinline__ unsigned pk2(float lo, float hi) { f32x2 v = {lo, hi}; bf16x2_t b = __builtin_convertvector(v, bf16x2_t); return __builtin_bit_cast(unsigned, b); }
__device__ __forceinline__ float bf2f(unsigned short h) { return __builtin_bit_cast(float, (unsigned)h << 16); }
__device__ __forceinline__ float bflo(unsigned w) { return __builtin_bit_cast(float, w << 16); }
__device__ __forceinline__ float bfhi(unsigned w) { return __builtin_bit_cast(float, w & 0xffff0000u); }
__device__ __forceinline__ float sigmoidf_(float x) { return __builtin_amdgcn_rcpf(1.0f + __expf(-x)); }
__device__ __forceinline__ float siluf_(float x) { return x * __builtin_amdgcn_rcpf(1.0f + __expf(-x)); }
__device__ __forceinline__ float geluf_(float x) { const float z = 1.5957691216057308f * (x + 0.044715f * x * x * x); return x * __builtin_amdgcn_rcpf(1.0f + __expf(-z)); }
__device__ __forceinline__ float wave_sum(float v) {
#pragma unroll
    for (int o = 1; o < 64; o <<= 1) v += __shfl_xor(v, o);
    return v;
}
#define LDS_WAIT() asm volatile("s_waitcnt lgkmcnt(0)" ::: "memory")
#define VM_WAIT() asm volatile("s_waitcnt vmcnt(0)" ::: "memory")
namespace pg8 {
#define PG8_LAS __attribute__((address_space(3)))
typedef unsigned short bf16_t;
typedef short bf16x8 __attribute__((ext_vector_type(8)));
typedef float f32x4 __attribute__((ext_vector_type(4)));
typedef unsigned u32x4 __attribute__((ext_vector_type(4)));
constexpr int BM = 256, BK = 64, HALF = 128, HTB = HALF * BK * 2  , STAGE_BYTES = 8 * HTB, NXCD = 8, WGM = 8;

__host__ __device__ __forceinline__ int lds_byte(int r, int c) { const int st = (r >> 4) * 2 + (c >> 5), rr = r & 15, cc = c & 31, ob = rr * 64 + cc * 2; return st * 1024 + (ob ^ (((ob >> 9) & 1) << 5)); }
__host__ __device__ __forceinline__ void stage_rc(int b, int& R, int& C) { const int st = b / 1024, sb = b % 1024, swz = sb ^ (((sb >> 9) & 1) << 5); R = (st >> 1) * 16 + swz / 64; C = (st & 1) * 32 + (swz % 64) / 2; }
__host__ __device__ __forceinline__ int perm32(int rho) { const int n = rho >> 4, i = rho & 15; return 8 * (i >> 2) + 4 * n + (i & 3); }

struct Unit { int pm, pn; };
struct Gemm { const bf16_t* A; const bf16_t* Bt; int M, N, K; };

struct StaticOrder {
    int nM, nN, nwg, G, c;
    __host__ __device__ void init(int M, int N, int G_, int c_) { nM = M / BM; nN = N / BM; nwg = nM * nN; G = G_; c = c_; }
    __host__ __device__ bool next(int i, Unit& u) const {
        const long L = (long)i * G + c; if (L >= nwg) return false;
        int wgid = (int)L; { const int q = nwg / NXCD, r = nwg % NXCD, xcd = wgid % NXCD, off = wgid / NXCD; wgid = (xcd < r ? xcd * (q + 1) : r * (q + 1) + (xcd - r) * q) + off; }
        const int nig = WGM * nN, gid = wgid / nig, fm = gid * WGM, gsz = (nM - fm) < WGM ? (nM - fm) : WGM;
        u.pm = fm + ((wgid % nig) % gsz); u.pn = (wgid % nig) / gsz; return true;
    }
    __device__ __forceinline__ void a_ready(const Unit&) const {}
    __device__ __forceinline__ void done(const Unit&) const {}
};


struct OneUnit {
    Unit u;
    __device__ __forceinline__ bool next(int i, Unit& o) const { if (i != 0) return false; o = u; return true; }
    __device__ __forceinline__ void a_ready(const Unit&) const {}
    __device__ __forceinline__ void done(const Unit&) const {}
};
#define EPI_ROW0(expr) int row0 = (expr); asm volatile("" : "+v"(row0))

struct EpiInProj {
    static constexpr bool PERM = true, AFTER_DRAIN = false, HAS_MID = false;
    bf16_t* P; bf16_t* GT; float* outk; float* outv; const float* rope;
    template <int ACT> __device__ __forceinline__ void act_store(const f32x4 (&acc)[2][2][4][2], bf16_t* base) const {
#pragma unroll
        for (int ai = 0; ai < 2; ++ai)
#pragma unroll
            for (int m = 0; m < 4; ++m)
#pragma unroll
                for (int bj = 0; bj < 2; ++bj) {
                    f32x4 v0 = acc[ai][bj][m][0], v1 = acc[ai][bj][m][1];
#pragma unroll
                    for (int e = 0; e < 4; ++e) {
                        if (ACT == 1) { v0[e] = siluf_(v0[e]); v1[e] = siluf_(v1[e]); }
                        if (ACT == 2) { v0[e] = geluf_(v0[e]); v1[e] = geluf_(v1[e]); }
                        if (ACT == 3) { v0[e] = sigmoidf_(fminf(fmaxf(v0[e], -30.f), 30.f)); v1[e] = sigmoidf_(fminf(fmaxf(v1[e], -30.f), 30.f)); }
                    }
                    u32x4 w; w.x = pk2(v0[0], v0[1]); w.y = pk2(v0[2], v0[3]); w.z = pk2(v1[0], v1[1]); w.w = pk2(v1[2], v1[3]);
                    *(u32x4*)(base + (size_t)(ai * HALF + m * 16) * PP + bj * HALF) = w;
                }
    }
    __device__ __forceinline__ void gate_store(const f32x4 (&acc)[2][2][4][2], bf16_t* gt) const {
#pragma unroll
        for (int ai = 0; ai < 2; ++ai)
#pragma unroll
            for (int m = 0; m < 4; ++m)
#pragma unroll
                for (int bj = 0; bj < 2; ++bj) {
                    f32x4 v0 = acc[ai][bj][m][0], v1 = acc[ai][bj][m][1];
#pragma unroll
                    for (int e = 0; e < 4; ++e) { v0[e] = sigmoidf_(fminf(fmaxf(v0[e], -30.f), 30.f)); v1[e] = sigmoidf_(fminf(fmaxf(v1[e], -30.f), 30.f)); }
                    u32x4 w; w.x = pk2(v0[0], v0[1]); w.y = pk2(v0[2], v0[3]); w.z = pk2(v1[0], v1[1]); w.w = pk2(v1[2], v1[3]);
                    *(u32x4*)(gt + (ai * 8 + m * 2 + bj) * 512) = w;
                }
    }
    template <bool ROPE, bool KOUT> __device__ __forceinline__ void qk_store(const f32x4 (&acc)[2][2][4][2], bf16_t* base, int row0, int wc, int fq, float sc) const {
        const int p0 = wc * 16 + 4 * fq;
        const int j0 = (wc < 2) ? p0 : p0 - 32;
        const int dbase = (wc < 2) ? p0 : p0 + 32;
        f32x4 cs[8][2];
        if (ROPE) {
#pragma unroll
            for (int ai = 0; ai < 2; ++ai)
#pragma unroll
                for (int m = 0; m < 4; ++m) { const int t = (row0 + ai * HALF + m * 16 - MCTX) & 4095; const int pos = (wc < 2) ? (t >> 6) : (t & 63);
                    const float* rp = rope + (size_t)(pos * 32 + j0) * 2; cs[ai * 4 + m][0] = *(const f32x4*)rp; cs[ai * 4 + m][1] = *(const f32x4*)(rp + 4); }
        }
#pragma unroll
        for (int ai = 0; ai < 2; ++ai)
#pragma unroll
            for (int m = 0; m < 4; ++m)
#pragma unroll
                for (int bj = 0; bj < 2; ++bj) {
                    f32x4 v0 = acc[ai][bj][m][0], v1 = acc[ai][bj][m][1];
                    if (KOUT) { const int row = row0 + ai * HALF + m * 16; const int b = row >> 8, t = row & 255;
                        float* o = outk + (size_t)b * (2 * 256 * 256) + t * 256 + bj * 128 + dbase;
                        *(f32x4*)o = (f32x4){v0[0], v0[2], v1[0], v1[2]}; *(f32x4*)(o + 32) = (f32x4){v0[1], v0[3], v1[1], v1[3]}; }
                    if (ROPE) { const f32x4 c0 = cs[ai * 4 + m][0], c1 = cs[ai * 4 + m][1]; f32x4 w0, w1;
                        w0[0] = v0[0] * c0[0] - v0[1] * c0[1]; w0[1] = v0[0] * c0[1] + v0[1] * c0[0]; w0[2] = v0[2] * c0[2] - v0[3] * c0[3]; w0[3] = v0[2] * c0[3] + v0[3] * c0[2];
                        w1[0] = v1[0] * c1[0] - v1[1] * c1[1]; w1[1] = v1[0] * c1[1] + v1[1] * c1[0]; w1[2] = v1[2] * c1[2] - v1[3] * c1[3]; w1[3] = v1[2] * c1[3] + v1[3] * c1[2];
                        v0 = w0; v1 = w1; }
                    v0 = v0 * sc; v1 = v1 * sc;
                    u32x4 w; w.x = pk2(v0[0], v0[1]); w.y = pk2(v0[2], v0[3]); w.z = pk2(v1[0], v1[1]); w.w = pk2(v1[2], v1[3]);
                    *(u32x4*)(base + (size_t)(ai * HALF + m * 16) * PP + bj * HALF) = w;
                }
    }
    __device__ __forceinline__ void operator()(const f32x4 (&acc)[2][2][4][2], const Unit& u, int wr, int wc, int fr, int fq) const {
        const int pn = u.pn;
        int kind;
        if (pn < 2) kind = 0; else if (pn < 4) kind = 1; else if (pn < 8) kind = 4; else if (pn == 8) kind = 5; else if (pn == 9) kind = 6;
        else if (pn < 14) kind = 1; else if (pn < 18) kind = 2; else if (pn < 20) kind = 1; else kind = 3;
        const bool lat = u.pm >= 32;
        EPI_ROW0(u.pm * BM + wr * 64 + fr);
        const int colL = wc * 32 + 8 * fq;
        bf16_t* base = P + (size_t)row0 * PP + pn * BM + colL;
        if (kind == 3) { const int s = (pn - 20) >> 3, pe = (pn - 20) & 7; gate_store(acc, GT + ((size_t)(((s * 64 + u.pm) * 8 + pe) * 8 + wr * 4 + wc) * 16) * 512 + (fq * 16 + fr) * 8); }
        else if (kind == 1) act_store<1>(acc, base);
        else if (kind == 2) act_store<2>(acc, base);
        else if (kind == 0) act_store<0>(acc, base);
        else if (kind == 4) { if (lat) qk_store<true, false>(acc, base, row0, wc, fq, QSCALE); else qk_store<false, false>(acc, base, row0, wc, fq, QSCALE); }
        else if (kind == 5) { if (lat) qk_store<true, false>(acc, base, row0, wc, fq, 1.0f); else qk_store<false, true>(acc, base, row0, wc, fq, 1.0f); }
        else {
            act_store<0>(acc, base);
            if (!lat) {
#pragma unroll
                for (int ai = 0; ai < 2; ++ai)
#pragma unroll
                    for (int m = 0; m < 4; ++m)
#pragma unroll
                        for (int bj = 0; bj < 2; ++bj) { const int row = row0 + ai * HALF + m * 16; const int b = row >> 8, t = row & 255;
                            float* o = outv + (size_t)b * (2 * 256 * 256) + t * 256 + bj * 128 + colL; *(f32x4*)o = acc[ai][bj][m][0]; *(f32x4*)(o + 4) = acc[ai][bj][m][1]; }
            }
        }
    }
};

struct EpiGlu {
    static constexpr bool PERM = true, AFTER_DRAIN = false, HAS_MID = false;
    const bf16_t* YG; const bf16_t* P; bf16_t* YC; const float* bias;
    __device__ __forceinline__ void operator()(const f32x4 (&acc)[2][2][4][2], const Unit& u, int wr, int wc, int fr, int fq) const {
        EPI_ROW0(u.pm * BM + wr * 64 + fr);
        const int col0 = u.pn * BM + wc * 32 + 8 * fq;
#pragma unroll
        for (int bj = 0; bj < 2; ++bj) {
            const int col = col0 + bj * HALF;
            const f32x4 b0 = *(const f32x4*)(bias + col), b1 = *(const f32x4*)(bias + col + 4);
            u32x4 yg[8], za[8];
#pragma unroll
            for (int i = 0; i < 8; ++i) { const size_t row = (size_t)(row0 + (i >> 2) * HALF + (i & 3) * 16); yg[i] = *(const u32x4*)(YG + row * 512 + col); za[i] = *(const u32x4*)(P + row * PP + C_ZA + col); }
#pragma unroll
            for (int i = 0; i < 8; ++i) { const int ai = i >> 2, m = i & 3; const size_t row = (size_t)(row0 + ai * HALF + m * 16);
                const f32x4 v0 = acc[ai][bj][m][0] + b0, v1 = acc[ai][bj][m][1] + b1;
                u32x4 w;
                w.x = pk2(bflo(yg[i].x) * sigmoidf_(v0[0]) * bflo(za[i].x), bfhi(yg[i].x) * sigmoidf_(v0[1]) * bfhi(za[i].x));
                w.y = pk2(bflo(yg[i].y) * sigmoidf_(v0[2]) * bflo(za[i].y), bfhi(yg[i].y) * sigmoidf_(v0[3]) * bfhi(za[i].y));
                w.z = pk2(bflo(yg[i].z) * sigmoidf_(v1[0]) * bflo(za[i].z), bfhi(yg[i].z) * sigmoidf_(v1[1]) * bfhi(za[i].z));
                w.w = pk2(bflo(yg[i].w) * sigmoidf_(v1[2]) * bflo(za[i].w), bfhi(yg[i].w) * sigmoidf_(v1[3]) * bfhi(za[i].w));
                *(u32x4*)(YC + row * DM + col) = w; }
        }
    }
};

struct EpiMerge {
    static constexpr bool PERM = true, AFTER_DRAIN = false, HAS_MID = true;
    const bf16_t* GT; bf16_t* O;
    __device__ __forceinline__ bool is_mid(int t) const { return t == 8 || t == 24; }
    __device__ __forceinline__ void mid(f32x4 (&acc)[2][2][4][2], const Unit& u, int wr, int wc, int fr, int fq, int t) const {
        const int s = (t == 8) ? 0 : 1;
        int lo_ = (fq * 16 + fr) * 8; asm volatile("" : "+v"(lo_));
        const bf16_t* gbase = GT + ((size_t)(((s * 64 + u.pm) * 8 + u.pn) * 8 + wr * 4 + wc) * 16) * 512 + lo_;
        constexpr size_t SSTR = (size_t)64 * 8 * 8 * 16 * 512;
#pragma unroll
        for (int ai = 0; ai < 2; ++ai) {
            u32x4 gn[8], gd[8];
#pragma unroll
            for (int i = 0; i < 8; ++i) { const bf16_t* gp = gbase + (ai * 8 + i) * 512; gn[i] = *(const u32x4*)gp; gd[i] = *(const u32x4*)(gp + SSTR); }
#pragma unroll
            for (int i = 0; i < 8; ++i) { const int m = i >> 1, bj = i & 1; f32x4 r0, r1;
                r0[0] = bflo(gn[i].x) * __builtin_amdgcn_rcpf(bflo(gd[i].x)); r0[1] = bfhi(gn[i].x) * __builtin_amdgcn_rcpf(bfhi(gd[i].x)); r0[2] = bflo(gn[i].y) * __builtin_amdgcn_rcpf(bflo(gd[i].y)); r0[3] = bfhi(gn[i].y) * __builtin_amdgcn_rcpf(bfhi(gd[i].y));
                r1[0] = bflo(gn[i].z) * __builtin_amdgcn_rcpf(bflo(gd[i].z)); r1[1] = bfhi(gn[i].z) * __builtin_amdgcn_rcpf(bfhi(gd[i].z)); r1[2] = bflo(gn[i].w) * __builtin_amdgcn_rcpf(bflo(gd[i].w)); r1[3] = bfhi(gn[i].w) * __builtin_amdgcn_rcpf(bfhi(gd[i].w));
                acc[ai][bj][m][0] *= r0; acc[ai][bj][m][1] *= r1; }
            asm volatile("" ::: "memory");
        }
    }
    __device__ __forceinline__ void operator()(const f32x4 (&acc)[2][2][4][2], const Unit& u, int wr, int wc, int fr, int fq) const {
        EPI_ROW0(u.pm * BM + wr * 64 + fr);
        const int col0 = u.pn * BM + wc * 32 + 8 * fq;
        const bf16_t* gbase = GT + ((size_t)(((2 * 64 + u.pm) * 8 + u.pn) * 8 + wr * 4 + wc) * 16) * 512 + (fq * 16 + fr) * 8;
        bf16_t* obase = O + (size_t)row0 * DM + col0;
#pragma unroll
        for (int ai = 0; ai < 2; ++ai) {
            u32x4 g[8];
#pragma unroll
            for (int i = 0; i < 8; ++i) g[i] = *(const u32x4*)(gbase + (ai * 8 + i) * 512);
#pragma unroll
            for (int i = 0; i < 8; ++i) { const int m = i >> 1, bj = i & 1;
                const f32x4 v0 = acc[ai][bj][m][0], v1 = acc[ai][bj][m][1];
                u32x4 w;
                w.x = pk2(v0[0] * bflo(g[i].x), v0[1] * bfhi(g[i].x)); w.y = pk2(v0[2] * bflo(g[i].y), v0[3] * bfhi(g[i].y));
                w.z = pk2(v1[0] * bflo(g[i].z), v1[1] * bfhi(g[i].z)); w.w = pk2(v1[2] * bflo(g[i].w), v1[3] * bfhi(g[i].w));
                *(u32x4*)(obase + (size_t)(ai * HALF + m * 16) * DM + bj * HALF) = w; }
        }
    }
};

struct EpiOut {
    static constexpr bool PERM = false, AFTER_DRAIN = false, HAS_MID = false;
    const float* xa; const float* xb;
    float* out; const float* gate;
    __device__ __forceinline__ void operator()(const f32x4 (&acc)[2][2][4][2], const Unit& u, int wr, int wc, int fr, int fq) const {
        EPI_ROW0(u.pm * BM + wr * 64 + fr);
        const int col0 = u.pn * BM + wc * 32 + 4 * fq;
        const int cv = (u.pm < 32) ? 0 : ((u.pm < 48) ? 1 : 2);
        const float* gp = gate + (size_t)cv * 6144 + 4096 + col0;
        const float* xbase = ((u.pm < 32) ? (xa + (size_t)row0 * DM) : (xb + (size_t)(row0 - MCTX) * DM)) + col0;
        float* obase = out + (size_t)row0 * DM + col0;
#pragma unroll
        for (int bj = 0; bj < 2; ++bj) {
            const f32x4 g0 = *(const f32x4*)(gp + bj * HALF), g1 = *(const f32x4*)(gp + bj * HALF + 16);
            f32x4 x[16];
#pragma unroll
            for (int i = 0; i < 16; ++i) x[i] = *(const f32x4*)(xbase + (size_t)((i >> 3) * HALF + ((i >> 1) & 3) * 16) * DM + bj * HALF + (i & 1) * 16);
#pragma unroll
            for (int i = 0; i < 16; ++i) { const int ai = i >> 3, m = (i >> 1) & 3, n = i & 1;
                const f32x4 o = x[i] * DN_ALPHA + ((n == 0) ? g0 : g1) * acc[ai][bj][m][n];
                *(f32x4*)(obase + (size_t)(ai * HALF + m * 16) * DM + bj * HALF + n * 16) = o; }
        }
    }
};

struct EpiNull {
    static constexpr bool PERM = true, AFTER_DRAIN = false, HAS_MID = false;
    float* sink;
    __device__ __forceinline__ void operator()(const f32x4 (&acc)[2][2][4][2], const Unit& u, int wr, int wc, int fr, int fq) const {
        float s = 0.f;
#pragma unroll
        for (int ai = 0; ai < 2; ++ai)
#pragma unroll
            for (int bj = 0; bj < 2; ++bj)
#pragma unroll
                for (int m = 0; m < 4; ++m)
#pragma unroll
                    for (int n = 0; n < 2; ++n) s += (acc[ai][bj][m][n][0] + acc[ai][bj][m][n][1]) + (acc[ai][bj][m][n][2] + acc[ai][bj][m][n][3]);
        if (s == 123456.789f) sink[u.pm * 64 + fr] = s;
    }
};
template <class Epi, class Sched, bool ALIGN_EPI = false, bool SP2 = false>
__device__ __forceinline__ void gemm_phase(PG8_LAS unsigned char* lds, const Gemm g, const Sched& S, const Epi& E, int tid_in) {
    int tid_ = tid_in; asm volatile("" : "+v"(tid_));
    const int tid = tid_, wid = __builtin_amdgcn_readfirstlane(tid >> 6), lane = tid & 63, wr = wid >> 2, wc = wid & 3, fr = lane & 15, fq = lane >> 4;
    const int K = g.K, nt = K / BK;
    unsigned voffA[2], voffB[2];
#pragma unroll
    for (int i = 0; i < 2; ++i) { int R, C; stage_rc(tid * 16 + i * 8192, R, C); const int Rb = Epi::PERM ? ((R & ~31) + perm32(R & 31)) : R;
        voffA[i] = (unsigned)(R * K + C) * 2u; voffB[i] = (unsigned)(Rb * K + C) * 2u; }
    const size_t kstep = (size_t)(BK * 2);
    const size_t hstep = (size_t)HALF * K * 2;
    const size_t tstep = 2 * hstep;
    const unsigned ldsw = (unsigned)wid * 1024u;
    const int aoff = lds_byte(wr * 64 + fr, fq * 8), boff = lds_byte(wc * 32 + fr, fq * 8);
#define PG8_SA(b, h) (((b) * 2 + (h)) * HTB)
#define PG8_SB(b, h) ((4 + (b) * 2 + (h)) * HTB)
#define PG8_STAGE(bufoff, gbase, voff) do { _Pragma("unroll") for (int _i = 0; _i < 2; ++_i) \
        __builtin_amdgcn_global_load_lds((const unsigned*)((const char*)(gbase) + (voff)[_i]), (PG8_LAS unsigned*)(lds + (bufoff) + ldsw + _i * 8192), 16, 0, 0); } while (0)
#define PG8_LDA(dst, b, h) do { _Pragma("unroll") for (int m = 0; m < 4; ++m) _Pragma("unroll") for (int k = 0; k < 2; ++k) dst[m][k] = *(const PG8_LAS bf16x8*)(lds + PG8_SA(b, h) + aoff + m * 2048 + k * 1024); } while (0)
#define PG8_LDB(dst, b, h) do { _Pragma("unroll") for (int n = 0; n < 2; ++n) _Pragma("unroll") for (int k = 0; k < 2; ++k) dst[n][k] = *(const PG8_LAS bf16x8*)(lds + PG8_SB(b, h) + boff + n * 2048 + k * 1024); } while (0)
#define PG8_MMA(ai, bj, At, Bt) do { __builtin_amdgcn_s_setprio(1); _Pragma("unroll") for (int m = 0; m < 4; ++m) _Pragma("unroll") for (int n = 0; n < 2; ++n) _Pragma("unroll") for (int k = 0; k < 2; ++k) \
        acc[ai][bj][m][n] = __builtin_amdgcn_mfma_f32_16x16x32_bf16(Bt[n][k], At[m][k], acc[ai][bj][m][n], 0, 0, 0); __builtin_amdgcn_s_setprio(0); } while (0)
#define PG8_WAIT_V(n) asm volatile("s_waitcnt vmcnt(" #n ")" ::: "memory")
#define PG8_WAIT_L(n) asm volatile("s_waitcnt lgkmcnt(" #n ")" ::: "memory")
#define PG8_BAR __builtin_amdgcn_s_barrier()
#define PG8_SCHED __builtin_amdgcn_sched_barrier(0)
    Unit cur, nxt; int ui = 0;
    if (!S.next(0, cur)) return;
    f32x4 acc[2][2][4][2];
#pragma unroll
    for (int a = 0; a < 2; ++a)
#pragma unroll
        for (int b = 0; b < 2; ++b)
#pragma unroll
            for (int m = 0; m < 4; ++m)
#pragma unroll
                for (int n = 0; n < 2; ++n) acc[a][b][m][n] = (f32x4){0.f, 0.f, 0.f, 0.f};
    bf16x8 At[4][2], B0[2][2], B1[2][2];
    const char* cA = (const char*)g.A + (size_t)cur.pm * tstep; const char* cB = (const char*)g.Bt + (size_t)cur.pn * tstep;
    S.a_ready(cur);
    if constexpr (SP2) {
        PG8_STAGE(PG8_SB(0, 0), cB, voffB); PG8_STAGE(PG8_SB(0, 1), cB + hstep, voffB); PG8_STAGE(PG8_SA(0, 0), cA, voffA); PG8_STAGE(PG8_SA(0, 1), cA + hstep, voffA);
        if (wr == 1) PG8_BAR;
        PG8_WAIT_V(2); PG8_BAR;
        PG8_STAGE(PG8_SB(1, 0), cB + kstep, voffB); PG8_STAGE(PG8_SA(1, 0), cA + kstep, voffA); PG8_STAGE(PG8_SB(1, 1), cB + hstep + kstep, voffB);
        PG8_WAIT_V(6); PG8_BAR;
    } else {
        PG8_STAGE(PG8_SB(0, 0), cB, voffB); PG8_STAGE(PG8_SA(0, 0), cA, voffA); PG8_STAGE(PG8_SB(0, 1), cB + hstep, voffB); PG8_STAGE(PG8_SA(0, 1), cA + hstep, voffA);
        if (wr == 1) PG8_BAR;
        PG8_WAIT_V(4); PG8_BAR;
        PG8_STAGE(PG8_SB(1, 0), cB + kstep, voffB); PG8_STAGE(PG8_SA(1, 0), cA + kstep, voffA); PG8_STAGE(PG8_SB(1, 1), cB + hstep + kstep, voffB);
        PG8_WAIT_V(6); PG8_BAR;
    }
    for (;;) {
        const bool has_next = S.next(ui + 1, nxt);
        const char* nA = has_next ? (const char*)g.A + (size_t)nxt.pm * tstep : cA; const char* nB = has_next ? (const char*)g.Bt + (size_t)nxt.pn * tstep : cB;
        for (int t = 0; t < nt; t += 2) {
            if constexpr (Epi::HAS_MID) { if (E.is_mid(t)) E.mid(acc, cur, wr, wc, fr, fq, t); }
            const bool last = (t == nt - 2);
            const char* a1 = cA + (size_t)(t + 1) * kstep;
            const char* a2 = last ? nA : cA + (size_t)(t + 2) * kstep; const char* b2 = last ? nB : cB + (size_t)(t + 2) * kstep;
            const char* a3 = a2 + kstep; const char* b3 = b2 + kstep;
            if (last && has_next) S.a_ready(nxt);
            if constexpr (SP2) {
            PG8_LDB(B0, 0, 0); PG8_LDB(B1, 0, 1); PG8_SCHED; PG8_LDA(At, 0, 0); PG8_STAGE(PG8_SA(1, 1), a1 + hstep, voffA);
            PG8_WAIT_V(8); PG8_WAIT_L(0); PG8_BAR; PG8_MMA(0, 0, At, B0); PG8_MMA(0, 1, At, B1); PG8_BAR; PG8_SCHED;
            PG8_LDA(At, 0, 1); PG8_STAGE(PG8_SB(0, 0), b2, voffB); PG8_STAGE(PG8_SB(0, 1), b2 + hstep, voffB); PG8_STAGE(PG8_SA(0, 0), a2, voffA);
            PG8_WAIT_V(8); PG8_WAIT_L(0); PG8_BAR; PG8_MMA(1, 0, At, B0); PG8_MMA(1, 1, At, B1); PG8_BAR; PG8_SCHED;
            PG8_LDB(B0, 1, 0); PG8_LDB(B1, 1, 1); PG8_SCHED; PG8_LDA(At, 1, 0); PG8_STAGE(PG8_SA(0, 1), a2 + hstep, voffA);
            PG8_WAIT_V(8); PG8_WAIT_L(0); PG8_BAR; PG8_MMA(0, 0, At, B0); PG8_MMA(0, 1, At, B1); PG8_BAR; PG8_SCHED;
            PG8_LDA(At, 1, 1); PG8_STAGE(PG8_SB(1, 0), b3, voffB); PG8_STAGE(PG8_SB(1, 1), b3 + hstep, voffB); PG8_STAGE(PG8_SA(1, 0), a3, voffA);
            PG8_WAIT_V(8); PG8_WAIT_L(0); PG8_BAR; PG8_MMA(1, 0, At, B0); PG8_MMA(1, 1, At, B1); PG8_BAR; PG8_SCHED;
            } else {
            PG8_LDB(B0, 0, 0); PG8_SCHED; PG8_LDA(At, 0, 0); PG8_STAGE(PG8_SA(1, 1), a1 + hstep, voffA);
            PG8_WAIT_L(8); PG8_BAR; PG8_WAIT_L(0); PG8_MMA(0, 0, At, B0); PG8_BAR; PG8_SCHED;
            PG8_LDB(B1, 0, 1); PG8_STAGE(PG8_SB(0, 0), b2, voffB);
            PG8_BAR; PG8_WAIT_L(0); PG8_MMA(0, 1, At, B1); PG8_BAR;
            PG8_LDA(At, 0, 1); PG8_STAGE(PG8_SA(0, 0), a2, voffA);
            PG8_BAR; PG8_WAIT_L(0); PG8_MMA(1, 0, At, B0); PG8_BAR; PG8_SCHED;
            PG8_STAGE(PG8_SB(0, 1), b2 + hstep, voffB);
            PG8_WAIT_V(6); PG8_BAR; PG8_MMA(1, 1, At, B1); PG8_BAR;
            PG8_LDB(B0, 1, 0); PG8_SCHED; PG8_LDA(At, 1, 0); PG8_STAGE(PG8_SA(0, 1), a2 + hstep, voffA);
            PG8_WAIT_L(8); PG8_BAR; PG8_WAIT_L(0); PG8_MMA(0, 0, At, B0); PG8_BAR; PG8_SCHED;
            PG8_LDB(B1, 1, 1); PG8_STAGE(PG8_SB(1, 0), b3, voffB);
            PG8_BAR; PG8_WAIT_L(0); PG8_MMA(0, 1, At, B1); PG8_BAR;
            PG8_LDA(At, 1, 1); PG8_STAGE(PG8_SA(1, 0), a3, voffA);
            PG8_BAR; PG8_WAIT_L(0); PG8_MMA(1, 0, At, B0); PG8_BAR; PG8_SCHED;
            PG8_STAGE(PG8_SB(1, 1), b3 + hstep, voffB);
            PG8_WAIT_V(6); PG8_BAR; PG8_MMA(1, 1, At, B1); PG8_BAR;
            }
        }
        if constexpr (ALIGN_EPI) { if (wr == 0) PG8_BAR; }
        if constexpr (!Epi::AFTER_DRAIN) { E(acc, cur, wr, wc, fr, fq); S.done(cur); }
        if (!has_next) break;
#pragma unroll
        for (int a = 0; a < 2; ++a)
#pragma unroll
            for (int b = 0; b < 2; ++b)
#pragma unroll
                for (int m = 0; m < 4; ++m)
#pragma unroll
                    for (int n = 0; n < 2; ++n) acc[a][b][m][n] = (f32x4){0.f, 0.f, 0.f, 0.f};
        cur = nxt; cA = nA; cB = nB; ++ui;
        if constexpr (ALIGN_EPI) { if (wr == 1) PG8_BAR; }
    }
    PG8_WAIT_V(0);
    if constexpr (!ALIGN_EPI) { if (wr == 0) PG8_BAR; }
    PG8_BAR;
    if constexpr (Epi::AFTER_DRAIN) { E.fused(acc, cur, wr, wc, fr, fq, lds, wid, lane); S.done(cur); }
#undef PG8_SA
#undef PG8_SB
#undef PG8_STAGE
#undef PG8_LDA
#undef PG8_LDB
#undef PG8_MMA
#undef PG8_WAIT_V
#undef PG8_WAIT_L
#undef PG8_BAR
#undef PG8_SCHED
}
}
#define XB_TMO      128
#define XB_XCNT(j)  (256  + 64 * (j))
#define XB_XSUB(j)  (1280 + 64 * (j))
#define XB_XGEN(j)  (2304 + 64 * (j))
#define XB_TOP      3328
#define XB_TOPGEN   3392
#define XCD_BAR_WORDS 3456
#define XB_SPIN_CAP (1u << 18)

__device__ __forceinline__ unsigned xb_ld(unsigned* p)              { return __hip_atomic_load(p, __ATOMIC_RELAXED, __HIP_MEMORY_SCOPE_AGENT); }
__device__ __forceinline__ unsigned xb_add(unsigned* p, unsigned v) { return __hip_atomic_fetch_add(p, v, __ATOMIC_RELAXED, __HIP_MEMORY_SCOPE_AGENT); }
__device__ __forceinline__ unsigned xb_xcc_id() { return (unsigned)__builtin_amdgcn_s_getreg((3 << 11) | 20) & 0xFu; }
#define XB_SPIN(cond, bar) do { unsigned _sp = 0; while (cond) { __builtin_amdgcn_s_sleep(1); \
    if ((++_sp & 255u) == 0u) { if (xb_ld(&(bar)[XB_TMO])) break; if (_sp > XB_SPIN_CAP) { atomicAdd(&(bar)[XB_TMO], 1u); break; } } } } while (0)

struct XcdBarrier {
    unsigned* bar; unsigned x;
    volatile LAS unsigned* st;
};

__device__ __forceinline__ XcdBarrier xcd_barrier_post(unsigned* bar, volatile LAS unsigned* st) {
    XcdBarrier b; b.bar = bar; b.x = xb_xcc_id(); b.st = st;
    if (threadIdx.x == 0) (void)xb_add(&bar[XB_XCNT(b.x)], 1u);
    return b;
}
__device__ __forceinline__ void xcd_barrier_complete(unsigned* bar, unsigned x, unsigned& nloc, unsigned& nx) {
    const unsigned G = gridDim.x * gridDim.y * gridDim.z;
    unsigned sum, cnt, mine, sp = 0u;
    for (;;) {
        sum = 0u; cnt = 0u; mine = 0u;
#pragma unroll
        for (unsigned j = 0; j < 16; ++j) { const unsigned c = xb_ld(&bar[XB_XCNT(j)]); sum += c; cnt += (c > 0u) ? 1u : 0u; mine = (j == x) ? c : mine; }
        if (sum == G) break;
        __builtin_amdgcn_s_sleep(1);
        if ((++sp & 255u) == 0u) { if (xb_ld(&bar[XB_TMO])) break; if (sp > XB_SPIN_CAP) { atomicAdd(&bar[XB_TMO], 1u); break; } }
    }
    nloc = mine > 0u ? mine : 1u; nx = cnt > 0u ? cnt : 1u;
}

__device__ __forceinline__ void xcd_barrier(const XcdBarrier& b) {
    asm volatile("s_waitcnt vmcnt(0)" ::: "memory");
    __syncthreads();
    if (threadIdx.x == 0) {
        unsigned* bar = b.bar;
        __builtin_amdgcn_s_waitcnt(0);
        unsigned nloc = b.st[0], nx = b.st[1];
        if (nloc == 0u) { xcd_barrier_complete(bar, b.x, nloc, nx); b.st[0] = nloc; b.st[1] = nx; }
        const unsigned old = xb_add(&bar[XB_XSUB(b.x)], 1u);
        const unsigned gen = old / nloc;
        if (old + 1u == (gen + 1u) * nloc) {
            __builtin_amdgcn_fence(__ATOMIC_RELEASE, "agent");
            asm volatile("s_waitcnt vmcnt(0)" ::: "memory");
            const unsigned og = xb_add(&bar[XB_TOP], 1u);
            const unsigned tg = og / nx;
            if (og + 1u == (tg + 1u) * nx) xb_add(&bar[XB_TOPGEN], 1u);
            else XB_SPIN(xb_ld(&bar[XB_TOPGEN]) == tg, bar);
            __builtin_amdgcn_fence(__ATOMIC_ACQUIRE, "agent");
            xb_add(&bar[XB_XGEN(b.x)], 1u);
            asm volatile("s_waitcnt vmcnt(0)" ::: "memory");
        } else {
            XB_SPIN(xb_ld(&bar[XB_XGEN(b.x)]) == gen, bar);
            __builtin_amdgcn_fence(__ATOMIC_ACQUIRE, "agent");
            asm volatile("s_waitcnt vmcnt(0)" ::: "memory");
        }
    }
    __syncthreads();
}


typedef GAS unsigned gu32;
struct Args { const float* in[31]; float* out; unsigned char* ws; int ph_lo, ph_hi; };
typedef const __attribute__((address_space(4))) Args* KArgs;
struct Frame {
    LAS unsigned char* lds;
    volatile LAS unsigned* MISC;
    unsigned* ctl;
    int tid, lane, wave, G, bid;
    unsigned char* ws;
    float* out;
    KArgs ka;
    __device__ __forceinline__ const float* in(int k) const { return ka->in[k]; }
};
#define WSP(T, off) ((T*)(F.ws + (off)))

__device__ __forceinline__ int wq_next(Frame& F, int phase) {
    __syncthreads();
    if (F.tid == 0) F.MISC[16] = __hip_atomic_fetch_add(F.ctl + CW_WQ + 64 * phase, 1u, __ATOMIC_RELAXED, __HIP_MEMORY_SCOPE_AGENT);
    __syncthreads();
    return (int)F.MISC[16];
}

__device__ __forceinline__ void p0_gemv_tile(Frame& F, int idx) {
    const int l = idx / 768, rem = idx % 768, kc = rem / 24, nc = rem % 24, lane = F.lane;
    const int k = kc * 64 + lane;
    const float s0 = siluf_(F.in(6  )[k]), s1 = siluf_(F.in(5  )[k]), s2 = siluf_(F.in(5  )[2048 + k]);
    const float* W = F.in(7  ) + ((size_t)l * 2048 + kc * 64) * 6144 + nc * 256 + lane * 4;
    f32x4 a0 = {0.f, 0.f, 0.f, 0.f}, a1 = a0, a2 = a0;
#pragma unroll 16
    for (int r = 0; r < 64; ++r) {
        const f32x4 wv = *(const f32x4*)(W + (size_t)r * 6144);
        const float t0 = __shfl(s0, r), t1 = __shfl(s1, r), t2 = __shfl(s2, r);
        a0 += wv * t0; a1 += wv * t1; a2 += wv * t2;
    }
    float* o = WSP(float, WS_MODP) + ((size_t)(l * 32 + kc) * 3) * 6144 + nc * 256 + lane * 4;
    *(f32x4*)o = a0; *(f32x4*)(o + 6144) = a1; *(f32x4*)(o + 2 * 6144) = a2;
}
__device__ __forceinline__ int sigma_col(int n) {
    if (n < C_Q || n >= C_V) return n;
    const int hb = n & ~127, c = n & 127, p = c >> 1, e = c & 1;
    return hb + ((p < 32) ? p : p + 32) + 32 * e;
}
__device__ __forceinline__ void p0_transpose_item(const float* W, int N, bf16* WT, int Kd, int koff, bool perm, LAS float* scr, int item, int lane) {
    const int nblk = N / 32, kb = item / nblk, nb = item % nblk, k0 = 64 * kb, n0 = 32 * nb;
    const int ncol = perm ? sigma_col(n0 + (lane & 31)) : (n0 + (lane & 31));
    float tv[32];
#pragma unroll
    for (int i = 0; i < 32; ++i) { const int kk = 2 * i + (lane >> 5); tv[i] = W[(size_t)(k0 + kk) * N + ncol]; }
#pragma unroll
    for (int i = 0; i < 32; ++i) { const int kk = 2 * i + (lane >> 5); scr[kk * 33 + (lane & 31)] = tv[i]; }
    LDS_WAIT(); asm volatile("" ::: "memory");
    const int c = lane & 7;
#pragma unroll
    for (int j = 0; j < 4; ++j) { const int n = (lane >> 3) + 8 * j; const LAS float* s = scr + (8 * c) * 33 + n;
        u32x4 o; o.x = pk2(s[0 * 33], s[1 * 33]); o.y = pk2(s[2 * 33], s[3 * 33]); o.z = pk2(s[4 * 33], s[5 * 33]); o.w = pk2(s[6 * 33], s[7 * 33]);
        *(u32x4*)(WT + (size_t)(n0 + n) * Kd + koff + k0 + 8 * c) = o; }
    LDS_WAIT(); asm volatile("" ::: "memory");
}
__device__ __forceinline__ void p0_ssm_tables(Frame& F, int item4) {
    const int item = item4 >> 2, part = item4 & 3, l = item >> 5, g = item & 31, tid = F.tid;
    LAS float* apow = (LAS float*)F.lds;
    LAS float* Bb = apow + 2 * 33 * 64 * 2;
    LAS float* Cc = Bb + 2 * 64 * 16 * 2;
    __syncthreads();
    for (int idx = tid; idx < 2 * 33 * 64; idx += NT) {
        const int d = idx / (33 * 64), j = (idx / 64) % 33, p = idx & 63;
        const int pi = ((l * 2 + d) * 32 + g) * 64 + p;
        const double lr = (double)F.in(10  )[pi], li = (double)F.in(11  )[pi], dt = exp((double)F.in(12  )[(l * 2 + d) * 32 + g]);
        const double mag = exp(lr * dt * (double)j); double sn, cs; sincos(li * dt * (double)j, &sn, &cs);
        apow[idx * 2] = (float)(mag * cs); apow[idx * 2 + 1] = (float)(mag * sn);
        if (j == TCH && part == 0) { float* at = WSP(float, WS_AT) + (size_t)((l * 32 + g) * 2 + d) * 128; at[p] = (float)(mag * cs); at[64 + p] = (float)(mag * sn); }
    }
    for (int idx = tid; idx < 2 * 64 * 16; idx += NT) {
        const int d = idx / 1024, p = (idx >> 4) & 63, cc = idx & 15;
        const int pi = ((l * 2 + d) * 32 + g) * 64 + p;
        const double lr = (double)F.in(10  )[pi], li = (double)F.in(11  )[pi], dt = exp((double)F.in(12  )[(l * 2 + d) * 32 + g]);
        const double mag = exp(lr * dt); double sn, cs; sincos(li * dt, &sn, &cs);
        const double are = mag * cs, aim = mag * sn, nr = are - 1.0, den = lr * lr + li * li;
        const double fre = (nr * lr + aim * li) / den, fim = (aim * lr - nr * li) / den;
        const double br = (double)F.in(13  )[(size_t)pi * 16 + cc], bi = (double)F.in(14  )[(size_t)pi * 16 + cc];
        Bb[idx * 2] = (float)(fre * br - fim * bi); Bb[idx * 2 + 1] = (float)(fre * bi + fim * br);
        const int ci = (((l * 2 + d) * 32 + g) * 16 + cc) * 64 + p;
        const int co = (d * 16 + cc) * 64 + p;
        Cc[co * 2] = F.in(15  )[ci]; Cc[co * 2 + 1] = F.in(16  )[ci];
    }
    __syncthreads();
    bf16* lagt = WSP(bf16, WS_LAG) + (size_t)(l * 32 + g) * 16384;
    for (int idx = part * 4032 + tid; idx < (part + 1) * 4032; idx += NT) {
        const int L = idx >> 8, delta = L - 31, cc = (idx >> 4) & 15, c2 = idx & 15;
        float v = 0.f;
        if (delta >= 0) { const int j = delta;
            for (int p = 0; p < 64; ++p) { const float ar = apow[((0 * 33 + j) * 64 + p) * 2], ai = apow[((0 * 33 + j) * 64 + p) * 2 + 1];
                const float br = Bb[((0 * 64 + p) * 16 + c2) * 2], bi = Bb[((0 * 64 + p) * 16 + c2) * 2 + 1];
                const float zr = ar * br - ai * bi, zi = ar * bi + ai * br;
                v += Cc[((0 * 16 + cc) * 64 + p) * 2] * zr - Cc[((0 * 16 + cc) * 64 + p) * 2 + 1] * zi; } }
        if (delta <= 0) { const int j = -delta;
            for (int p = 0; p < 64; ++p) { const float ar = apow[((1 * 33 + j) * 64 + p) * 2], ai = apow[((1 * 33 + j) * 64 + p) * 2 + 1];
                const float br = Bb[((1 * 64 + p) * 16 + c2) * 2], bi = Bb[((1 * 64 + p) * 16 + c2) * 2 + 1];
                const float zr = ar * br - ai * bi, zi = ar * bi + ai * br;
                v += Cc[((1 * 16 + cc) * 64 + p) * 2] * zr - Cc[((1 * 16 + cc) * 64 + p) * 2 + 1] * zi; } }
        if (delta == 0 && cc == c2) v += F.in(17  )[l * 512 + g * 16 + cc];
        lagt[idx] = (bf16)f2bf(v);
    }
    bf16* wf = WSP(bf16, WS_WF) + (size_t)(l * 32 + g) * 131072;
    for (int idx = part * 32768 + tid; idx < (part + 1) * 32768; idx += NT) {
        const int row = idx >> 9, col = idx & 511, d = row >> 7, ri = (row >> 6) & 1, p = row & 63, j = col >> 4, c2 = col & 15;
        const int pw = (d == 0) ? (TCH - 1 - j) : j;
        const float ar = apow[((d * 33 + pw) * 64 + p) * 2], ai = apow[((d * 33 + pw) * 64 + p) * 2 + 1];
        const float br = Bb[((d * 64 + p) * 16 + c2) * 2], bi = Bb[((d * 64 + p) * 16 + c2) * 2 + 1];
        wf[idx] = (bf16)f2bf(ri ? (ar * bi + ai * br) : (ar * br - ai * bi));
    }
    bf16* wy = WSP(bf16, WS_WY) + (size_t)(l * 32 + g) * 131072;
    for (int idx = part * 32768 + tid; idx < (part + 1) * 32768; idx += NT) {
        const int row = idx >> 8, col = idx & 255, i = row >> 4, cc = row & 15, d = col >> 7, ri = (col >> 6) & 1, p = col & 63;
        const int pw = (d == 0) ? (i + 1) : (TCH - i);
        const float ar = apow[((d * 33 + pw) * 64 + p) * 2], ai = apow[((d * 33 + pw) * 64 + p) * 2 + 1];
        const float cr = Cc[((d * 16 + cc) * 64 + p) * 2], ci = Cc[((d * 16 + cc) * 64 + p) * 2 + 1];
        wy[idx] = (bf16)f2bf(ri ? -(cr * ai + ci * ar) : (cr * ar - ci * ai));
    }
    __syncthreads();
}
__device__ __forceinline__ void p0_prologue(Frame& F) {
    const int gw = F.bid * NW + F.wave, NGW = F.G * NW;
    for (int it = gw; it < 1536; it += NGW) p0_gemv_tile(F, it);
    for (int it = F.bid; it < 256; it += F.G) p0_ssm_tables(F, it);
    LAS float* scr = (LAS float*)(F.lds + F.wave * 16384);
    constexpr int I_IN = 32 * 352, I_PA = 8 * 64, I_PB = 16 * 64, I_PC = 8 * 64, I_OUT = 32 * 64, I_GLU = 8 * 16;
    constexpr int I_L = I_IN + I_PA + I_PB + I_PC + I_OUT + I_GLU;
    for (int it = gw; it < 2 * I_L; it += NGW) {
        const int l = it / I_L; int r = it % I_L;
        if (r < I_IN) { p0_transpose_item(F.in(9  ) + (size_t)l * 2048 * DIN, DIN, WSP(bf16, WS_WIN) + (size_t)l * DIN * 2048, 2048, 0, true, scr, r, F.lane); continue; } r -= I_IN;
        if (r < I_PA) { p0_transpose_item(F.in(25  ) + (size_t)l * 512 * 2048, 2048, WSP(bf16, WS_WP) + (size_t)l * 2048 * 2048, 2048, 0, false, scr, r, F.lane); continue; } r -= I_PA;
        if (r < I_PB) { p0_transpose_item(F.in(26  ) + (size_t)l * 1024 * 2048, 2048, WSP(bf16, WS_WP) + (size_t)l * 2048 * 2048, 2048, 512, false, scr, r, F.lane); continue; } r -= I_PB;
        if (r < I_PC) { p0_transpose_item(F.in(27  ) + (size_t)l * 512 * 2048, 2048, WSP(bf16, WS_WP) + (size_t)l * 2048 * 2048, 2048, 1536, false, scr, r, F.lane); continue; } r -= I_PC;
        if (r < I_OUT) { p0_transpose_item(F.in(28  ) + (size_t)l * 2048 * 2048, 2048, WSP(bf16, WS_WOUT) + (size_t)l * 2048 * 2048, 2048, 0, false, scr, r, F.lane); continue; } r -= I_OUT;
        p0_transpose_item(F.in(18  ) + (size_t)l * 512 * 512, 512, WSP(bf16, WS_WGLU) + (size_t)l * 512 * 512, 512, 0, false, scr, r, F.lane);
    }
    const int gt = F.bid * NT + F.tid, NGT = F.G * NT;
    for (int i = gt; i < 2 * 2 * 256 * 256; i += NGT) {
        const int col = i & 255, rowi = i >> 8;
        const int hb = col & 128, cc = col & 127, p = cc >> 1, e = cc & 1, src = hb + ((p < 32) ? p : p + 32) + 32 * e;
        WSP(bf16, WS_CK)[i] = (bf16)f2bf(F.in(2  )[(size_t)rowi * 256 + src]);
        WSP(bf16, WS_CV)[i] = (bf16)f2bf(F.in(3  )[i]);
    }
    for (int i = gt; i < 2 * 4 * 128 * 128; i += NGT) WSP(bf16, WS_WS)[i] = (bf16)f2bf(F.in(23  )[i]);
    for (int i = gt; i < 64 * 32; i += NGT) {
        const int pos = i >> 5, j = i & 31;
        const double inv = pow(10000.0, -(double)(2 * j) / 64.0); double sn, cs; sincos((double)pos * inv, &sn, &cs);
        WSP(float, WS_ROPE)[i * 2] = (float)cs; WSP(float, WS_ROPE)[i * 2 + 1] = (float)sn;
    }
}

__device__ __forceinline__ void ln_row(const float* xrow, f32x4 (&v)[8], int lane) {
    const f32x4* xr = (const f32x4*)xrow + lane; float s = 0.f;
#pragma unroll
    for (int j = 0; j < 8; ++j) { v[j] = xr[64 * j]; s += (v[j].x + v[j].y) + (v[j].z + v[j].w); }
    const float mean = wave_sum(s) * (1.f / DM); float s2 = 0.f;
#pragma unroll
    for (int j = 0; j < 8; ++j) { v[j] = v[j] - mean; s2 += (v[j].x * v[j].x + v[j].y * v[j].y) + (v[j].z * v[j].z + v[j].w * v[j].w); }
    const float rstd = 1.f / sqrtf(wave_sum(s2) * (1.f / DM) + LN_EPS);
#pragma unroll
    for (int j = 0; j < 8; ++j) v[j] = v[j] * rstd;
}
__device__ __forceinline__ void ln_renorm(f32x4 (&v)[8]) {
    float s = 0.f;
#pragma unroll
    for (int j = 0; j < 8; ++j) s += (v[j].x + v[j].y) + (v[j].z + v[j].w);
    const float mean = wave_sum(s) * (1.f / DM); float s2 = 0.f;
#pragma unroll
    for (int j = 0; j < 8; ++j) { v[j] = v[j] - mean; s2 += (v[j].x * v[j].x + v[j].y * v[j].y) + (v[j].z * v[j].z + v[j].w * v[j].w); }
    const float rstd = 1.f / sqrtf(wave_sum(s2) * (1.f / DM) + LN_EPS);
#pragma unroll
    for (int j = 0; j < 8; ++j) v[j] = v[j] * rstd;
}
__device__ __forceinline__ void store_h_row(bf16* hrow, const f32x4 (&v)[8], const LAS float* sc1p, const LAS float* sh, int lane) {
#pragma unroll
    for (int j = 0; j < 8; ++j) { const int c = lane * 4 + 256 * j;
        const f32x4 a = *(const LAS f32x4*)(sc1p + c), b = *(const LAS f32x4*)(sh + c);
        const f32x4 o = v[j] * a + b; u32x2 w; w.x = pk2(o.x, o.y); w.y = pk2(o.z, o.w);
        *(u32x2*)(hrow + c) = w; }
}
__device__ __forceinline__ void p1_lnmod(Frame& F) {
    const float* modp = WSP(float, WS_MODP); float* mod = WSP(float, WS_MOD);
    if (F.tid < 144) { const int idx = F.bid * 144 + F.tid; if (idx < 36864) { const int l = idx / 18432, r = idx % 18432, cv = r / 6144, n = r % 6144; float s = F.in(8  )[l * 6144 + n];
        for (int kc = 0; kc < 32; ++kc) s += modp[((size_t)(l * 32 + kc) * 3 + cv) * 6144 + n]; mod[idx] = s; } }
    const int row0 = F.bid * 64, cv = (row0 < MCTX) ? 0 : 1 + ((row0 - MCTX) >> 12);
    LAS float* sc1p = (LAS float*)F.lds; LAS float* sh = sc1p + 2048;
    for (int n = F.tid; n < 4096; n += NT) { float s = F.in(8  )[n];
        for (int kc = 0; kc < 32; ++kc) s += modp[((size_t)(0 * 32 + kc) * 3 + cv) * 6144 + n];
        if (n < 2048) sh[n] = s; else sc1p[n - 2048] = 1.0f + s; }
    __syncthreads();
    bf16* H = WSP(bf16, WS_H);
    for (int i = 0; i < 8; ++i) { const int row = row0 + F.wave * 8 + i;
        const float* xr = (row < MCTX) ? (F.in(0  ) + (size_t)row * DM) : (F.in(1  ) + (size_t)(row - MCTX) * DM);
        f32x4 v[8]; ln_row(xr, v, F.lane); store_h_row(H + (size_t)row * DM, v, sc1p, sh, F.lane); }
    __syncthreads();
}
__device__ __forceinline__ void pg_postln(Frame& F, int l) {
    const float* mod = WSP(float, WS_MOD);
    const int row0 = F.bid * 64, cv = (row0 < MCTX) ? 0 : 1 + ((row0 - MCTX) >> 12);
    LAS float* sc1p = (LAS float*)F.lds; LAS float* sh = sc1p + 2048; LAS float* lg = sh + 2048; LAS float* lb = lg + 2048;
    __syncthreads();
    for (int n = F.tid; n < 2048; n += NT) { lg[n] = F.in(29  )[l * 2048 + n]; lb[n] = F.in(30  )[l * 2048 + n];
        if (l == 0) { sh[n] = mod[(size_t)(1 * 3 + cv) * 6144 + n]; sc1p[n] = 1.0f + mod[(size_t)(1 * 3 + cv) * 6144 + 2048 + n]; } }
    __syncthreads();
    bf16* H = WSP(bf16, WS_H);
    for (int i = 0; i < 8; ++i) { const int row = row0 + F.wave * 8 + i;
        float* orow = F.out + (size_t)row * DM;
        f32x4 v[8]; ln_row(orow, v, F.lane);
#pragma unroll
        for (int j = 0; j < 8; ++j) { const int c = F.lane * 4 + 256 * j; v[j] = v[j] * *(const LAS f32x4*)(lg + c) + *(const LAS f32x4*)(lb + c); *(f32x4*)(orow + c) = v[j]; }
        if (l == 0) { ln_renorm(v); store_h_row(H + (size_t)row * DM, v, sc1p, sh, F.lane); } }
    __syncthreads();
}

__device__ __forceinline__ int crow(int r, int hi) { return (r & 3) + 8 * (r >> 2) + 4 * hi; }
constexpr int AK_PITCH = 272, AV_PITCH = 320, ATT_K_OFF = 0, ATT_V_OFF = 64 * AK_PITCH;
__device__ __forceinline__ s16x4 vtr(const LAS unsigned char* p) { typedef short v4i16_t __attribute__((ext_vector_type(4))); return __builtin_bit_cast(s16x4, __builtin_amdgcn_ds_read_tr16_b64_v4i16((LAS v4i16_t*)p)); }

__device__ __forceinline__ void attn_unit(Frame& F, int l, int kind, int b, int h, int qb) {
    const int lane = F.lane, w = F.wave, r32 = lane & 31, hi = lane >> 5, tid = F.tid;
    const bf16* P = WSP(bf16, WS_P);
    const int kvh = h >> 2;
    const int seq0 = kind ? (MCTX + b * 4096) : (b * 256);
    const int t0 = kind ? qb * 256 : 0;
    const int tq = t0 + 32 * w + r32;
    const size_t qrow = (size_t)(seq0 + tq);
    int tlo = 0, nloc = 4;
    if (kind) { const int lo = (t0 - 128) < 0 ? 0 : (t0 - 128), hi_ = (t0 + 384) > 4096 ? 4096 : (t0 + 384); tlo = lo >> 6; nloc = (hi_ >> 6) - tlo; }
    const int ntile = nloc + (kind ? 4 : 0);
    bf16x8 qf[8];
    { const bf16* qp = P + qrow * PP + C_Q + h * 128 + hi * 8;
#pragma unroll
      for (int ks = 0; ks < 8; ++ks) qf[ks] = *(const bf16x8*)(qp + 16 * ks); }
    float mrun = F.in(20  )[l * 8 + h] * LOG2E, lrun = (hi == 0) ? 1.0f : 0.0f;
    f32x16 o[4];
#pragma unroll
    for (int i = 0; i < 4; ++i)
#pragma unroll
        for (int r = 0; r < 16; ++r) o[i][r] = 0.f;
    LAS unsigned char* ldsK = F.lds + ATT_K_OFF; LAS unsigned char* ldsV = F.lds + ATT_V_OFF;
    u32x4 kr[2], vr[2];
    const bf16* CK = WSP(bf16, WS_CK) + (size_t)((b * 2 + l) * 256) * 256 + kvh * 128;
    const bf16* CV = WSP(bf16, WS_CV) + (size_t)((b * 2 + l) * 256) * 256 + kvh * 128;
#define ATT_LOAD(i) do { \
        _Pragma("unroll") for (int q_ = 0; q_ < 2; ++q_) { const int c_ = tid + 512 * q_, kv_ = c_ >> 4, dch_ = c_ & 15; \
            if ((i) < nloc) { const bf16* src_ = P + (size_t)(seq0 + (tlo + (i)) * 64 + kv_) * PP + kvh * 128 + dch_ * 8; kr[q_] = *(const u32x4*)(src_ + C_K); vr[q_] = *(const u32x4*)(src_ + C_V); } \
            else { const size_t off_ = (size_t)(((i) - nloc) * 64 + kv_) * 256 + dch_ * 8; kr[q_] = *(const u32x4*)(CK + off_); vr[q_] = *(const u32x4*)(CV + off_); } } } while (0)
    ATT_LOAD(0);
    for (int i = 0; i < ntile; ++i) {
        __syncthreads();
#pragma unroll
        for (int q_ = 0; q_ < 2; ++q_) { const int c_ = tid + 512 * q_, kv_ = c_ >> 4, dch_ = c_ & 15;
            *(LAS u32x4*)(ldsK + kv_ * AK_PITCH + dch_ * 16) = kr[q_]; *(LAS u32x4*)(ldsV + kv_ * AV_PITCH + dch_ * 16) = vr[q_]; }
        __syncthreads();
        if (i + 1 < ntile) ATT_LOAD(i + 1);
        const bool local = kind && (i < nloc);
        const int k0 = (tlo + i) * 64;
        bool need = true;
        if (local) { const int wq0 = t0 + 32 * w; need = (k0 + 63 >= wq0 - 128) && (k0 <= wq0 + 31 + 128); }
        if (need) {
            f32x16 s0, s1;
#pragma unroll
            for (int r = 0; r < 16; ++r) { s0[r] = 0.f; s1[r] = 0.f; }
#pragma unroll
            for (int ks = 0; ks < 8; ++ks) {
                const bf16x8 a0 = *(const LAS bf16x8*)(ldsK + r32 * AK_PITCH + ks * 32 + hi * 16);
                const bf16x8 a1 = *(const LAS bf16x8*)(ldsK + (32 + r32) * AK_PITCH + ks * 32 + hi * 16);
                s0 = __builtin_amdgcn_mfma_f32_32x32x16_bf16(a0, qf[ks], s0, 0, 0, 0);
                s1 = __builtin_amdgcn_mfma_f32_32x32x16_bf16(a1, qf[ks], s1, 0, 0, 0);
            }
            if (local) {
#pragma unroll
                for (int r = 0; r < 16; ++r) { const int kp = k0 + crow(r, hi); int d0 = kp - tq; d0 = d0 < 0 ? -d0 : d0; int d1 = kp + 32 - tq; d1 = d1 < 0 ? -d1 : d1;
                    if (d0 > 128) s0[r] = -INFINITY; if (d1 > 128) s1[r] = -INFINITY; }
            }
            float mx = fmaxf(s0[0], s1[0]);
#pragma unroll
            for (int r = 1; r < 16; ++r) mx = fmaxf(mx, fmaxf(s0[r], s1[r]));
            mx = fmaxf(mx, __shfl_xor(mx, 32));
            const float mnew = fmaxf(mrun, mx), alpha = __builtin_amdgcn_exp2f(mrun - mnew);
            mrun = mnew; lrun *= alpha;
#pragma unroll
            for (int i2 = 0; i2 < 4; ++i2)
#pragma unroll
                for (int r = 0; r < 16; ++r) o[i2][r] *= alpha;
            float ls = 0.f;
#pragma unroll
            for (int r = 0; r < 16; ++r) { s0[r] = __builtin_amdgcn_exp2f(s0[r] - mnew); s1[r] = __builtin_amdgcn_exp2f(s1[r] - mnew); ls += s0[r] + s1[r]; }
            lrun += ls;
            bf16x8 pb[4];
            { u32x4 t;
              t.x = pk2(s0[0], s0[1]); t.y = pk2(s0[2], s0[3]); t.z = pk2(s0[4], s0[5]); t.w = pk2(s0[6], s0[7]); pb[0] = __builtin_bit_cast(bf16x8, t);
              t.x = pk2(s0[8], s0[9]); t.y = pk2(s0[10], s0[11]); t.z = pk2(s0[12], s0[13]); t.w = pk2(s0[14], s0[15]); pb[1] = __builtin_bit_cast(bf16x8, t);
              t.x = pk2(s1[0], s1[1]); t.y = pk2(s1[2], s1[3]); t.z = pk2(s1[4], s1[5]); t.w = pk2(s1[6], s1[7]); pb[2] = __builtin_bit_cast(bf16x8, t);
              t.x = pk2(s1[8], s1[9]); t.y = pk2(s1[10], s1[11]); t.z = pk2(s1[12], s1[13]); t.w = pk2(s1[14], s1[15]); pb[3] = __builtin_bit_cast(bf16x8, t); }
            const LAS unsigned char* vb = ldsV + (4 * hi + ((lane & 15) >> 2)) * AV_PITCH + ((lane >> 4) & 1) * 32 + (lane & 3) * 8;
#pragma unroll
            for (int s = 0; s < 4; ++s)
#pragma unroll
                for (int db = 0; db < 4; ++db) {
                    const s16x4 lo = vtr(vb + (16 * s) * AV_PITCH + db * 64), hh = vtr(vb + (16 * s + 8) * AV_PITCH + db * 64);
                    const bf16x8 a = {lo[0], lo[1], lo[2], lo[3], hh[0], hh[1], hh[2], hh[3]};
                    o[db] = __builtin_amdgcn_mfma_f32_32x32x16_bf16(a, pb[s], o[db], 0, 0, 0);
                }
        }
    }
#undef ATT_LOAD
    const float ltot = lrun + __shfl_xor(lrun, 32), inv = 1.0f / ltot;
    bf16* YC = WSP(bf16, WS_H) + qrow * DM + 512 + h * 128;
    const bf16* zb = P + qrow * PP + C_ZB + h * 128;
#pragma unroll
    for (int db = 0; db < 4; ++db)
#pragma unroll
        for (int rg = 0; rg < 4; ++rg) { const int d = 32 * db + 8 * rg + 4 * hi;
            const u32x2 z = *(const u32x2*)(zb + d);
            u32x2 wv; wv.x = pk2(o[db][4 * rg] * inv * bflo(z.x), o[db][4 * rg + 1] * inv * bfhi(z.x)); wv.y = pk2(o[db][4 * rg + 2] * inv * bflo(z.y), o[db][4 * rg + 3] * inv * bfhi(z.y));
            *(u32x2*)(YC + d) = wv; }
}

__device__ __forceinline__ void ssm_stage_u(Frame& F, int g, int rowbase) {
    const bf16* P = WSP(bf16, WS_P);
#pragma unroll
    for (int q = 0; q < 8; ++q) { const int c = F.tid + 512 * q, hh = c & 1, tok = c >> 1, n = tok >> 5, j = tok & 31;
        const u32x4 v = *(const u32x4*)(P + (size_t)(rowbase + tok) * PP + C_XA + g * 16 + hh * 8);
        *(LAS u32x4*)(F.lds + ((j * 64 + n) * 32 + hh * 16)) = v; }
}
__device__ __forceinline__ void ssm_unit(Frame& F, int l, int g, int tb) {
    const int lane = F.lane, w = F.wave, r32 = lane & 31, hi = lane >> 5, tid = F.tid;
    const int unit = g * 4 + tb;
    const int rowblk = tb * 4096;
    const bool ctx = tb < 2;
    const int nchunk = ctx ? 8 : 128;
    float* Fb = WSP(float, WS_F) + (size_t)unit * 128 * 256;
    bf16* Sb = WSP(bf16, WS_SIN) + (size_t)unit * 128 * 256;
    const bf16* WF = WSP(bf16, WS_WF) + (size_t)(l * 32 + g) * 131072;
    const bf16* WY = WSP(bf16, WS_WY) + (size_t)(l * 32 + g) * 131072;
    LAS unsigned char* ldsU = F.lds;
    LAS unsigned char* ldsL = F.lds + 65536;
    __syncthreads();
    { const u32x4* src = (const u32x4*)(WSP(bf16, WS_LAG) + (size_t)(l * 32 + g) * 16384);
      for (int i = tid; i < 63 * 32; i += NT) *(LAS u32x4*)(ldsL + i * 16) = src[i]; }
    for (int half = 0; half < 2; ++half) {
        const bf16* wfr = WF + (size_t)(32 * w + r32) * 512 + hi * 8;
        bf16x8 afr[32];
#pragma unroll
        for (int j = 0; j < 32; ++j) afr[j] = *(const bf16x8*)(wfr + 16 * j);
        __syncthreads();
        ssm_stage_u(F, g, rowblk + half * 2048);
        __syncthreads();
        f32x16 acc[2];
#pragma unroll
        for (int r = 0; r < 16; ++r) { acc[0][r] = 0.f; acc[1][r] = 0.f; }
#pragma unroll
        for (int j = 0; j < 32; ++j) {
            const bf16x8 b0 = *(const LAS bf16x8*)(ldsU + (j * 64 + r32) * 32 + hi * 16), b1 = *(const LAS bf16x8*)(ldsU + (j * 64 + 32 + r32) * 32 + hi * 16);
            acc[0] = __builtin_amdgcn_mfma_f32_32x32x16_bf16(afr[j], b0, acc[0], 0, 0, 0);
            acc[1] = __builtin_amdgcn_mfma_f32_32x32x16_bf16(afr[j], b1, acc[1], 0, 0, 0);
        }
#pragma unroll
        for (int ib = 0; ib < 2; ++ib)
#pragma unroll
            for (int rg = 0; rg < 4; ++rg) { float* o = Fb + (size_t)(half * 64 + ib * 32 + r32) * 256 + 32 * w + 8 * rg + 4 * hi;
                *(f32x4*)o = (f32x4){acc[ib][4 * rg], acc[ib][4 * rg + 1], acc[ib][4 * rg + 2], acc[ib][4 * rg + 3]}; }
    }
    __syncthreads();
    { const int nseq = ctx ? 16 : 1;
      const float* at = WSP(float, WS_AT) + (size_t)((l * 32 + g) * 2) * 128;
      for (int it = tid; it < nseq * 128; it += NT) {
          const int sq = it >> 7, d = (it >> 6) & 1, p = it & 63;
          const float ar = at[d * 128 + p], ai = at[d * 128 + 64 + p];
          float sr = 0.f, si = 0.f;
          if (!ctx) { const float* s0 = F.in(4  ) + (size_t)((((tb - 2) * 2 + l) * 2 + d) * 2) * 2048 + g * 64 + p; sr = s0[0]; si = s0[2048]; }
          float fr_[8], fi_[8], gr_[8], gi_[8];
#pragma unroll
          for (int e = 0; e < 8; ++e) { const int cc = d ? (nchunk - 1 - e) : e, n = sq * nchunk + cc; const float* f = Fb + (size_t)n * 256 + d * 128 + p; fr_[e] = f[0]; fi_[e] = f[64]; }
          for (int c0 = 0; c0 < nchunk; c0 += 8) {
              if (c0 + 8 < nchunk) {
#pragma unroll
                  for (int e = 0; e < 8; ++e) { const int cI = c0 + 8 + e, cc = d ? (nchunk - 1 - cI) : cI, n = sq * nchunk + cc; const float* f = Fb + (size_t)n * 256 + d * 128 + p; gr_[e] = f[0]; gi_[e] = f[64]; }
              }
#pragma unroll
              for (int e = 0; e < 8; ++e) { const int cI = c0 + e, cc = d ? (nchunk - 1 - cI) : cI, n = sq * nchunk + cc;
                  bf16* so = Sb + (size_t)n * 256 + d * 128 + p; so[0] = (bf16)f2bf(sr); so[64] = (bf16)f2bf(si);
                  const float nr = ar * sr - ai * si + fr_[e], ni = ar * si + ai * sr + fi_[e]; sr = nr; si = ni; }
#pragma unroll
              for (int e = 0; e < 8; ++e) { fr_[e] = gr_[e]; fi_[e] = gi_[e]; }
          }
          if (ctx) { const int bb = tb * 16 + sq; float* o = F.out + (size_t)M * DM + 2 * (size_t)(32 * 2 * 256 * 256) + (size_t)((((bb * 2 + l) * 2 + d) * 2) * 2048) + g * 64 + p; o[0] = sr; o[2048] = si; }
      } }
    bf16* YG = WSP(bf16, WS_YG);
    for (int half = 0; half < 2; ++half) {
        __syncthreads();
        ssm_stage_u(F, g, rowblk + half * 2048);
        __syncthreads();
        f32x16 acc[2][2];
#pragma unroll
        for (int a_ = 0; a_ < 2; ++a_)
#pragma unroll
            for (int b_ = 0; b_ < 2; ++b_)
#pragma unroll
                for (int r = 0; r < 16; ++r) acc[a_][b_][r] = 0.f;
        const LAS unsigned char* lagp = ldsL + (r32 & 15) * 32 + hi * 16;
#pragma unroll 4
        for (int j = 0; j < 32; ++j) {
            const bf16x8 b0 = *(const LAS bf16x8*)(ldsU + (j * 64 + r32) * 32 + hi * 16), b1 = *(const LAS bf16x8*)(ldsU + (j * 64 + 32 + r32) * 32 + hi * 16);
#pragma unroll
            for (int rr = 0; rr < 2; ++rr) { const int i = 2 * (2 * w + rr) + (r32 >> 4);
                const bf16x8 a = *(const LAS bf16x8*)(lagp + (i - j + 31) * 512);
                acc[rr][0] = __builtin_amdgcn_mfma_f32_32x32x16_bf16(a, b0, acc[rr][0], 0, 0, 0);
                acc[rr][1] = __builtin_amdgcn_mfma_f32_32x32x16_bf16(a, b1, acc[rr][1], 0, 0, 0); }
        }
#pragma unroll 8
        for (int ks = 0; ks < 16; ++ks) {
            const bf16x8 b0 = *(const bf16x8*)(Sb + (size_t)(half * 64 + r32) * 256 + 16 * ks + hi * 8), b1 = *(const bf16x8*)(Sb + (size_t)(half * 64 + 32 + r32) * 256 + 16 * ks + hi * 8);
#pragma unroll
            for (int rr = 0; rr < 2; ++rr) {
                const bf16x8 a = *(const bf16x8*)(WY + (size_t)(32 * (2 * w + rr) + r32) * 256 + 16 * ks + hi * 8);
                acc[rr][0] = __builtin_amdgcn_mfma_f32_32x32x16_bf16(a, b0, acc[rr][0], 0, 0, 0);
                acc[rr][1] = __builtin_amdgcn_mfma_f32_32x32x16_bf16(a, b1, acc[rr][1], 0, 0, 0); }
        }
#pragma unroll
        for (int rr = 0; rr < 2; ++rr)
#pragma unroll
            for (int ib = 0; ib < 2; ++ib)
#pragma unroll
                for (int rg = 0; rg < 4; ++rg) { const int i = 2 * (2 * w + rr) + (rg >> 1), c = 8 * (rg & 1) + 4 * hi, n = ib * 32 + r32;
                    const size_t row = (size_t)(rowblk + half * 2048 + n * 32 + i);
                    u32x2 wv; wv.x = pk2(geluf_(acc[rr][ib][4 * rg]), geluf_(acc[rr][ib][4 * rg + 1])); wv.y = pk2(geluf_(acc[rr][ib][4 * rg + 2]), geluf_(acc[rr][ib][4 * rg + 3]));
                    *(u32x2*)(YG + row * 512 + g * 16 + c) = wv; }
    }
}

constexpr int SG_PITCH = 272;
__device__ __forceinline__ void sgu_unit(Frame& F, int l, int ck, int g) {
    const int lane = F.lane, w = F.wave, r32 = lane & 31, hi = lane >> 5, tid = F.tid;
    const bf16* P = WSP(bf16, WS_P);
    const int row0 = ck * 128;
    LAS unsigned char* vnt = F.lds;
    __syncthreads();
    {
      const int q = tid >> 2, qq = tid & 3;
      const bf16* vrow = P + (size_t)(row0 + q) * PP + C_VS + qq * 32;
      u32x4 mine[4]; float s = 0.f, s2 = 0.f;
#pragma unroll
      for (int gg = 0; gg < 4; ++gg)
#pragma unroll
          for (int k = 0; k < 4; ++k) { const u32x4 v = *(const u32x4*)(vrow + gg * 128 + k * 8); if (gg == g) mine[k] = v;
              const float f0 = bflo(v.x), f1 = bfhi(v.x), f2 = bflo(v.y), f3 = bfhi(v.y), f4 = bflo(v.z), f5 = bfhi(v.z), f6 = bflo(v.w), f7 = bfhi(v.w);
              s += ((f0 + f1) + (f2 + f3)) + ((f4 + f5) + (f6 + f7)); s2 += ((f0 * f0 + f1 * f1) + (f2 * f2 + f3 * f3)) + ((f4 * f4 + f5 * f5) + (f6 * f6 + f7 * f7)); }
      s += __shfl_xor(s, 1); s += __shfl_xor(s, 2); s2 += __shfl_xor(s2, 1); s2 += __shfl_xor(s2, 2);
      const float mean = s * (1.f / 512.f), var = fmaxf(s2 * (1.f / 512.f) - mean * mean, 0.f), rstd = 1.f / sqrtf(var + LN_EPS);
      const float* lgp = F.in(21  ) + l * 512 + g * 128 + qq * 32; const float* lbp = F.in(22  ) + l * 512 + g * 128 + qq * 32;
#pragma unroll
      for (int k = 0; k < 4; ++k) { const unsigned ww[4] = {mine[k].x, mine[k].y, mine[k].z, mine[k].w};
#pragma unroll
          for (int e = 0; e < 4; ++e) { const int c = qq * 32 + k * 8 + e * 2;
              const float v0 = (bflo(ww[e]) - mean) * rstd * lgp[k * 8 + e * 2] + lbp[k * 8 + e * 2], v1 = (bfhi(ww[e]) - mean) * rstd * lgp[k * 8 + e * 2 + 1] + lbp[k * 8 + e * 2 + 1];
              *(LAS unsigned short*)(vnt + c * SG_PITCH + q * 2) = (unsigned short)f2bf(v0); *(LAS unsigned short*)(vnt + (c + 1) * SG_PITCH + q * 2) = (unsigned short)f2bf(v1); } }
    }
    __syncthreads();
    const int pb = w >> 1, cb0 = 2 * (w & 1);
    const bf16* Ws = WSP(bf16, WS_WS) + (size_t)((l * 4 + g) * 128 + 32 * pb + r32) * 128 + hi * 8;
    f32x16 acc[2];
#pragma unroll
    for (int r = 0; r < 16; ++r) { acc[0][r] = 0.f; acc[1][r] = 0.f; }
#pragma unroll
    for (int ks = 0; ks < 8; ++ks) {
        const bf16x8 a = *(const bf16x8*)(Ws + 16 * ks);
        const bf16x8 b0 = *(const LAS bf16x8*)(vnt + (32 * cb0 + r32) * SG_PITCH + (16 * ks + 8 * hi) * 2), b1 = *(const LAS bf16x8*)(vnt + (32 * (cb0 + 1) + r32) * SG_PITCH + (16 * ks + 8 * hi) * 2);
        acc[0] = __builtin_amdgcn_mfma_f32_32x32x16_bf16(a, b0, acc[0], 0, 0, 0);
        acc[1] = __builtin_amdgcn_mfma_f32_32x32x16_bf16(a, b1, acc[1], 0, 0, 0);
    }
    bf16* YC = WSP(bf16, WS_H);
    const float* bs = F.in(24  ) + (l * 4 + g) * 128;
    LAS float* outt = (LAS float*)(F.lds + 36864);
#pragma unroll
    for (int cbi = 0; cbi < 2; ++cbi)
#pragma unroll
        for (int r = 0; r < 16; ++r) { const int p = 32 * pb + crow(r, hi), c = 32 * (cb0 + cbi) + r32; outt[p * 132 + c] = acc[cbi][r] + bs[p]; }
    __syncthreads();
    { const int p = tid >> 2, cq = (tid & 3) * 32; const size_t row = (size_t)(row0 + p);
#pragma unroll
      for (int k = 0; k < 4; ++k) { const int c = cq + 8 * k;
          const u32x4 u8 = *(const u32x4*)(P + row * PP + C_U + g * 128 + c), z8 = *(const u32x4*)(P + row * PP + C_ZC + g * 128 + c);
          const f32x4 o0 = *(const LAS f32x4*)(outt + p * 132 + c), o1 = *(const LAS f32x4*)(outt + p * 132 + c + 4);
          u32x4 wv;
          wv.x = pk2(o0[0] * bflo(u8.x) * bflo(z8.x), o0[1] * bfhi(u8.x) * bfhi(z8.x)); wv.y = pk2(o0[2] * bflo(u8.y) * bflo(z8.y), o0[3] * bfhi(u8.y) * bfhi(z8.y));
          wv.z = pk2(o1[0] * bflo(u8.z) * bflo(z8.z), o1[1] * bfhi(u8.z) * bfhi(z8.z)); wv.w = pk2(o1[2] * bflo(u8.w) * bflo(z8.w), o1[3] * bfhi(u8.w) * bfhi(z8.w));
          *(u32x4*)(YC + row * DM + 1536 + g * 128 + c) = wv; } }
}

#ifndef PHASE_MASK
#define PHASE_MASK 0xff
#endif
#define PM(k) ((PHASE_MASK >> (k)) & 1)
#ifndef UNIT_MASK
#define UNIT_MASK 7
#endif
#define UM(k) (((rep == 0 ? 7 : UNIT_MASK) >> (k)) & 1)
#ifndef REPEAT_PHASE
#define REPEAT_PHASE -1
#endif
constexpr int N_PHASES = 14;
__global__ void __launch_bounds__(NT, 2) fwd_kernel(Args args) {
    extern __shared__ __attribute__((aligned(16))) unsigned char lds[];
    Frame F;
    F.lds = (LAS unsigned char*)lds;
    F.MISC = (volatile LAS unsigned*)(F.lds + MISC_OFF);
    F.tid = threadIdx.x; F.lane = F.tid & 63; F.wave = __builtin_amdgcn_readfirstlane(F.tid >> 6);
    F.G = gridDim.x; F.bid = blockIdx.x;
    F.ws = args.ws; F.out = args.out; F.ctl = (unsigned*)(args.ws + WS_CTL);
    F.ka = (KArgs)__builtin_amdgcn_kernarg_segment_ptr();
    for (int u = F.tid; u < (LDS_BYTES - LDSCTL_OFF) / 4; u += NT) ((LAS unsigned*)(F.lds + LDSCTL_OFF))[u] = 0u;
    __syncthreads();
    XcdBarrier bar = xcd_barrier_post((unsigned*)(F.ctl + CW_BAR), F.MISC + 8);
    const int lo = args.ph_lo, hi = args.ph_hi;
#define IN(k) (lo <= (k) && (k) < hi)
#define FRESH() do { asm volatile("" : "+s"(F.ka)); asm volatile("" : "+v"(F.tid)); F.lane = F.tid & 63; F.wave = __builtin_amdgcn_readfirstlane(F.tid >> 6); } while (0)
#define SEAM(k) do { if (IN(k) && IN((k) + 1)) xcd_barrier(bar); } while (0)

#define REPS(k) ((REPEAT_PHASE == (k)) ? 2 : 1)
#define RSEAM(k) do { if (rep + 1 < REPS(k)) xcd_barrier(bar); } while (0)
    if (PM(0) && IN(0)) for (int rep = 0; rep < REPS(0); ++rep) { FRESH(); p0_prologue(F); RSEAM(0); }
    SEAM(0);
    if (PM(1) && IN(1)) for (int rep = 0; rep < REPS(1); ++rep) { FRESH(); p1_lnmod(F); RSEAM(1); }
    SEAM(1);
    for (int l = 0; l < 2; ++l) {
        const int pb = 2 + 6 * l;
        if (PM(2) && IN(pb)) for (int rep = 0; rep < REPS(2) - l * (REPS(2) - 1); ++rep) { FRESH();
            pg8::Gemm g{WSP(bf16, WS_H), WSP(bf16, WS_WIN) + (size_t)l * DIN * 2048, M, DIN, DM}; pg8::StaticOrder S; S.init(M, DIN, F.G, F.bid);
            float* okv = F.out + (size_t)M * DM + (size_t)l * 256 * 256;
            pg8::EpiInProj E{WSP(bf16, WS_P), WSP(bf16, WS_GT), okv, okv + (size_t)32 * 2 * 256 * 256, WSP(float, WS_ROPE)};
            pg8::gemm_phase<pg8::EpiInProj, pg8::StaticOrder, true, true>(F.lds, g, S, E, F.tid);
            RSEAM(2);
        }
        if (REPEAT_PHASE >= 8 && l == 0 && IN(pb)) { xcd_barrier(bar); FRESH();
            const int NN = (REPEAT_PHASE == 8) ? DIN : DM;
            pg8::Gemm g{WSP(bf16, WS_H), WSP(bf16, WS_WIN), M, NN, DM}; pg8::StaticOrder S; S.init(M, NN, F.G, F.bid);
            pg8::EpiNull E{WSP(float, WS_F)};
            pg8::gemm_phase<pg8::EpiNull, pg8::StaticOrder, true, true>(F.lds, g, S, E, F.tid);
        }
        SEAM(pb);
        if (PM(3) && IN(pb + 1)) for (int rep = 0; rep < REPS(3) - l * (REPS(3) - 1); ++rep) {
            for (;;) {
                int u = wq_next(F, pb + 1 + 32 * rep); FRESH();
                if (u >= 1152) break;
                if (u < 256) { if (UM(0)) attn_unit(F, l, 1, u >> 7, (u >> 4) & 7, u & 15); continue; } u -= 256;
                if (u < 128) { if (UM(1)) ssm_unit(F, l, u >> 2, u & 3); continue; } u -= 128;
                if (u < 256) { if (UM(0)) attn_unit(F, l, 0, u >> 3, u & 7, 0); continue; } u -= 256;
                if (UM(2)) sgu_unit(F, l, u >> 2, u & 3);
            }
            __syncthreads();
            RSEAM(3);
        }
        SEAM(pb + 1);
        if (PM(4) && IN(pb + 2)) for (int rep = 0; rep < REPS(4) - l * (REPS(4) - 1); ++rep) { FRESH();
            for (int t = F.bid; t < 128; t += F.G) {
                pg8::Gemm g{WSP(bf16, WS_YG), WSP(bf16, WS_WGLU) + (size_t)l * 512 * 512, M, 512, 512}; pg8::OneUnit S{{t >> 1, t & 1}};
                pg8::EpiGlu E{WSP(bf16, WS_YG), WSP(bf16, WS_P), WSP(bf16, WS_H), F.in(19  ) + l * 512};
                pg8::gemm_phase<pg8::EpiGlu, pg8::OneUnit, false, true>(F.lds, g, S, E, F.tid);
            }
            RSEAM(4);
        }
        SEAM(pb + 2);
        if (PM(5) && IN(pb + 3)) for (int rep = 0; rep < REPS(5) - l * (REPS(5) - 1); ++rep) { FRESH();
            pg8::Gemm g{WSP(bf16, WS_H), WSP(bf16, WS_WP) + (size_t)l * 2048 * 2048, M, DM, DM}; pg8::StaticOrder S; S.init(M, DM, F.G, F.bid);
            pg8::EpiMerge E{WSP(bf16, WS_GT), WSP(bf16, WS_MRG)};
            pg8::gemm_phase<pg8::EpiMerge, pg8::StaticOrder, true, true>(F.lds, g, S, E, F.tid);
            RSEAM(5);
        }
        SEAM(pb + 3);
        if (PM(6) && IN(pb + 4)) for (int rep = 0; rep < REPS(6) - l * (REPS(6) - 1); ++rep) { FRESH();
            pg8::Gemm g{WSP(bf16, WS_MRG), WSP(bf16, WS_WOUT) + (size_t)l * 2048 * 2048, M, DM, DM}; pg8::StaticOrder S; S.init(M, DM, F.G, F.bid);
            const float* xa = (l == 0) ? F.in(0  ) : F.out; const float* xb = (l == 0) ? F.in(1  ) : (F.out + (size_t)MCTX * DM);
            pg8::EpiOut E{xa, xb, F.out, WSP(float, WS_MOD) + (size_t)l * 3 * 6144};
            pg8::gemm_phase<pg8::EpiOut, pg8::StaticOrder, true, true>(F.lds, g, S, E, F.tid);
            RSEAM(6);
        }
        SEAM(pb + 4);
        if (PM(7) && IN(pb + 5)) { FRESH(); pg_postln(F, l); }
        if (l == 0) SEAM(pb + 5);
    }
#undef IN
#undef SEAM
}

#ifndef N_LAUNCH_MODE
#define N_LAUNCH_MODE 0
#endif
extern "C" void kernel_launch(void* const* d_in, const int* in_sizes, int n_in, void* d_out, int out_size, void* d_ws, size_t ws_size, hipStream_t stream) {
    static int grid = 0;
    if (grid == 0) {
        if (n_in != 31 || ws_size < WS_END) { fprintf(stderr, "kernel_launch: need 31 inputs and >= %zu bytes of workspace; got %d, %zu\n", (size_t)WS_END, n_in, ws_size); grid = -1; return; }
        int dev = 0, cus = 0, per_cu = 0;
        if (hipGetDevice(&dev) != hipSuccess || hipDeviceGetAttribute(&cus, hipDeviceAttributeMultiprocessorCount, dev) != hipSuccess) { grid = -1; return; }
        if (hipFuncSetAttribute((const void*)fwd_kernel, hipFuncAttributeMaxDynamicSharedMemorySize, LDS_BYTES) != hipSuccess) { fprintf(stderr, "kernel_launch: hipFuncSetAttribute failed\n"); grid = -1; return; }
        if (hipOccupancyMaxActiveBlocksPerMultiprocessor(&per_cu, (const void*)fwd_kernel, NT, LDS_BYTES) != hipSuccess || per_cu < 1) { fprintf(stderr, "kernel_launch: occupancy query says %d\n", per_cu); (void)hipGetLastError(); grid = -1; return; }
        grid = cus;
    }
    if (grid < 0) return;
    (void)hipMemsetAsync((char*)d_ws + WS_CTL, 0, CTL_ZERO_BYTES, stream);
    Args a{};
    for (int i = 0; i < 31; ++i) a.in[i] = (const float*)d_in[i];
    a.out = (float*)d_out; a.ws = (unsigned char*)d_ws;
#if N_LAUNCH_MODE == 0
    a.ph_lo = 0; a.ph_hi = N_PHASES;
    { void* params[] = {&a}; (void)params; hipLaunchKernelGGL(fwd_kernel, dim3(grid), dim3(NT), LDS_BYTES, stream, a); hipError_t e = hipPeekAtLastError();
      if (e != hipSuccess) fprintf(stderr, "launch failed: %s\n", hipGetErrorString(e)); }
#else
    for (int p = 0; p < N_PHASES; ++p) { a.ph_lo = p; a.ph_hi = p + 1;
        void* params[] = {&a}; hipError_t e = hipLaunchCooperativeKernel((const void*)fwd_kernel, dim3(grid), dim3(NT), params, LDS_BYTES, stream);
        if (e != hipSuccess) { fprintf(stderr, "launch %d failed: %s\n", p, hipGetErrorString(e)); break; } }
#endif
}
```
